# Optimizing an MI355X kernel written in HIP

```python
import jax, jax.numpy as jnp
from jax import lax
import numpy as np

D_MODEL = 1024
BATCH = 32
SEQ = 2048
DEPTH = 2

CHUNK = 64
N_MEM = 256
HEAD_DIM = 64
N_HEADS = D_MODEL // HEAD_DIM
DECAY_LORA = 64
AAA_LORA = 64
GATE_LORA = 128
GN_EPS = 64e-5
N_MIX = 6
SB_BLOCK = 128
X_HEADS = 4
X_HEAD_DIM = D_MODEL // X_HEADS
N_GROUPS = 4
EXPERTS_PER_GROUP = 8
TOP_K = 2
D_EXPERT = 256
NORM_EPS = 1e-6
N_RWKV = (DEPTH + 1) // 2
N_SB = DEPTH // 2

kernel_name = "rwkv7_stickbreak_memx_hmoe_trunk"


def _rms_norm(x, g):
    xf = x.astype(jnp.float32)
    y = xf * lax.rsqrt(jnp.mean(xf * xf, axis=-1, keepdims=True) + NORM_EPS)
    return (y * g.astype(jnp.float32)).astype(x.dtype)


def _rwkv7_time_mix(h, mix, wr, wk, wv, w0, w1, w2, a0, a1, a2, g1, g2,
                    k_k, k_a, r_k, lnx_w, lnx_b, wo):
    B, S, C = h.shape
    H, N = N_HEADS, HEAD_DIM
    f32 = jnp.float32
    dt = h.dtype
    h_prev = jnp.pad(h, ((0, 0), (1, 0), (0, 0)))[:, :-1]
    dx = h_prev - h
    xr, xw, xk, xv, xa, xg = [h + dx * mix[i] for i in range(N_MIX)]

    r = (xr @ wr).astype(f32)
    k = (xk @ wk).astype(f32)
    v = (xv @ wv).astype(f32)
    w_log = -jax.nn.softplus(-(w0 + jnp.tanh(xw @ w1) @ w2).astype(f32)) - 0.5
    decay = jnp.exp(-jnp.exp(w_log))
    a = jax.nn.sigmoid((a0 + (xa @ a1) @ a2).astype(f32))
    g = jax.nn.sigmoid(xg @ g1) @ g2

    kk = (k * k_k).reshape(B, S, H, N)
    kk = kk / jnp.maximum(jnp.linalg.norm(kk, axis=-1, keepdims=True), 1e-12)
    k = k * (1.0 + (a - 1.0) * k_a)

    rh = r.reshape(B, S, H, N)
    kh = k.reshape(B, S, H, N)
    vh = v.reshape(B, S, H, N)
    bh = kk * a.reshape(B, S, H, N)
    dh = decay.reshape(B, S, H, N)

    def to_chunks(t):
        return jnp.moveaxis(t, 1, 0).reshape(S // CHUNK, CHUNK, B, H, N)

    def frame_step(state, inp):
        r_t, d_t, k_t, v_t, kk_t, b_t = inp
        sa = jnp.einsum('bhvk,bhk->bhv', state, -kk_t)
        state = (state * d_t[:, :, None, :]
                 + sa[..., None] * b_t[:, :, None, :]
                 + v_t[..., None] * k_t[:, :, None, :])
        y_t = jnp.einsum('bhvk,bhk->bhv', state, r_t)
        return state, y_t

    def chunk_step(state, inp_chunk):
        return lax.scan(frame_step, state, inp_chunk)

    state0 = jnp.zeros((B, H, N, N), f32)
    _, y = lax.scan(chunk_step, state0,
                    (to_chunks(rh), to_chunks(dh), to_chunks(kh), to_chunks(vh),
                     to_chunks(kk), to_chunks(bh)))
    y = jnp.moveaxis(y.reshape(S, B, H, N), 0, 1)

    mu = jnp.mean(y, axis=-1, keepdims=True)
    var = jnp.mean(jnp.square(y - mu), axis=-1, keepdims=True)
    y = ((y - mu) * lax.rsqrt(var + GN_EPS)).reshape(B, S, C) * lnx_w + lnx_b
    bonus = jnp.sum(rh * kh * r_k, axis=-1, keepdims=True) * vh
    y = y + bonus.reshape(B, S, C)
    return (y * g).astype(dt) @ wo


def _stick_breaking_attention(h, wqkv, wo):
    B, S, C = h.shape
    H, N = N_HEADS, HEAD_DIM
    f32 = jnp.float32
    qkv = (h @ wqkv).reshape(B, S, 3, H, N).astype(f32)
    q = qkv[:, :, 0] * (N ** -0.5)
    k = qkv[:, :, 1]
    v = qkv[:, :, 2]
    outs = []
    for blk in range(S // SB_BLOCK):
        q0 = blk * SB_BLOCK
        end = q0 + SB_BLOCK
        z = jnp.einsum('bthd,bshd->bhts', q[:, q0:end], k[:, :end])
        t_idx = q0 + jnp.arange(SB_BLOCK)[:, None]
        s_idx = jnp.arange(end)[None, :]
        before = s_idx < t_idx
        log_fail = jnp.where(before, jax.nn.log_sigmoid(-z), 0.0)
        later = lax.cumsum(log_fail, axis=3, reverse=True) - log_fail
        att = jnp.where(before, jnp.exp(jax.nn.log_sigmoid(z) + later), 0.0)
        outs.append(jnp.einsum('bhts,bshd->bthd', att, v[:, :end]))
    o = jnp.concatenate(outs, axis=1).reshape(B, S, C)
    return o.astype(h.dtype) @ wo


def _memory_cross_attention(h, mem_k, mem_v, wq, wo):
    B, S, C = h.shape
    q = (h @ wq).reshape(B, S, X_HEADS, X_HEAD_DIM)
    scores = jnp.einsum('bthd,bmhd->bhtm', q, mem_k).astype(jnp.float32) * (X_HEAD_DIM ** -0.5)
    p = jax.nn.softmax(scores, axis=-1).astype(h.dtype)
    o = jnp.einsum('bhtm,bmhd->bthd', p, mem_v).reshape(B, S, C)
    return o @ wo


def _hierarchical_moe(h, wg, bg, we, be, w1, w3, w2):
    B, S, C = h.shape
    G, E = N_GROUPS, EXPERTS_PER_GROUP
    f32 = jnp.float32
    t = h.reshape(B * S, C)
    g_logits = (t @ wg).astype(f32) + bg
    g_prob = jax.nn.softmax(g_logits, axis=-1)
    group = jnp.argmax(g_logits, axis=-1)
    p_group = jnp.take_along_axis(g_prob, group[:, None], axis=-1)
    e_logits = ((t @ we).astype(f32) + be).reshape(-1, G, E)
    e_sel = jnp.take_along_axis(e_logits, group[:, None, None], axis=1)[:, 0]
    top_val, top_idx = lax.top_k(e_sel, TOP_K)
    top_w = jax.nn.softmax(top_val, axis=-1) * p_group
    gate_e = jnp.sum(jax.nn.one_hot(top_idx, E, dtype=f32) * top_w[..., None], axis=1)
    gate = jax.nn.one_hot(group, G, dtype=f32)[:, :, None] * gate_e[:, None, :]
    y = jnp.zeros((B * S, C), f32)
    for gi in range(G):
        hid = jax.nn.silu(jnp.einsum('td,edf->tef', t, w1[gi])) * jnp.einsum('td,edf->tef', t, w3[gi])
        hid = hid * gate[:, gi, :, None].astype(hid.dtype)
        y = y + jnp.einsum('tef,efd->td', hid, w2[gi]).astype(f32)
    return y.astype(h.dtype).reshape(B, S, C)


def setup_inputs(seed: int = 0) -> dict:
    key = jax.random.key(seed)
    ks = iter(jax.random.split(key, 48))
    f32 = jnp.float32
    C, H, N = D_MODEL, N_HEADS, HEAD_DIM
    G, E, F = N_GROUPS, EXPERTS_PER_GROUP, D_EXPERT

    def nrm(shape, scale):
        return jax.random.normal(next(ks), shape, f32) * scale

    def gain(shape):
        return 1.0 + nrm(shape, 0.02)

    return {
        "x": nrm((BATCH, SEQ, C), 1.0),
        "mem": nrm((BATCH, N_MEM, C), 1.0),
        "norm_mix": gain((DEPTH, C)),
        "norm_cross": gain((DEPTH, C)),
        "norm_ffn": gain((DEPTH, C)),
        "norm_mem": gain((C,)),
        "norm_final": gain((C,)),
        "rw_mix": jax.random.uniform(next(ks), (N_RWKV, N_MIX, C), f32),
        "rw_wr": nrm((N_RWKV, C, C), C ** -0.5),
        "rw_wk": nrm((N_RWKV, C, C), C ** -0.5),
        "rw_wv": nrm((N_RWKV, C, C), C ** -0.5),
        "rw_w0": jax.random.uniform(next(ks), (N_RWKV, C), f32, -2.5, 1.0),
        "rw_w1": nrm((N_RWKV, C, DECAY_LORA), C ** -0.5),
        "rw_w2": nrm((N_RWKV, DECAY_LORA, C), 0.5 * DECAY_LORA ** -0.5),
        "rw_a0": nrm((N_RWKV, C), 0.5),
        "rw_a1": nrm((N_RWKV, C, AAA_LORA), C ** -0.5),
        "rw_a2": nrm((N_RWKV, AAA_LORA, C), 0.5 * AAA_LORA ** -0.5),
        "rw_g1": nrm((N_RWKV, C, GATE_LORA), C ** -0.5),
        "rw_g2": nrm((N_RWKV, GATE_LORA, C), GATE_LORA ** -0.5),
        "rw_kk": 1.0 + nrm((N_RWKV, C), 0.1),
        "rw_ka": 1.0 + nrm((N_RWKV, C), 0.1),
        "rw_rk": nrm((N_RWKV, H, N), 0.1),
        "rw_lnx_w": gain((N_RWKV, C)),
        "rw_lnx_b": nrm((N_RWKV, C), 0.02),
        "rw_wo": nrm((N_RWKV, C, C), C ** -0.5),
        "sb_wqkv": nrm((N_SB, C, 3 * C), C ** -0.5),
        "sb_wo": nrm((N_SB, C, C), C ** -0.5),
        "xa_wq": nrm((DEPTH, C, C), C ** -0.5),
        "xa_wkv": nrm((C, 2 * C), C ** -0.5),
        "xa_wo": nrm((DEPTH, C, C), C ** -0.5),
        "moe_wg": nrm((DEPTH, C, G), C ** -0.5),
        "moe_bg": nrm((DEPTH, G), 0.01),
        "moe_we": nrm((DEPTH, C, G * E), C ** -0.5),
        "moe_be": nrm((DEPTH, G * E), 0.01),
        "moe_w1": nrm((DEPTH, G, E, C, F), C ** -0.5),
        "moe_w3": nrm((DEPTH, G, E, C, F), C ** -0.5),
        "moe_w2": nrm((DEPTH, G, E, F, C), F ** -0.5),
    }


def reference(x, mem, norm_mix, norm_cross, norm_ffn, norm_mem, norm_final,
              rw_mix, rw_wr, rw_wk, rw_wv, rw_w0, rw_w1, rw_w2, rw_a0, rw_a1, rw_a2,
              rw_g1, rw_g2, rw_kk, rw_ka, rw_rk, rw_lnx_w, rw_lnx_b, rw_wo,
              sb_wqkv, sb_wo, xa_wq, xa_wkv, xa_wo,
              moe_wg, moe_bg, moe_we, moe_be, moe_w1, moe_w3, moe_w2):
    B = mem.shape[0]
    mem_kv = (_rms_norm(mem, norm_mem) @ xa_wkv).reshape(B, N_MEM, 2, X_HEADS, X_HEAD_DIM)
    mem_k = mem_kv[:, :, 0]
    mem_v = mem_kv[:, :, 1]
    h = x
    for i in range(DEPTH):
        hn = _rms_norm(h, norm_mix[i])
        j = i // 2
        if i % 2 == 0:
            h = h + _rwkv7_time_mix(hn, rw_mix[j], rw_wr[j], rw_wk[j], rw_wv[j],
                                    rw_w0[j], rw_w1[j], rw_w2[j], rw_a0[j], rw_a1[j], rw_a2[j],
                                    rw_g1[j], rw_g2[j], rw_kk[j], rw_ka[j], rw_rk[j],
                                    rw_lnx_w[j], rw_lnx_b[j], rw_wo[j])
        else:
            h = h + _stick_breaking_attention(hn, sb_wqkv[j], sb_wo[j])
        h = h + _memory_cross_attention(_rms_norm(h, norm_cross[i]), mem_k, mem_v,
                                        xa_wq[i], xa_wo[i])
        h = h + _hierarchical_moe(_rms_norm(h, norm_ffn[i]), moe_wg[i], moe_bg[i],
                                  moe_we[i], moe_be[i], moe_w1[i], moe_w3[i], moe_w2[i])
    return _rms_norm(h, norm_final)
```

```cpp
#include <hip/hip_runtime.h>
#include <cstdio>
#include <cstdint>
#include <cstddef>

#ifndef MK_MULTI
#define MK_MULTI 0
#endif

#define GAS __attribute__((address_space(1)))
#define LAS __attribute__((address_space(3)))
typedef unsigned short bf16_t;
typedef short bf16x8 __attribute__((ext_vector_type(8)));
typedef float f32x4 __attribute__((ext_vector_type(4)));
typedef float f32x2 __attribute__((ext_vector_type(2)));
typedef unsigned u32x4 __attribute__((ext_vector_type(4)));
typedef unsigned u32x2 __attribute__((ext_vector_type(2)));

constexpr int BATCH = 32, SEQ = 2048, DM = 1024, T = BATCH * SEQ;
constexpr int NH = 16, HD = 64;
constexpr int NMEM = 256, XH = 4, XD = 256;
constexpr int NG = 4, NEG = 8, NE = 32, DF = 256;
constexpr int NGRP = 2;
constexpr int TG = T / NGRP, BG = BATCH / NGRP;
constexpr float NORM_EPS = 1e-6f, GN_EPS = 64e-5f;
constexpr int STAB_OFF = 256 * 1024;
constexpr int NB = 2 * NE;
constexpr int MAXSLOT = 2 * T + NB * 256;

namespace pg8 {
constexpr int BM = 256, BK = 64, HALF = 128, HTB = HALF * BK * 2, STAGE_BYTES = 8 * HTB, NXCD = 8, WGM = 8;
__host__ __device__ __forceinline__ int lds_byte(int r, int c) { const int st = (r >> 4) * 2 + (c >> 5), rr = r & 15, cc = c & 31, ob = rr * 64 + cc * 2; return st * 1024 + (ob ^ (((ob >> 9) & 1) << 5)); }
__host__ __device__ __forceinline__ void stage_rc(int b, int& R, int& C) { const int st = b / 1024, sb = b % 1024, swz = sb ^ (((sb >> 9) & 1) << 5); R = (st >> 1) * 16 + swz / 64; C = (st & 1) * 32 + (swz % 64) / 2; }
__host__ __device__ __forceinline__ int perm32(int rho) { const int n = rho >> 4, i = rho & 15; return 8 * (i >> 2) + 4 * n + (i & 3); }

struct Unit { int pm, pn; long offA, offB; };
struct Gemm { const bf16_t* A; const bf16_t* Bt; int lda, ldb, K; };

__device__ __forceinline__ unsigned cvt_pk_bf16(float lo, float hi) { unsigned r; asm volatile("v_cvt_pk_bf16_f32 %0, %1, %2" : "=v"(r) : "v"(lo), "v"(hi)); return r; }

struct OrderMN {
    int nM, nN, nwg, G, c; long sA, sB;
    __device__ void init(int M, int N, int lda, int ldb, int G_, int c_) { nM = M / BM; nN = N / BM; nwg = nM * nN; G = G_; c = c_; sA = (long)BM * lda * 2; sB = (long)BM * ldb * 2; }
    __device__ __forceinline__ bool next(int i, Unit& u) const {
        const long L = (long)i * G + c; if (L >= nwg) return false;
        int wgid = (int)L; { const int q = nwg / NXCD, r = nwg % NXCD, xcd = wgid % NXCD, off = wgid / NXCD; wgid = (xcd < r ? xcd * (q + 1) : r * (q + 1) + (xcd - r) * q) + off; }
        const int nig = WGM * nN, gid = wgid / nig, fm = gid * WGM, gsz = (nM - fm) < WGM ? (nM - fm) : WGM;
        u.pm = fm + ((wgid % nig) % gsz); u.pn = (wgid % nig) / gsz; u.offA = u.pm * sA; u.offB = u.pn * sB; return true;
    }
};

struct OrderLora2 : OrderMN {
    __device__ __forceinline__ bool next(int i, Unit& u) const { if (!OrderMN::next(i, u)) return false; if (u.pn >= 8) { u.offA += 256; u.offB += 256; } return true; }
};
struct OrderRKV : OrderMN {
    long aStep;
    __device__ __forceinline__ bool next(int i, Unit& u) const { if (!OrderMN::next(i, u)) return false; u.offA += (long)(u.pn >> 2) * aStep; return true; }
};
__device__ __forceinline__ float xadd16(float x) { const unsigned u = __float_as_uint(x); const auto r = __builtin_amdgcn_permlane16_swap(u, u, false, false); return __uint_as_float(r[0]) + __uint_as_float(r[1]); }
__device__ __forceinline__ float xadd32(float x) { const unsigned u = __float_as_uint(x); const auto r = __builtin_amdgcn_permlane32_swap(u, u, false, false); return __uint_as_float(r[0]) + __uint_as_float(r[1]); }
__device__ __forceinline__ float xmax16(float x) { const unsigned u = __float_as_uint(x); const auto r = __builtin_amdgcn_permlane16_swap(u, u, false, false); return fmaxf(__uint_as_float(r[0]), __uint_as_float(r[1])); }
__device__ __forceinline__ float xmax32(float x) { const unsigned u = __float_as_uint(x); const auto r = __builtin_amdgcn_permlane32_swap(u, u, false, false); return fmaxf(__uint_as_float(r[0]), __uint_as_float(r[1])); }
__device__ __forceinline__ float rstd16(const float* ssq, int row) { const f32x4* p = (const f32x4*)(ssq + (size_t)row * 16); const f32x4 a = p[0], b = p[1], c = p[2], d = p[3];
    const f32x4 s = (a + b) + (c + d); return rsqrtf(((s[0] + s[1]) + (s[2] + s[3])) * (1.f / 1024.f) + 1e-6f); }
__device__ __forceinline__ float rstd16q(const float* ssq, int row, int fq) { const f32x4 a = *(const f32x4*)(ssq + (size_t)row * 16 + 4 * fq);
    return rsqrtf(xadd32(xadd16((a[0] + a[1]) + (a[2] + a[3]))) * (1.f / 1024.f) + 1e-6f); }
struct EpiBf16 {
    static constexpr bool PERM = true;
    static constexpr bool HAS_PRE = false;
    bf16_t* O; int ldc; int split_cols; size_t split_stride; float scale0; const float* ssq;
    __device__ __forceinline__ void operator()(const f32x4 (&acc)[2][2][4][2], const Unit& u, int wr, int wc, int fr, int fq) const {
        const int row0 = u.pm * BM + wr * 64 + fr; int colt = u.pn * BM; bf16_t* base = O;
        float sc0 = scale0; if (split_cols) { const int t = colt / split_cols; base += (size_t)t * split_stride; colt -= t * split_cols; if (t != 0) sc0 = 1.f; }
        const int col0 = colt + wc * 32 + 8 * fq;
#pragma unroll
        for (int ai = 0; ai < 2; ++ai)
#pragma unroll
            for (int m = 0; m < 4; ++m) { const int row = row0 + ai * HALF + m * 16; bf16_t* rowp = base + (size_t)row * ldc + col0;
                const float sc = ssq ? sc0 * rstd16q(ssq, row, fq) : sc0;
#pragma unroll
                for (int bj = 0; bj < 2; ++bj) { const f32x4 v0 = acc[ai][bj][m][0] * sc, v1 = acc[ai][bj][m][1] * sc;
                    u32x4 w; w.x = cvt_pk_bf16(v0[0], v0[1]); w.y = cvt_pk_bf16(v0[2], v0[3]); w.z = cvt_pk_bf16(v1[0], v1[1]); w.w = cvt_pk_bf16(v1[2], v1[3]);
                    *(u32x4*)(rowp + bj * HALF) = w; } }
    }
};
__device__ __forceinline__ float sigmoidf_(float x) { return __builtin_amdgcn_rcpf(1.f + __expf(-x)); }
struct EpiSoftmax {
    static constexpr bool PERM = true;
    static constexpr bool HAS_PRE = false;
    bf16_t* O; int ldc; float scale; LAS float* sm; const float* ssq;
    __device__ __forceinline__ void operator()(f32x4 (&acc)[2][2][4][2], const Unit& u, int wr, int wc, int fr, int fq) const {
        const int rl0 = wr * 64 + fr;
#pragma unroll
        for (int ai = 0; ai < 2; ++ai)
#pragma unroll
            for (int m = 0; m < 4; ++m) { float mx = -3.0e38f; const float sc = ssq ? scale * rstd16q(ssq, u.pm * BM + rl0 + ai * HALF + m * 16, fq) : scale;
#pragma unroll
                for (int bj = 0; bj < 2; ++bj)
#pragma unroll
                    for (int n = 0; n < 2; ++n) { acc[ai][bj][m][n] = acc[ai][bj][m][n] * sc; const f32x4 v = acc[ai][bj][m][n]; mx = fmaxf(mx, fmaxf(fmaxf(v[0], v[1]), fmaxf(v[2], v[3]))); }
                mx = xmax32(xmax16(mx));
                if (fq == 0) sm[(rl0 + ai * HALF + m * 16) * 4 + wc] = mx; }
        asm volatile("s_waitcnt lgkmcnt(0)" ::: "memory"); __builtin_amdgcn_s_barrier(); asm volatile("" ::: "memory");
#pragma unroll
        for (int ai = 0; ai < 2; ++ai)
#pragma unroll
            for (int m = 0; m < 4; ++m) { const int rl = rl0 + ai * HALF + m * 16; const f32x4 q = *(const LAS f32x4*)(sm + rl * 4); const float M = fmaxf(fmaxf(q[0], q[1]), fmaxf(q[2], q[3])); float sum = 0.f;
#pragma unroll
                for (int bj = 0; bj < 2; ++bj)
#pragma unroll
                    for (int n = 0; n < 2; ++n) { f32x4 v = acc[ai][bj][m][n]; v[0] = __expf(v[0] - M); v[1] = __expf(v[1] - M); v[2] = __expf(v[2] - M); v[3] = __expf(v[3] - M); acc[ai][bj][m][n] = v; sum += (v[0] + v[1]) + (v[2] + v[3]); }
                sum = xadd32(xadd16(sum));
                if (fq == 0) sm[1024 + rl * 4 + wc] = sum; }
        asm volatile("s_waitcnt lgkmcnt(0)" ::: "memory"); __builtin_amdgcn_s_barrier(); asm volatile("" ::: "memory");
        const int row0 = u.pm * BM + rl0, col0 = u.pn * BM + wc * 32 + 8 * fq;
#pragma unroll
        for (int ai = 0; ai < 2; ++ai)
#pragma unroll
            for (int m = 0; m < 4; ++m) { const int rl = rl0 + ai * HALF + m * 16; const f32x4 q = *(const LAS f32x4*)(sm + 1024 + rl * 4); const float inv = __builtin_amdgcn_rcpf((q[0] + q[1]) + (q[2] + q[3]));
                bf16_t* rowp = O + (size_t)(row0 + ai * HALF + m * 16) * ldc + col0;
#pragma unroll
                for (int bj = 0; bj < 2; ++bj) { const f32x4 v0 = acc[ai][bj][m][0] * inv, v1 = acc[ai][bj][m][1] * inv;
                    u32x4 w; w.x = cvt_pk_bf16(v0[0], v0[1]); w.y = cvt_pk_bf16(v0[2], v0[3]); w.z = cvt_pk_bf16(v1[0], v1[1]); w.w = cvt_pk_bf16(v1[2], v1[3]);
                    *(u32x4*)(rowp + bj * HALF) = w; } }
    }
};
struct EpiLora {
    static constexpr bool PERM = true;
    static constexpr bool HAS_PRE = false;
    bf16_t* O; size_t stride; const float* w0; const float* a0;
    __device__ __forceinline__ void operator()(const f32x4 (&acc)[2][2][4][2], const Unit& u, int wr, int wc, int fr, int fq) const {
        const int row0 = u.pm * BM + wr * 64 + fr; int colt = u.pn * BM; const int t = colt / 1024; colt -= t * 1024; bf16_t* base = O + (size_t)t * stride;
        const int col0 = colt + wc * 32 + 8 * fq; const float* bias = (t == 0) ? w0 : a0;
        f32x4 bv[2][2];
#pragma unroll
        for (int bj = 0; bj < 2; ++bj)
#pragma unroll
            for (int n = 0; n < 2; ++n) bv[bj][n] = (t < 2) ? *(const f32x4*)(bias + col0 + bj * HALF + 4 * n) : (f32x4){0.f, 0.f, 0.f, 0.f};
#pragma unroll
        for (int ai = 0; ai < 2; ++ai)
#pragma unroll
            for (int m = 0; m < 4; ++m) { bf16_t* rowp = base + (size_t)(row0 + ai * HALF + m * 16) * 1024 + col0;
#pragma unroll
                for (int bj = 0; bj < 2; ++bj) { f32x4 v0 = acc[ai][bj][m][0] + bv[bj][0], v1 = acc[ai][bj][m][1] + bv[bj][1];
                    if (t < 2) { const float s = (t == 0) ? -0.6065306597f : 1.f;
#pragma unroll
                        for (int e = 0; e < 4; ++e) { v0[e] = s * sigmoidf_(v0[e]); v1[e] = s * sigmoidf_(v1[e]); } }
                    u32x4 w; w.x = cvt_pk_bf16(v0[0], v0[1]); w.y = cvt_pk_bf16(v0[2], v0[3]); w.z = cvt_pk_bf16(v1[0], v1[1]); w.w = cvt_pk_bf16(v1[2], v1[3]);
                    *(u32x4*)(rowp + bj * HALF) = w; } }
    }
};
struct EpiResB {
    static constexpr bool PERM = true;
    static constexpr bool HAS_PRE = false;
    const float* basef; bf16_t* hb; int ldc; float* ssq;
    __device__ __forceinline__ void operator()(const f32x4 (&acc)[2][2][4][2], const Unit& u, int wr, int wc, int fr, int fq) const {
        const int row0 = u.pm * BM + wr * 64 + fr, col0 = u.pn * BM + wc * 32 + 8 * fq;
#pragma unroll
        for (int ai = 0; ai < 2; ++ai)
#pragma unroll
            for (int m = 0; m < 4; ++m) { const int row = row0 + ai * HALF + m * 16; const size_t off = (size_t)row * ldc + col0; float sq = 0.f;
#pragma unroll
                for (int bj = 0; bj < 2; ++bj) { f32x4 b0, b1;
                    if (basef) { b0 = *(const f32x4*)(basef + off + bj * HALF); b1 = *(const f32x4*)(basef + off + bj * HALF + 4); }
                    else { const u32x4 w = *(const u32x4*)(hb + off + bj * HALF);
                        b0 = (f32x4){__uint_as_float(w.x << 16), __uint_as_float(w.x & 0xffff0000u), __uint_as_float(w.y << 16), __uint_as_float(w.y & 0xffff0000u)};
                        b1 = (f32x4){__uint_as_float(w.z << 16), __uint_as_float(w.z & 0xffff0000u), __uint_as_float(w.w << 16), __uint_as_float(w.w & 0xffff0000u)}; }
                    const f32x4 o0 = b0 + acc[ai][bj][m][0], o1 = b1 + acc[ai][bj][m][1];
                    u32x4 w; w.x = cvt_pk_bf16(o0[0], o0[1]); w.y = cvt_pk_bf16(o0[2], o0[3]); w.z = cvt_pk_bf16(o1[0], o1[1]); w.w = cvt_pk_bf16(o1[2], o1[3]);
                    *(u32x4*)(hb + off + bj * HALF) = w;
                    sq += ((o0[0] * o0[0] + o0[1] * o0[1]) + (o0[2] * o0[2] + o0[3] * o0[3])) + ((o1[0] * o1[0] + o1[1] * o1[1]) + (o1[2] * o1[2] + o1[3] * o1[3])); }
                sq = xadd32(xadd16(sq)); if (fq == 0) ssq[(size_t)row * 16 + u.pn * 4 + wc] = sq; }
    }
};
struct EpiScatter {
    static constexpr bool PERM = true;
    static constexpr bool HAS_PRE = true;
    bf16_t* hb; const int* stab; float* ssq; LAS int* tab;
    __device__ __forceinline__ void prefetch(const Unit& u, int wid) const {
        if (wid < 4) { int l; asm volatile("v_mbcnt_lo_u32_b32 %0, -1, 0\n\tv_mbcnt_hi_u32_b32 %0, -1, %0" : "=v"(l));
            __builtin_amdgcn_global_load_lds((const unsigned*)(stab + u.pm * BM + wid * 64 + l), (LAS unsigned*)(tab + wid * 64), 4, 0, 0); }
    }
    __device__ __forceinline__ void operator()(const f32x4 (&acc)[2][2][4][2], const Unit& u, int wr, int wc, int fr, int fq) const {
        const int col0 = u.pn * BM + wc * 32 + 8 * fq;
        int tk[2][4];
        asm volatile("ds_read_b32 %0, %8\n\tds_read_b32 %1, %8 offset:64\n\tds_read_b32 %2, %8 offset:128\n\tds_read_b32 %3, %8 offset:192\n\tds_read_b32 %4, %8 offset:512\n\tds_read_b32 %5, %8 offset:576\n\t"
                     "ds_read_b32 %6, %8 offset:640\n\tds_read_b32 %7, %8 offset:704\n\ts_waitcnt lgkmcnt(0)"
                     : "=&v"(tk[0][0]), "=&v"(tk[0][1]), "=&v"(tk[0][2]), "=&v"(tk[0][3]), "=&v"(tk[1][0]), "=&v"(tk[1][1]), "=&v"(tk[1][2]), "=&v"(tk[1][3]) : "v"((unsigned)(size_t)tab + (unsigned)(wr * 64 + fr) * 4u) : "memory");
#pragma unroll
        for (int ai = 0; ai < 2; ++ai)
#pragma unroll
            for (int m = 0; m < 4; ++m) { const int tok = tk[ai][m]; float sq = 0.f;
                if (tok >= 0) { const size_t off = (size_t)tok * DM + col0;
#pragma unroll
                    for (int bj = 0; bj < 2; ++bj) { const u32x4 w0 = *(const u32x4*)(hb + off + bj * HALF);
                        const f32x4 b0 = (f32x4){__uint_as_float(w0.x << 16), __uint_as_float(w0.x & 0xffff0000u), __uint_as_float(w0.y << 16), __uint_as_float(w0.y & 0xffff0000u)};
                        const f32x4 b1 = (f32x4){__uint_as_float(w0.z << 16), __uint_as_float(w0.z & 0xffff0000u), __uint_as_float(w0.w << 16), __uint_as_float(w0.w & 0xffff0000u)};
                        const f32x4 o0 = b0 + acc[ai][bj][m][0], o1 = b1 + acc[ai][bj][m][1];
                        u32x4 w; w.x = cvt_pk_bf16(o0[0], o0[1]); w.y = cvt_pk_bf16(o0[2], o0[3]); w.z = cvt_pk_bf16(o1[0], o1[1]); w.w = cvt_pk_bf16(o1[2], o1[3]);
                        *(u32x4*)(hb + off + bj * HALF) = w;
                        sq += ((o0[0] * o0[0] + o0[1] * o0[1]) + (o0[2] * o0[2] + o0[3] * o0[3])) + ((o1[0] * o1[0] + o1[1] * o1[1]) + (o1[2] * o1[2] + o1[3] * o1[3])); } }
                if (ssq) { sq = xadd32(xadd16(sq)); if (fq == 0 && tok >= 0) ssq[(size_t)tok * 16 + u.pn * 4 + wc] = sq; } }
    }
};
struct EpiRoute {
    static constexpr bool PERM = false;
    static constexpr bool HAS_PRE = false;
    float* out; const float* ssq;
    __device__ __forceinline__ void operator()(const f32x4 (&acc)[2][2][4][2], const Unit& u, int wr, int wc, int fr, int fq) const {
        if (wc >= 2) return;
        const int row0 = u.pm * BM + wr * 64 + fr, col0 = wc * 32 + 4 * fq;
#pragma unroll
        for (int ai = 0; ai < 2; ++ai)
#pragma unroll
            for (int m = 0; m < 4; ++m) { const int row = row0 + ai * HALF + m * 16; float* rowp = out + (size_t)row * 64 + col0; const float rs = rstd16q(ssq, row, fq);
#pragma unroll
                for (int n = 0; n < 2; ++n) *(f32x4*)(rowp + n * 16) = acc[ai][0][m][n] * rs; }
    }
};
struct EpiSwiGLU {
    static constexpr bool PERM = true;
    static constexpr bool HAS_PRE = false;
    bf16_t* hid; const float* gate;
    __device__ __forceinline__ void operator()(const f32x4 (&acc)[2][2][4][2], const Unit& u, int wr, int wc, int fr, int fq) const {
        const int row0 = u.pm * BM + wr * 64 + fr, col0 = u.pn * 128 + wc * 32 + 8 * fq;
#pragma unroll
        for (int ai = 0; ai < 2; ++ai)
#pragma unroll
            for (int m = 0; m < 4; ++m) { const int row = row0 + ai * HALF + m * 16; const f32x2 gr = *(const f32x2*)(gate + 2 * (size_t)row); const float rs = gr.x, g = gr.y;
                f32x4 h0, h1;
#pragma unroll
                for (int e = 0; e < 4; ++e) { const float a0 = acc[ai][0][m][0][e] * rs, a1 = acc[ai][0][m][1][e] * rs;
                    h0[e] = a0 * sigmoidf_(a0) * acc[ai][1][m][0][e] * g; h1[e] = a1 * sigmoidf_(a1) * acc[ai][1][m][1][e] * g; }
                u32x4 w; w.x = cvt_pk_bf16(h0[0], h0[1]); w.y = cvt_pk_bf16(h0[2], h0[3]); w.z = cvt_pk_bf16(h1[0], h1[1]); w.w = cvt_pk_bf16(h1[2], h1[3]);
                *(u32x4*)(hid + (size_t)row * 256 + col0) = w; }
    }
};

template <class Epi, class Sched, bool ALIGN_EPI>
__device__ __forceinline__ void gemm_phase(LAS unsigned char* lds, const int wid, const Gemm g, const Sched& S, const Epi& E) {
    int lane; asm volatile("v_mbcnt_lo_u32_b32 %0, -1, 0\n\tv_mbcnt_hi_u32_b32 %0, -1, %0" : "=v"(lane));
    const int tid = wid * 64 + lane, wr = wid >> 2, wc = wid & 3, fr = lane & 15, fq = lane >> 4;
    const int K = g.K, nt = K / BK;
    unsigned voffA[2], voffB[2];
#pragma unroll
    for (int i = 0; i < 2; ++i) { int R, C; stage_rc(tid * 16 + i * 8192, R, C); const int Rb = Epi::PERM ? ((R & ~31) + perm32(R & 31)) : R;
        voffA[i] = (unsigned)(R * g.lda + C) * 2u; voffB[i] = (unsigned)(Rb * g.ldb + C) * 2u; }
    const size_t kstep = (size_t)(BK * 2);
    const size_t hstepA = (size_t)HALF * g.lda * 2, hstepB = (size_t)HALF * g.ldb * 2;
    const unsigned ldsw = (unsigned)wid * 1024u;
    const int aoff = lds_byte(wr * 64 + fr, fq * 8), boff = lds_byte(wc * 32 + fr, fq * 8);
#define PG8_SA(b, h) (((b) * 2 + (h)) * HTB)
#define PG8_SB(b, h) ((4 + (b) * 2 + (h)) * HTB)
#define PG8_STAGE(bufoff, gbase, voff) do { _Pragma("unroll") for (int _i = 0; _i < 2; ++_i) \
        __builtin_amdgcn_global_load_lds((const unsigned*)((const char*)(gbase) + (voff)[_i]), (LAS unsigned*)(lds + (bufoff) + ldsw + _i * 8192), 16, 0, 0); } while (0)
#define PG8_LDA(dst, b, h) do { _Pragma("unroll") for (int m = 0; m < 4; ++m) _Pragma("unroll") for (int k = 0; k < 2; ++k) dst[m][k] = *(const LAS bf16x8*)(lds + PG8_SA(b, h) + aoff + m * 2048 + k * 1024); } while (0)
#define PG8_LDB(dst, b, h) do { _Pragma("unroll") for (int n = 0; n < 2; ++n) _Pragma("unroll") for (int k = 0; k < 2; ++k) dst[n][k] = *(const LAS bf16x8*)(lds + PG8_SB(b, h) + boff + n * 2048 + k * 1024); } while (0)
#define PG8_MMA(ai, bj, At, Bt) do { __builtin_amdgcn_s_setprio(1); _Pragma("unroll") for (int m = 0; m < 4; ++m) _Pragma("unroll") for (int n = 0; n < 2; ++n) _Pragma("unroll") for (int k = 0; k < 2; ++k) \
        acc[ai][bj][m][n] = __builtin_amdgcn_mfma_f32_16x16x32_bf16(Bt[n][k], At[m][k], acc[ai][bj][m][n], 0, 0, 0); __builtin_amdgcn_s_setprio(0); } while (0)
#define PG8_WAIT_V(n) asm volatile("s_waitcnt vmcnt(" #n ")" ::: "memory")
#define PG8_WAIT_L(n) asm volatile("s_waitcnt lgkmcnt(" #n ")" ::: "memory")
#define PG8_BAR __builtin_amdgcn_s_barrier()
#define PG8_SCHED __builtin_amdgcn_sched_barrier(0)
    Unit cur, nxt; int ui = 0;
    if (!S.next(0, cur)) return;
    f32x4 acc[2][2][4][2];
#pragma unroll
    for (int a = 0; a < 2; ++a)
#pragma unroll
        for (int b = 0; b < 2; ++b)
#pragma unroll
            for (int m = 0; m < 4; ++m)
#pragma unroll
                for (int n = 0; n < 2; ++n) acc[a][b][m][n] = (f32x4){0.f, 0.f, 0.f, 0.f};
    bf16x8 At[4][2], B0[2][2], B1[2][2];
    const char* cA = (const char*)g.A + cur.offA; const char* cB = (const char*)g.Bt + cur.offB;
    PG8_STAGE(PG8_SB(0, 0), cB, voffB); PG8_STAGE(PG8_SB(0, 1), cB + hstepB, voffB); PG8_STAGE(PG8_SA(0, 0), cA, voffA); PG8_STAGE(PG8_SA(0, 1), cA + hstepA, voffA);
    if (wr == 1) PG8_BAR;
    PG8_WAIT_V(2); PG8_BAR;
    PG8_STAGE(PG8_SB(1, 0), cB + kstep, voffB); PG8_STAGE(PG8_SA(1, 0), cA + kstep, voffA); PG8_STAGE(PG8_SB(1, 1), cB + hstepB + kstep, voffB);
    PG8_WAIT_V(6); PG8_BAR;
    for (;;) {
        const bool has_next = S.next(ui + 1, nxt);
        const char* nA = has_next ? (const char*)g.A + nxt.offA : cA; const char* nB = has_next ? (const char*)g.Bt + nxt.offB : cB;
        if constexpr (Epi::HAS_PRE) E.prefetch(cur, wid);
        for (int t = 0; t < nt; t += 2) {
            const bool last = (t == nt - 2);
            const char* a1 = cA + (size_t)(t + 1) * kstep;
            const char* a2 = last ? nA : cA + (size_t)(t + 2) * kstep; const char* b2 = last ? nB : cB + (size_t)(t + 2) * kstep;
            const char* a3 = a2 + kstep; const char* b3 = b2 + kstep;
            PG8_LDB(B0, 0, 0); PG8_LDB(B1, 0, 1); PG8_SCHED; PG8_LDA(At, 0, 0); PG8_STAGE(PG8_SA(1, 1), a1 + hstepA, voffA);
            PG8_WAIT_V(8); PG8_WAIT_L(0); PG8_BAR; PG8_MMA(0, 0, At, B0); PG8_MMA(0, 1, At, B1); PG8_BAR; PG8_SCHED;
            PG8_LDA(At, 0, 1); PG8_STAGE(PG8_SB(0, 0), b2, voffB); PG8_STAGE(PG8_SB(0, 1), b2 + hstepB, voffB); PG8_STAGE(PG8_SA(0, 0), a2, voffA);
            PG8_WAIT_V(8); PG8_WAIT_L(0); PG8_BAR; PG8_MMA(1, 0, At, B0); PG8_MMA(1, 1, At, B1); PG8_BAR; PG8_SCHED;
            PG8_LDB(B0, 1, 0); PG8_LDB(B1, 1, 1); PG8_SCHED; PG8_LDA(At, 1, 0); PG8_STAGE(PG8_SA(0, 1), a2 + hstepA, voffA);
            PG8_WAIT_V(8); PG8_WAIT_L(0); PG8_BAR; PG8_MMA(0, 0, At, B0); PG8_MMA(0, 1, At, B1); PG8_BAR; PG8_SCHED;
            PG8_LDA(At, 1, 1); PG8_STAGE(PG8_SB(1, 0), b3, voffB); PG8_STAGE(PG8_SB(1, 1), b3 + hstepB, voffB); PG8_STAGE(PG8_SA(1, 0), a3, voffA);
            PG8_WAIT_V(8); PG8_WAIT_L(0); PG8_BAR; PG8_MMA(1, 0, At, B0); PG8_MMA(1, 1, At, B1); PG8_BAR; PG8_SCHED;
        }
        if constexpr (ALIGN_EPI) { if (wr == 0) PG8_BAR; }
        { int l2; asm volatile("v_mbcnt_lo_u32_b32 %0, -1, 0\n\tv_mbcnt_hi_u32_b32 %0, -1, %0" : "=v"(l2)); E(acc, cur, wr, wc, l2 & 15, l2 >> 4); }
        if (!has_next) break;
#pragma unroll
        for (int a = 0; a < 2; ++a)
#pragma unroll
            for (int b = 0; b < 2; ++b)
#pragma unroll
                for (int m = 0; m < 4; ++m)
#pragma unroll
                    for (int n = 0; n < 2; ++n) acc[a][b][m][n] = (f32x4){0.f, 0.f, 0.f, 0.f};
        cur = nxt; cA = nA; cB = nB; ++ui;
        if constexpr (ALIGN_EPI) { if (wr == 1) PG8_BAR; }
    }
    PG8_WAIT_V(0);
    if constexpr (!ALIGN_EPI) { if (wr == 0) PG8_BAR; }
    PG8_BAR;
#undef PG8_SA
#undef PG8_SB
#undef PG8_STAGE
#undef PG8_LDA
#undef PG8_LDB
#undef PG8_MMA
#undef PG8_WAIT_V
#undef PG8_WAIT_L
#undef PG8_BAR
#undef PG8_SCHED
}
template <class Epi, class Sched, bool ALIGN_EPI>
__device__ __forceinline__ void gemm_phase_g(LAS unsigned char* lds, const int wid, const Gemm g, const Sched& S, const Epi& E, const int* rowtab, LAS unsigned* gtab) {
    int lane; asm volatile("v_mbcnt_lo_u32_b32 %0, -1, 0\n\tv_mbcnt_hi_u32_b32 %0, -1, %0" : "=v"(lane));
    const int tid = wid * 64 + lane, wr = wid >> 2, wc = wid & 3, fr = lane & 15, fq = lane >> 4;
    const int K = g.K, nt = K / BK;
    unsigned voffA[2], voffB[2];
#pragma unroll
    for (int i = 0; i < 2; ++i) { int R, C; stage_rc(tid * 16 + i * 8192, R, C); const int Rb = Epi::PERM ? ((R & ~31) + perm32(R & 31)) : R;
        voffA[i] = (unsigned)R | ((unsigned)(C * 2) << 16); voffB[i] = (unsigned)(Rb * g.ldb + C) * 2u; }
    const size_t kstep = (size_t)(BK * 2);
    const size_t hstepA = (size_t)HALF * g.lda * 2, hstepB = (size_t)HALF * g.ldb * 2;
    const unsigned ldsw = (unsigned)wid * 1024u;
    const int aoff = lds_byte(wr * 64 + fr, fq * 8), boff = lds_byte(wc * 32 + fr, fq * 8);
#define PG8_SA(b, h) (((b) * 2 + (h)) * HTB)
#define PG8_SB(b, h) ((4 + (b) * 2 + (h)) * HTB)
#define PG8_STAGE(bufoff, gbase, voff) do { _Pragma("unroll") for (int _i = 0; _i < 2; ++_i) \
        __builtin_amdgcn_global_load_lds((const unsigned*)((const char*)(gbase) + (voff)[_i]), (LAS unsigned*)(lds + (bufoff) + ldsw + _i * 8192), 16, 0, 0); } while (0)
#define PG8_LDA(dst, b, h) do { _Pragma("unroll") for (int m = 0; m < 4; ++m) _Pragma("unroll") for (int k = 0; k < 2; ++k) dst[m][k] = *(const LAS bf16x8*)(lds + PG8_SA(b, h) + aoff + m * 2048 + k * 1024); } while (0)
#define PG8_LDB(dst, b, h) do { _Pragma("unroll") for (int n = 0; n < 2; ++n) _Pragma("unroll") for (int k = 0; k < 2; ++k) dst[n][k] = *(const LAS bf16x8*)(lds + PG8_SB(b, h) + boff + n * 2048 + k * 1024); } while (0)
#define PG8_MMA(ai, bj, At, Bt) do { __builtin_amdgcn_s_setprio(1); _Pragma("unroll") for (int m = 0; m < 4; ++m) _Pragma("unroll") for (int n = 0; n < 2; ++n) _Pragma("unroll") for (int k = 0; k < 2; ++k) \
        acc[ai][bj][m][n] = __builtin_amdgcn_mfma_f32_16x16x32_bf16(Bt[n][k], At[m][k], acc[ai][bj][m][n], 0, 0, 0); __builtin_amdgcn_s_setprio(0); } while (0)
#define PG8_STAGE_A(bufoff, gbase, half, tb) do { _Pragma("unroll") for (int _i = 0; _i < 2; ++_i) { const unsigned _o = gtab[(tb) * 256 + (half) * 128 + (voffA[_i] & 0xffffu)] + (voffA[_i] >> 16); \
        __builtin_amdgcn_global_load_lds((const unsigned*)((const char*)(gbase) + _o), (LAS unsigned*)(lds + (bufoff) + ldsw + _i * 8192), 16, 0, 0); } } while (0)
#define PG8_WAIT_V(n) asm volatile("s_waitcnt vmcnt(" #n ")" ::: "memory")
#define PG8_WAIT_L(n) asm volatile("s_waitcnt lgkmcnt(" #n ")" ::: "memory")
#define PG8_BAR __builtin_amdgcn_s_barrier()
#define PG8_SCHED __builtin_amdgcn_sched_barrier(0)
    Unit cur, nxt; int ui = 0;
    if (!S.next(0, cur)) return;
    f32x4 acc[2][2][4][2];
#pragma unroll
    for (int a = 0; a < 2; ++a)
#pragma unroll
        for (int b = 0; b < 2; ++b)
#pragma unroll
            for (int m = 0; m < 4; ++m)
#pragma unroll
                for (int n = 0; n < 2; ++n) acc[a][b][m][n] = (f32x4){0.f, 0.f, 0.f, 0.f};
    bf16x8 At[4][2], B0[2][2], B1[2][2];
    const char* cA = (const char*)g.A; const char* cB = (const char*)g.Bt + cur.offB;
    if (wid < 4) __builtin_amdgcn_global_load_lds((const unsigned*)(rowtab + cur.pm * 256 + tid), (LAS unsigned*)(gtab + wid * 64), 4, 0, 0);
    asm volatile("s_waitcnt vmcnt(0) lgkmcnt(0)" ::: "memory"); __builtin_amdgcn_s_barrier(); asm volatile("" ::: "memory");
    int cb = 0;
    PG8_STAGE(PG8_SB(0, 0), cB, voffB); PG8_STAGE(PG8_SB(0, 1), cB + hstepB, voffB); PG8_STAGE_A(PG8_SA(0, 0), cA, 0, cb); PG8_STAGE_A(PG8_SA(0, 1), cA, 1, cb);
    if (wr == 1) PG8_BAR;
    PG8_WAIT_V(2); PG8_BAR;
    PG8_STAGE(PG8_SB(1, 0), cB + kstep, voffB); PG8_STAGE_A(PG8_SA(1, 0), cA + kstep, 0, cb); PG8_STAGE(PG8_SB(1, 1), cB + hstepB + kstep, voffB);
    PG8_WAIT_V(6); PG8_BAR;
    for (;;) {
        const bool has_next = S.next(ui + 1, nxt);
        const char* nA = cA; const char* nB = has_next ? (const char*)g.Bt + nxt.offB : cB;
        if (has_next && wid < 4) __builtin_amdgcn_global_load_lds((const unsigned*)(rowtab + nxt.pm * 256 + tid), (LAS unsigned*)(gtab + (cb ^ 1) * 256 + wid * 64), 4, 0, 0);
        const int nbq = has_next ? (cb ^ 1) : cb;
        for (int t = 0; t < nt; t += 2) {
            const bool last = (t == nt - 2);
            const char* a1 = cA + (size_t)(t + 1) * kstep; const int tb2 = last ? nbq : cb;
            const char* a2 = last ? nA : cA + (size_t)(t + 2) * kstep; const char* b2 = last ? nB : cB + (size_t)(t + 2) * kstep;
            const char* a3 = a2 + kstep; const char* b3 = b2 + kstep;
            PG8_LDB(B0, 0, 0); PG8_LDB(B1, 0, 1); PG8_SCHED; PG8_LDA(At, 0, 0); PG8_STAGE_A(PG8_SA(1, 1), a1, 1, cb);
            PG8_WAIT_V(8); PG8_WAIT_L(0); PG8_BAR; PG8_MMA(0, 0, At, B0); PG8_MMA(0, 1, At, B1); PG8_BAR; PG8_SCHED;
            PG8_LDA(At, 0, 1); PG8_STAGE(PG8_SB(0, 0), b2, voffB); PG8_STAGE(PG8_SB(0, 1), b2 + hstepB, voffB); PG8_STAGE_A(PG8_SA(0, 0), a2, 0, tb2);
            PG8_WAIT_V(8); PG8_WAIT_L(0); PG8_BAR; PG8_MMA(1, 0, At, B0); PG8_MMA(1, 1, At, B1); PG8_BAR; PG8_SCHED;
            PG8_LDB(B0, 1, 0); PG8_LDB(B1, 1, 1); PG8_SCHED; PG8_LDA(At, 1, 0); PG8_STAGE_A(PG8_SA(0, 1), a2, 1, tb2);
            PG8_WAIT_V(8); PG8_WAIT_L(0); PG8_BAR; PG8_MMA(0, 0, At, B0); PG8_MMA(0, 1, At, B1); PG8_BAR; PG8_SCHED;
            PG8_LDA(At, 1, 1); PG8_STAGE(PG8_SB(1, 0), b3, voffB); PG8_STAGE(PG8_SB(1, 1), b3 + hstepB, voffB); PG8_STAGE_A(PG8_SA(1, 0), a3, 0, tb2);
            PG8_WAIT_V(8); PG8_WAIT_L(0); PG8_BAR; PG8_MMA(1, 0, At, B0); PG8_MMA(1, 1, At, B1); PG8_BAR; PG8_SCHED;
        }
        if constexpr (ALIGN_EPI) { if (wr == 0) PG8_BAR; }
        { int l2; asm volatile("v_mbcnt_lo_u32_b32 %0, -1, 0\n\tv_mbcnt_hi_u32_b32 %0, -1, %0" : "=v"(l2)); E(acc, cur, wr, wc, l2 & 15, l2 >> 4); }
        if (!has_next) break;
#pragma unroll
        for (int a = 0; a < 2; ++a)
#pragma unroll
            for (int b = 0; b < 2; ++b)
#pragma unroll
                for (int m = 0; m < 4; ++m)
#pragma unroll
                    for (int n = 0; n < 2; ++n) acc[a][b][m][n] = (f32x4){0.f, 0.f, 0.f, 0.f};
        cur = nxt; cA = nA; cB = nB; ++ui; cb ^= 1;
        if constexpr (ALIGN_EPI) { if (wr == 1) PG8_BAR; }
    }
    PG8_WAIT_V(0);
    if constexpr (!ALIGN_EPI) { if (wr == 0) PG8_BAR; }
    PG8_BAR;
#undef PG8_SA
#undef PG8_SB
#undef PG8_STAGE
#undef PG8_LDA
#undef PG8_LDB
#undef PG8_MMA
#undef PG8_STAGE_A
#undef PG8_WAIT_V
#undef PG8_WAIT_L
#undef PG8_BAR
#undef PG8_SCHED
}
}

constexpr size_t MiB = 1u << 20;
constexpr size_t WS_CTL = 0, CTL_ZERO_BYTES = 1 * MiB;
constexpr size_t WS_SSQ = 1 * MiB;
constexpr size_t WS_WR = 9 * MiB, WS_WK = 11 * MiB, WS_WV = 13 * MiB, WS_WO0 = 15 * MiB;
constexpr size_t WS_WPQ = 17 * MiB;
constexpr size_t WS_WL2 = 18 * MiB;
constexpr size_t WS_SBQKV = 20 * MiB, WS_SBWO = 26 * MiB;
constexpr size_t WS_XAWQ = 28 * MiB, WS_XAWO = 32 * MiB, WS_XAWKV = 36 * MiB;
constexpr size_t WS_ROUTE = 40 * MiB;
constexpr size_t WS_W13 = 41 * MiB;
constexpr size_t WS_W2 = 105 * MiB;
constexpr size_t WS_MEMN = 137 * MiB, WS_MEMK = 153 * MiB, WS_MEMVT = 169 * MiB;
constexpr size_t WS_HB = 185 * MiB;
constexpr size_t WS_ARENA = 313 * MiB;
constexpr size_t WS_LOGIT = WS_ARENA + 512 * MiB;
constexpr size_t WS_TOKE = WS_LOGIT + 16 * MiB, WS_TOKP = WS_TOKE + 512 * 1024, WS_TOKW = WS_TOKE + 1 * MiB, WS_TOKS = WS_TOKW + 512 * 1024;
constexpr size_t WS_ROWTAB = WS_TOKE + 4 * MiB;
constexpr size_t WS_GATE = WS_TOKE + 2 * MiB;
constexpr size_t BUF = (size_t)T * DM * 2;
constexpr size_t HBUF = BUF / NGRP;
constexpr size_t WS_BONUS = WS_ARENA + 11 * HBUF;
constexpr size_t WS_END = WS_BONUS + 2 * MiB;   static_assert(WS_ROWTAB + 1 * MiB <= WS_BONUS && WS_END <= 1024 * MiB && (size_t)TG * 16 * 4 <= 2 * MiB, "workspace");
static_assert((size_t)MAXSLOT * 8 <= 2 * MiB, "gate table");
constexpr int CW_BAR = 4096;
constexpr int CW_CNT = 16384;
constexpr int CW_STQ = 32768;

constexpr int RING_BYTES = 131072;
constexpr int LDSCTL_OFF = RING_BYTES;
constexpr int LDS_XB = LDSCTL_OFF;
constexpr int LDS_TOFF = LDSCTL_OFF + 3072;
constexpr int LDS_FLAGS = LDSCTL_OFF + 256;
constexpr int LDS_HIST = LDSCTL_OFF + 512;
constexpr int LDS_INP = LDSCTL_OFF + 1024;
constexpr int LDS_TEXP = LDSCTL_OFF + 2048;
constexpr int LDS_GTAB = LDSCTL_OFF + 12288;
constexpr int LDS_SM = LDSCTL_OFF + 4096;
constexpr int LDS_YB = LDSCTL_OFF + 4096;
constexpr int LDS_BYTES = 153600;

#define RLX_AGENT __ATOMIC_RELAXED, __HIP_MEMORY_SCOPE_AGENT

#define XB_TMO      128
#define XB_XCNT(j)  (256  + 64 * (j))
#define XB_XSUB(j)  (1280 + 64 * (j))
#define XB_XGEN(j)  (2304 + 64 * (j))
#define XB_TOP      3328
#define XB_TOPGEN   3392
#define XCD_BAR_WORDS 3456
#define XB_SPIN_CAP (1u << 18)
__device__ __forceinline__ unsigned xb_ld(unsigned* p)              { return __hip_atomic_load(p, __ATOMIC_RELAXED, __HIP_MEMORY_SCOPE_AGENT); }
__device__ __forceinline__ unsigned xb_add(unsigned* p, unsigned v) { return __hip_atomic_fetch_add(p, v, __ATOMIC_RELAXED, __HIP_MEMORY_SCOPE_AGENT); }
__device__ __forceinline__ unsigned xb_xcc_id() { return (unsigned)__builtin_amdgcn_s_getreg((3 << 11) | 20) & 0xFu; }
#define XB_SPIN(cond, bar) do { unsigned _sp = 0; while (cond) { __builtin_amdgcn_s_sleep(1); \
    if ((++_sp & 255u) == 0u) { if (xb_ld(&(bar)[XB_TMO])) break; if (_sp > XB_SPIN_CAP) { atomicAdd(&(bar)[XB_TMO], 1u); break; } } } } while (0)
struct XcdBarrier { unsigned* bar; unsigned x; volatile LAS unsigned* st; };
__device__ __forceinline__ XcdBarrier xcd_barrier_post(unsigned* bar, volatile LAS unsigned* st) {
    XcdBarrier b; b.bar = bar; b.x = xb_xcc_id(); b.st = st;
    if (threadIdx.x == 0) (void)xb_add(&bar[XB_XCNT(b.x)], 1u);
    return b;
}
__device__ __forceinline__ void xcd_barrier_complete(unsigned* bar, unsigned x, unsigned& nloc, unsigned& nx) {
    const unsigned G = gridDim.x * gridDim.y * gridDim.z;
    unsigned sum, cnt, mine, sp = 0u;
    for (;;) {
        sum = 0u; cnt = 0u; mine = 0u;
#pragma unroll
        for (unsigned j = 0; j < 16; ++j) { const unsigned c = xb_ld(&bar[XB_XCNT(j)]); sum += c; cnt += (c > 0u) ? 1u : 0u; mine = (j == x) ? c : mine; }
        if (sum == G) break;
        __builtin_amdgcn_s_sleep(1);
        if ((++sp & 255u) == 0u) { if (xb_ld(&bar[XB_TMO])) break; if (sp > XB_SPIN_CAP) { atomicAdd(&bar[XB_TMO], 1u); break; } }
    }
    nloc = mine > 0u ? mine : 1u; nx = cnt > 0u ? cnt : 1u;
}
__device__ __forceinline__ void xcd_barrier(const XcdBarrier& b) {
    asm volatile("s_waitcnt vmcnt(0)" ::: "memory");
    __syncthreads();
    if (threadIdx.x == 0) {
        unsigned* bar = b.bar;
        __builtin_amdgcn_s_waitcnt(0);
        unsigned nloc = b.st[0], nx = b.st[1];
        if (nloc == 0u) { xcd_barrier_complete(bar, b.x, nloc, nx); b.st[0] = nloc; b.st[1] = nx; }
        const unsigned old = xb_add(&bar[XB_XSUB(b.x)], 1u);
        const unsigned gen = old / nloc;
        if (old + 1u == (gen + 1u) * nloc) {
            __builtin_amdgcn_fence(__ATOMIC_RELEASE, "agent");
            asm volatile("s_waitcnt vmcnt(0)" ::: "memory");
            const unsigned og = xb_add(&bar[XB_TOP], 1u);
            const unsigned tg = og / nx;
            if (og + 1u == (tg + 1u) * nx) xb_add(&bar[XB_TOPGEN], 1u);
            else XB_SPIN(xb_ld(&bar[XB_TOPGEN]) == tg, bar);
            __builtin_amdgcn_fence(__ATOMIC_ACQUIRE, "agent");
            xb_add(&bar[XB_XGEN(b.x)], 1u);
            asm volatile("s_waitcnt vmcnt(0)" ::: "memory");
        } else {
            XB_SPIN(xb_ld(&bar[XB_XGEN(b.x)]) == gen, bar);
            __builtin_amdgcn_fence(__ATOMIC_ACQUIRE, "agent");
            asm volatile("s_waitcnt vmcnt(0)" ::: "memory");
        }
    }
    __syncthreads();
}

__device__ __forceinline__ unsigned f2bf(float f) { unsigned u = __builtin_bit_cast(unsigned, f); return (u + 0x7fffu + ((u >> 16) & 1u)) >> 16; }
__device__ __forceinline__ unsigned pk2(float lo, float hi) { return f2bf(lo) | (f2bf(hi) << 16); }
__device__ __forceinline__ float bflo(unsigned w) { return __uint_as_float(w << 16); }
__device__ __forceinline__ float bfhi(unsigned w) { return __uint_as_float(w & 0xffff0000u); }
__device__ __forceinline__ f32x4 unpack4(u32x2 w) { return (f32x4){bflo(w.x), bfhi(w.x), bflo(w.y), bfhi(w.y)}; }
__device__ __forceinline__ u32x2 pack4(f32x4 v) { u32x2 w; w.x = pk2(v[0], v[1]); w.y = pk2(v[2], v[3]); return w; }
template <int CTRL> __device__ __forceinline__ float dppf(float v) { return __uint_as_float((unsigned)__builtin_amdgcn_update_dpp(0, (int)__float_as_uint(v), CTRL, 0xF, 0xF, true)); }
__device__ __forceinline__ float sum4(float v) { v += dppf<0xB1>(v); v += dppf<0x4E>(v); return v; }
__device__ __forceinline__ float sum8(float v) { v = sum4(v); v += dppf<0x141>(v); return v; }
__device__ __forceinline__ float sum16(float v) { v = sum8(v); v += dppf<0x140>(v); return v; }
__device__ __forceinline__ float rdlane(float v, int l) { return __int_as_float(__builtin_amdgcn_readlane(__float_as_int(v), l)); }
__device__ __forceinline__ float wave_sum(float v) { v = sum16(v); return (rdlane(v, 0) + rdlane(v, 16)) + (rdlane(v, 32) + rdlane(v, 48)); }
__device__ __forceinline__ float wave_max(float v) { v = fmaxf(v, dppf<0xB1>(v)); v = fmaxf(v, dppf<0x4E>(v)); v = fmaxf(v, dppf<0x141>(v)); v = fmaxf(v, dppf<0x140>(v));
    return fmaxf(fmaxf(rdlane(v, 0), rdlane(v, 16)), fmaxf(rdlane(v, 32), rdlane(v, 48))); }
__device__ __forceinline__ float sigm(float x) { return __builtin_amdgcn_rcpf(1.f + __expf(-x)); }

struct Ctx { int wave, bid, G, gw, NGW; };
__device__ __forceinline__ int lane_id() { int l; asm volatile("v_mbcnt_lo_u32_b32 %0, -1, 0\n\tv_mbcnt_hi_u32_b32 %0, -1, %0" : "=v"(l)); return l; }
#define PHASE_IDS const int lane = lane_id(); const int tid = c.wave * 64 + lane; (void)tid; (void)lane

__device__ __forceinline__ void store_pair16(bf16_t* p, int hh, u32x2 a, u32x2 b) {
    const auto x = __builtin_amdgcn_permlane32_swap(a.x, b.x, false, false), y = __builtin_amdgcn_permlane32_swap(a.y, b.y, false, false);
    u32x4 w; w.x = x[0]; w.y = y[0]; w.z = x[1]; w.w = y[1];
    *(u32x4*)(p + 4 * hh) = w;
}
__device__ __forceinline__ void tr_block(const float* W, int ldw, int k0, int n0, bf16_t* WT, int ldt, int drow0, LAS float* scr, int lane, const float* s, int mode) {
    LAS unsigned* Tw = (LAS unsigned*)scr; const int kq = lane >> 4, n4 = (lane & 15) * 4;
    f32x4 v0[8], v1[8];
#pragma unroll
    for (int i = 0; i < 8; ++i) { const float* p = W + (size_t)(k0 + 8 * i + 2 * kq) * ldw + n0 + n4; v0[i] = *(const f32x4*)p; v1[i] = *(const f32x4*)(p + ldw); }
    if (mode) {
#pragma unroll
        for (int i = 0; i < 8; ++i) { float m0 = s[k0 + 8 * i + 2 * kq], m1 = s[k0 + 8 * i + 2 * kq + 1]; if (mode == 1) { m0 = 1.f - m0; m1 = 1.f - m1; } v0[i] *= m0; v1[i] *= m1; }
    }
#pragma unroll
    for (int i = 0; i < 8; ++i)
#pragma unroll
        for (int e = 0; e < 4; ++e) Tw[(n4 + e) * 33 + 4 * i + kq] = pk2(v0[i][e], v1[i][e]);
    asm volatile("s_waitcnt lgkmcnt(0)" ::: "memory");
    const int nr = lane >> 3, kc = lane & 7;
#pragma unroll
    for (int j = 0; j < 8; ++j) { const int n = nr + 8 * j; const LAS unsigned* p = Tw + n * 33 + 4 * kc;
        u32x4 o; o.x = p[0]; o.y = p[1]; o.z = p[2]; o.w = p[3];
        *(u32x4*)(WT + (size_t)(drow0 + n) * ldt + k0 + 8 * kc) = o; }
    asm volatile("s_waitcnt lgkmcnt(0)" ::: "memory");
}
__device__ __forceinline__ void cp_item(const float* W, int N, bf16_t* WN, int item, int lane, const float* s) {
    const int nblk = N / 64, k0 = 64 * (item / nblk), n0 = 64 * (item % nblk), kq = lane >> 4, n4 = (lane & 15) * 4;
    f32x4 v[16];
#pragma unroll
    for (int i = 0; i < 16; ++i) v[i] = __builtin_nontemporal_load((const f32x4*)(W + (size_t)(k0 + 4 * i + kq) * N + n0 + n4));
#pragma unroll
    for (int i = 0; i < 16; ++i) *(u32x2*)(WN + (size_t)(k0 + 4 * i + kq) * N + n0 + n4) = pack4(v[i] * s[k0 + 4 * i + kq]);
}
__device__ __forceinline__ void tr_item(const float* W, int K, int N, bf16_t* WT, int drow, LAS float* scr, int item, int lane, const float* s = nullptr, int mode = 0) {
    const int nblk = N / 64, kb = item / nblk, nb = item % nblk;
    tr_block(W, N, 64 * kb, 64 * nb, WT, K, drow + 64 * nb, scr, lane, s, mode);
}

struct In {
    const float *x, *mem, *norm_mix, *norm_cross, *norm_ffn, *norm_mem, *norm_final;
    const float *rw_mix, *rw_wr, *rw_wk, *rw_wv, *rw_w0, *rw_w1, *rw_w2, *rw_a0, *rw_a1, *rw_a2, *rw_g1, *rw_g2, *rw_kk, *rw_ka, *rw_rk, *rw_lnx_w, *rw_lnx_b, *rw_wo;
    const float *sb_wqkv, *sb_wo, *xa_wq, *xa_wkv, *xa_wo, *moe_wg, *moe_bg, *moe_we, *moe_be, *moe_w1, *moe_w3, *moe_w2;
};
struct Args { In in; float* out; unsigned char* ws; int ph_lo, ph_hi; };
struct InL { const LAS unsigned long long* p;
    __device__ __forceinline__ const float* get(int i) const { const unsigned long long v = p[i]; const unsigned lo = __builtin_amdgcn_readfirstlane((unsigned)v), hi = __builtin_amdgcn_readfirstlane((unsigned)(v >> 32)); return (const float*)(((unsigned long long)hi << 32) | lo); } };
#define IN(name) (in.get((int)(offsetof(In, name) / 8)))

__device__ __forceinline__ void rms_row_to_bf16(const float* xrow, const float* gain, bf16_t* orow, int lane) {
    const f32x4* xr = (const f32x4*)xrow + lane; f32x4 v[4]; float s = 0.f;
#pragma unroll
    for (int j = 0; j < 4; ++j) { v[j] = xr[64 * j]; s += (v[j].x * v[j].x + v[j].y * v[j].y) + (v[j].z * v[j].z + v[j].w * v[j].w); }
    const float rs = rsqrtf(wave_sum(s) * (1.f / DM) + NORM_EPS);
#pragma unroll
    for (int j = 0; j < 4; ++j) { const f32x4 g = gain ? ((const f32x4*)gain)[lane + 64 * j] : (f32x4){1.f, 1.f, 1.f, 1.f}; ((u32x2*)orow)[lane + 64 * j] = pack4(v[j] * rs * g); }
}

__device__ __forceinline__ void p_prologue(const Ctx& c, const InL& in, unsigned char* ws, LAS unsigned char* lds) {
    PHASE_IDS;
    LAS float* scr = (LAS float*)(lds + c.wave * 16384);
    constexpr int I_SQ = 16 * 16;
    constexpr int I_QKV = 16 * 48, I_KV = 16 * 32;
    constexpr int I_L64 = 16 * 1, I_L128 = 16 * 2;
    constexpr int I_M13 = 16 * 4;
    constexpr int I_M2 = 4 * 16;
    constexpr int NITEMS = 4 * I_SQ + 2 * (2 * I_L64 + I_L128) + I_QKV + I_SQ + 4 * I_SQ + I_KV + 2 * 64 * I_M13 + 64 * I_M2;
    for (int it = c.gw; it < NITEMS; it += c.NGW) {
        int r = it;
        if (r < I_SQ) { tr_item(IN(rw_wr), DM, DM, (bf16_t*)(ws + WS_WR), 0, scr, r, lane); continue; } r -= I_SQ;
        if (r < I_SQ) { tr_item(IN(rw_wk), DM, DM, (bf16_t*)(ws + WS_WK), 0, scr, r, lane); continue; } r -= I_SQ;
        if (r < I_SQ) { tr_item(IN(rw_wv), DM, DM, (bf16_t*)(ws + WS_WV), 0, scr, r, lane); continue; } r -= I_SQ;
        if (r < I_SQ) { tr_item(IN(rw_wo), DM, DM, (bf16_t*)(ws + WS_WO0), 0, scr, r, lane); continue; } r -= I_SQ;
        if (r < 2 * (2 * I_L64 + I_L128)) {
            const int q = r / (2 * I_L64 + I_L128), rr = r % (2 * I_L64 + I_L128); const int mode = 1 + q; bf16_t* WT = (bf16_t*)(ws + WS_WPQ);
            if (rr < I_L64) tr_item(IN(rw_w1), DM, 64, WT, 256 * q + 0, scr, rr, lane, IN(rw_mix) + 1 * DM, mode);
            else if (rr < 2 * I_L64) tr_item(IN(rw_a1), DM, 64, WT, 256 * q + 64, scr, rr - I_L64, lane, IN(rw_mix) + 4 * DM, mode);
            else tr_item(IN(rw_g1), DM, 128, WT, 256 * q + 128, scr, rr - 2 * I_L64, lane, IN(rw_mix) + 5 * DM, mode);
            continue; } r -= 2 * (2 * I_L64 + I_L128);
        if (r < I_QKV) { tr_item(IN(sb_wqkv), DM, 3 * DM, (bf16_t*)(ws + WS_SBQKV), 0, scr, r, lane, IN(norm_mix) + DM, 2); continue; } r -= I_QKV;
        if (r < I_SQ) { tr_item(IN(sb_wo), DM, DM, (bf16_t*)(ws + WS_SBWO), 0, scr, r, lane); continue; } r -= I_SQ;
        if (r < 2 * I_SQ) { const int l = r / I_SQ; cp_item(IN(xa_wq) + (size_t)l * DM * DM, DM, (bf16_t*)(ws + WS_XAWQ) + (size_t)l * DM * DM, r % I_SQ, lane, IN(norm_cross) + l * DM); continue; } r -= 2 * I_SQ;
        if (r < 2 * I_SQ) { const int l = r / I_SQ; tr_item(IN(xa_wo) + (size_t)l * DM * DM, DM, DM, (bf16_t*)(ws + WS_XAWO) + (size_t)l * DM * DM, 0, scr, r % I_SQ, lane); continue; } r -= 2 * I_SQ;
        if (r < I_KV) { tr_item(IN(xa_wkv), DM, 2 * DM, (bf16_t*)(ws + WS_XAWKV), 0, scr, r, lane); continue; } r -= I_KV;
        if (r < 2 * 64 * I_M13) {
            const int which = r / (64 * I_M13), rr = r % (64 * I_M13), le = rr / I_M13, item = rr % I_M13;
            const float* W = (which ? IN(moe_w3) : IN(moe_w1)) + (size_t)le * DM * DF; bf16_t* WT = (bf16_t*)(ws + WS_W13) + (size_t)le * 512 * DM;
            const int nblk = DF / 64, kb = item / nblk, nb = item % nblk, n0 = 64 * nb;
            tr_block(W, DF, 64 * kb, n0, WT, DM, (n0 / 128) * 256 + (n0 % 128) + which * 128, scr, lane, IN(norm_ffn) + (le / NE) * DM, 2);
            continue; } r -= 2 * 64 * I_M13;
        { const int le = r / I_M2, item = r % I_M2; tr_item(IN(moe_w2) + (size_t)le * DF * DM, DF, DM, (bf16_t*)(ws + WS_W2) + (size_t)le * DM * DF, 0, scr, item, lane); }
    }
    const int gt = c.bid * 512 + tid, NT = c.G * 512;
    for (int i = gt; i < 2 * 256 * DM; i += NT) { const int l = i / (256 * DM), n = (i / DM) % 256, k = i % DM; float v = 0.f;
        if (n < NG) v = IN(moe_wg)[((size_t)l * DM + k) * NG + n]; else if (n < NG + NE) v = IN(moe_we)[((size_t)l * DM + k) * NE + (n - NG)];
        ((bf16_t*)(ws + WS_ROUTE))[i] = (bf16_t)f2bf(v * IN(norm_ffn)[l * DM + k]); }
    for (int i = gt; i < 3072 * 256; i += NT) { const int n = i / 256, k = i % 256, t = n / 1024, nn = n % 1024; float v = 0.f;
        if (t == 0) { if (k < 64) v = IN(rw_w2)[(size_t)k * DM + nn]; } else if (t == 1) { if (k >= 64 && k < 128) v = IN(rw_a2)[(size_t)(k - 64) * DM + nn]; } else { if (k >= 128) v = IN(rw_g2)[(size_t)(k - 128) * DM + nn]; }
        ((bf16_t*)(ws + WS_WL2))[i] = (bf16_t)f2bf(v); }
    for (int m = c.gw; m < BATCH * NMEM; m += c.NGW) rms_row_to_bf16(IN(mem) + (size_t)m * DM, IN(norm_mem), (bf16_t*)(ws + WS_MEMN) + (size_t)m * DM, lane);
}

__device__ __forceinline__ void p_norm_shift(const Ctx& c, const InL& in, int g, bf16_t* hn, bf16_t* xr, bf16_t* xk, bf16_t* xv) {
    PHASE_IDS;
    const int NGW = c.G * 8; const float* xin = IN(x); const float* gnp = IN(norm_mix); const float* mixp = IN(rw_mix);
    for (int row0 = c.bid * 8 + c.wave; row0 < TG; row0 += 2 * NGW) {
        f32x4 v[2][4], p[2][4]; bool first[2];
#pragma unroll
        for (int q = 0; q < 2; ++q) { const int t = g * TG + row0 + q * NGW; first[q] = (t % SEQ) == 0;
            const f32x4* xc = (const f32x4*)(xin + (size_t)t * DM) + lane; const f32x4* xp = (const f32x4*)(xin + (size_t)(first[q] ? t : t - 1) * DM) + lane;
#pragma unroll
            for (int j = 0; j < 4; ++j) { v[q][j] = xc[64 * j]; p[q][j] = xp[64 * j]; } }
#pragma unroll
        for (int q = 0; q < 2; ++q) { const int row = row0 + q * NGW; float s = 0.f, sp = 0.f;
#pragma unroll
            for (int j = 0; j < 4; ++j) { s += (v[q][j].x * v[q][j].x + v[q][j].y * v[q][j].y) + (v[q][j].z * v[q][j].z + v[q][j].w * v[q][j].w); sp += (p[q][j].x * p[q][j].x + p[q][j].y * p[q][j].y) + (p[q][j].z * p[q][j].z + p[q][j].w * p[q][j].w); }
            const float rs = rsqrtf(wave_sum(s) * (1.f / DM) + NORM_EPS); const float rpv = rsqrtf(wave_sum(sp) * (1.f / DM) + NORM_EPS); const float rp = first[q] ? 0.f : rpv;
#pragma unroll
            for (int j = 0; j < 4; ++j) { const int ci = lane + 64 * j; const f32x4 gn = ((const f32x4*)gnp)[ci];
                const f32x4 h = v[q][j] * rs * gn, hp = p[q][j] * rp * gn, dx = hp - h;
                const f32x4 mr = ((const f32x4*)(mixp + 0 * DM))[ci], mk = ((const f32x4*)(mixp + 2 * DM))[ci], mv = ((const f32x4*)(mixp + 3 * DM))[ci];
                const size_t o = (size_t)row * (DM / 4) + ci;
                ((u32x2*)hn)[o] = pack4(h); ((u32x2*)xr)[o] = pack4(h + dx * mr); ((u32x2*)xk)[o] = pack4(h + dx * mk); ((u32x2*)xv)[o] = pack4(h + dx * mv); } }
    }
}
__device__ __forceinline__ void p_lora_act(const Ctx& c, const bf16_t* pq, bf16_t* act) {
    PHASE_IDS;
    for (int row = c.gw; row < TG; row += c.NGW) {
        const bool first = (row % SEQ) == 0;
        f32x4 u = unpack4(((const u32x2*)(pq + (size_t)row * 512))[lane]);
        if (!first) u += unpack4(((const u32x2*)(pq + (size_t)(row - 1) * 512 + 256))[lane]);
        f32x4 o;
#pragma unroll
        for (int e = 0; e < 4; ++e) { const float x = u[e]; o[e] = (lane < 16) ? (1.f - 2.f * __builtin_amdgcn_rcpf(1.f + __expf(2.f * x))) : (lane < 32 ? x : sigm(x)); }
        ((u32x2*)(act + (size_t)row * 256))[lane] = pack4(o);
    }
}
typedef _Float16 f16x8 __attribute__((ext_vector_type(8)));
typedef float f32x16 __attribute__((ext_vector_type(16)));
typedef __bf16 bf16x2_t __attribute__((ext_vector_type(2)));
__device__ __forceinline__ unsigned cvt2bf(float lo, float hi) { f32x2 v = {lo, hi}; bf16x2_t b = __builtin_convertvector(v, bf16x2_t); return __builtin_bit_cast(unsigned, b); }
__device__ __forceinline__ unsigned cvt2h(float lo, float hi) { return __builtin_bit_cast(unsigned, __builtin_amdgcn_cvt_pkrtz(lo, hi)); }
__device__ __forceinline__ bf16x8 frag144(const LAS unsigned char* img, int row, int s, int hh) { return *(const LAS bf16x8*)(img + row * 144 + s * 32 + hh * 16); }
__device__ __forceinline__ bf16x8 frag144s(const LAS unsigned char* img, int row, int s, int hh) { return *(const LAS bf16x8*)(img + row * 144 + (((2 * s + hh) ^ ((row >> 3) & 7)) << 4)); }
__device__ __forceinline__ void s1_solve(const Ctx& c, const LAS unsigned char* I_A, const LAS unsigned char* I_AB, const LAS unsigned char* TB, const LAS float* RZ, LAS unsigned char* AT, LAS unsigned char* I_XT) {
    constexpr int P = 144;
    const int ct = c.wave; LAS unsigned char* at = AT + ct * 512;
#pragma unroll
    for (int bb = 0; bb < 4; ++bb) {
        const int lane = lane_id(), c16 = lane & 15, g4 = lane >> 4, col = 16 * ct + c16;
        f32x4 d = (f32x4){0.f, 0.f, 0.f, 0.f};
        if (bb > 0) {
#pragma unroll
            for (int s = 0; s < (16 * bb + 31) / 32; ++s) {
                const bf16x8 a = *(const LAS bf16x8*)(I_AB + (16 * bb + c16) * P + s * 64 + g4 * 16), b = *(const LAS bf16x8*)(I_XT + col * P + s * 64 + g4 * 16);
                d = __builtin_amdgcn_mfma_f32_16x16x32_bf16(a, b, d, 0, 0, 0); }
        }
        if (ct < 4) {
#pragma unroll
            for (int e = 0; e < 4; ++e) d[e] += __uint_as_float(((unsigned)*(const LAS unsigned short*)(I_A + (16 * bb + 4 * g4 + e) * P + col * 2)) << 16);
        } else {
#pragma unroll
            for (int e = 0; e < 4; ++e) d[e] += RZ[(16 * bb + 4 * g4 + e) * 68 + (col - 64)];
        }
        { u32x2 w; w.x = cvt2bf(d[0], d[1]); w.y = cvt2bf(d[2], d[3]); *(LAS u32x2*)(at + c16 * 32 + 8 * g4) = w; }
        asm volatile("s_waitcnt lgkmcnt(0)" ::: "memory");
        u32x4 bw = *(const LAS u32x4*)(at + c16 * 32 + 16 * (g4 & 1)); if (g4 >= 2) bw = (u32x4){0u, 0u, 0u, 0u};
        const bf16x8 a2 = *(const LAS bf16x8*)(TB + bb * 1024 + c16 * 64 + g4 * 16);
        const f32x4 x = __builtin_amdgcn_mfma_f32_16x16x32_bf16(a2, __builtin_bit_cast(bf16x8, bw), (f32x4){0.f, 0.f, 0.f, 0.f}, 0, 0, 0);
        { u32x2 w; w.x = cvt2bf(x[0], x[1]); w.y = cvt2bf(x[2], x[3]); *(LAS u32x2*)(I_XT + col * P + (16 * bb + 4 * g4) * 2) = w; }
        asm volatile("s_waitcnt lgkmcnt(0)" ::: "memory");
    }
}
__device__ __forceinline__ void s1_tinv(const LAS float* ADG, LAS unsigned char* TB) {
    const int lane = lane_id(), bq = lane >> 4, jc = lane & 15;
    float x[16];
#pragma unroll
    for (int ii = 0; ii < 16; ++ii) {
        const LAS f32x4* ar = (const LAS f32x4*)(ADG + bq * 256 + ii * 16); const f32x4 a0 = ar[0], a1 = ar[1], a2 = ar[2], a3 = ar[3];
        const float av[16] = {a0[0], a0[1], a0[2], a0[3], a1[0], a1[1], a1[2], a1[3], a2[0], a2[1], a2[2], a2[3], a3[0], a3[1], a3[2], a3[3]};
        float v = (ii == jc) ? 1.f : 0.f;
#pragma unroll
        for (int jj = 0; jj < ii; ++jj) v += av[jj] * x[jj];
        x[ii] = v;
        *(LAS unsigned short*)(TB + bq * 1024 + ii * 64 + jc * 2) = (unsigned short)f2bf(v);
    }
    *(LAS u32x4*)(TB + bq * 1024 + jc * 64 + 32) = (u32x4){0u, 0u, 0u, 0u}; *(LAS u32x4*)(TB + bq * 1024 + jc * 64 + 48) = (u32x4){0u, 0u, 0u, 0u};
}
__device__ __forceinline__ void p_scan_s1(const Ctx& c, const InL& in, const bf16_t* R, const bf16_t* Kb, const bf16_t* Vb, const bf16_t* WL, const bf16_t* Ab,
                                          bf16_t* RH, bf16_t* YL, bf16_t* MM, bf16_t* NT, float* bonus, LAS unsigned char* lds) {
    PHASE_IDS;
    constexpr int P = 144, IMG = 64 * P;
    LAS unsigned char* I_R = lds; LAS unsigned char* I_BT = lds + IMG; LAS unsigned char* I_KT = lds + 2 * IMG; LAS unsigned char* I_VT = lds + 3 * IMG;
    LAS unsigned char* I_AK = lds + 4 * IMG; LAS unsigned char* I_RB = lds + 5 * IMG; LAS unsigned char* I_RK = lds + 6 * IMG;
    LAS unsigned char* I_A = lds + 7 * IMG; LAS unsigned char* I_B = lds + 8 * IMG; LAS unsigned char* I_K = lds + 9 * IMG; LAS unsigned char* I_XT = I_B;
    LAS float* A4 = (LAS float*)(lds + 10 * IMG);
    LAS unsigned char* I_AB = lds + 10 * IMG; LAS float* ADG = (LAS float*)(lds + 10 * IMG + IMG); LAS unsigned char* TB = lds + 10 * IMG + IMG + 4096;
    LAS unsigned char* AT = I_AK;
    LAS float* RZ = (LAS float*)(lds + 10 * IMG + 17408);
    LAS float* PL = (LAS float*)(lds + 10 * IMG + 2 * 17408);
    LAS float* TOT = PL + 64;
    u32x4 nrw, nkw, nvw, nww, naw;
#define S1_LOAD(uu) do { const int ch_ = (uu) % (SEQ / 64), h_ = ((uu) / (SEQ / 64)) % NH, bl_ = (uu) / ((SEQ / 64) * NH); \
        const size_t off_ = ((size_t)(bl_ * SEQ + ch_ * 64 + (tid >> 3))) * DM + h_ * HD + (tid & 7) * 8; \
        nrw = *(const u32x4*)(R + off_); nkw = *(const u32x4*)(Kb + off_); nvw = *(const u32x4*)(Vb + off_); nww = *(const u32x4*)(WL + off_); naw = *(const u32x4*)(Ab + off_); } while (0)
    if (c.bid < BG * NH * (SEQ / 64)) S1_LOAD(c.bid);
    for (int u = c.bid; u < BG * NH * (SEQ / 64); u += c.G) {
        const int ch = u % (SEQ / 64), h = (u / (SEQ / 64)) % NH, bl = u / ((SEQ / 64) * NH);
        __syncthreads();
        {
            const int lane = lane_id(), tid = c.wave * 64 + lane;
            const int i = tid >> 3, n8 = (tid & 7) * 8;
            const u32x4 rw = nrw, kw = nkw, vw = nvw, ww = nww, aw = naw;
            float rr[8] = {bflo(rw.x), bfhi(rw.x), bflo(rw.y), bfhi(rw.y), bflo(rw.z), bfhi(rw.z), bflo(rw.w), bfhi(rw.w)};
            float kx[8] = {bflo(kw.x), bfhi(kw.x), bflo(kw.y), bfhi(kw.y), bflo(kw.z), bfhi(kw.z), bflo(kw.w), bfhi(kw.w)};
            float wx[8] = {bflo(ww.x), bfhi(ww.x), bflo(ww.y), bfhi(ww.y), bflo(ww.z), bfhi(ww.z), bflo(ww.w), bfhi(ww.w)};
            float ax[8] = {bflo(aw.x), bfhi(aw.x), bflo(aw.y), bfhi(aw.y), bflo(aw.z), bfhi(aw.z), bflo(aw.w), bfhi(aw.w)};
            const float* pkk = IN(rw_kk) + h * HD + n8; const float* pka = IN(rw_ka) + h * HD + n8;
            float kk[8], kp[8], bb[8]; float ssq = 0.f;
#pragma unroll
            for (int e = 0; e < 8; ++e) { kk[e] = kx[e] * pkk[e]; ssq += kk[e] * kk[e]; kp[e] = kx[e] * (1.f + (ax[e] - 1.f) * pka[e]); }
            ssq = sum8(ssq); const float inv = 1.f / fmaxf(sqrtf(ssq), 1e-12f);
            { const float* prk = IN(rw_rk) + h * HD + n8; float bo = 0.f;
#pragma unroll
              for (int e = 0; e < 8; ++e) bo += rr[e] * kp[e] * prk[e];
              bo = sum8(bo); if ((tid & 7) == 0) bonus[(size_t)(bl * SEQ + ch * 64 + i) * NH + h] = bo; }
#pragma unroll
            for (int e = 0; e < 8; ++e) { kk[e] *= inv; bb[e] = kk[e] * ax[e]; }
            LAS float* CW = A4;
            *(LAS f32x4*)(CW + i * 64 + n8) = (f32x4){wx[0], wx[1], wx[2], wx[3]}; *(LAS f32x4*)(CW + i * 64 + n8 + 4) = (f32x4){wx[4], wx[5], wx[6], wx[7]};
            __syncthreads();
            { const int n = tid & 63, seg = tid >> 6; float acc = 0.f;
#pragma unroll
              for (int e = 0; e < 8; ++e) { acc += CW[(8 * seg + e) * 64 + n]; CW[(8 * seg + e) * 64 + n] = acc; }
              TOT[seg * 64 + n] = acc; }
            __syncthreads();
            float cw[8];
            { const f32x4 c0 = *(const LAS f32x4*)(CW + i * 64 + n8), c1 = *(const LAS f32x4*)(CW + i * 64 + n8 + 4);
              cw[0] = c0.x; cw[1] = c0.y; cw[2] = c0.z; cw[3] = c0.w; cw[4] = c1.x; cw[5] = c1.y; cw[6] = c1.z; cw[7] = c1.w;
              const int seg = i >> 3;
              for (int sp = 0; sp < seg; ++sp) { const f32x4 t0 = *(const LAS f32x4*)(TOT + sp * 64 + n8), t1 = *(const LAS f32x4*)(TOT + sp * 64 + n8 + 4);
                  cw[0] += t0.x; cw[1] += t0.y; cw[2] += t0.z; cw[3] += t0.w; cw[4] += t1.x; cw[5] += t1.y; cw[6] += t1.z; cw[7] += t1.w; } }
            float at[8], bt[8], kt[8], rt[8];
#pragma unroll
            for (int e = 0; e < 8; ++e) { const float ein = __expf(cw[e]), eex = __expf(cw[e] - wx[e]), eng = __expf(-cw[e]);
                at[e] = -kk[e] * eex; bt[e] = bb[e] * eng; kt[e] = kp[e] * eng; rt[e] = rr[e] * ein; if (i == 63) PL[n8 + e] = ein; }
            u32x4 w;
            w.x = cvt2bf(at[0], at[1]); w.y = cvt2bf(at[2], at[3]); w.z = cvt2bf(at[4], at[5]); w.w = cvt2bf(at[6], at[7]); *(LAS u32x4*)(I_A + i * P + n8 * 2) = w;
            w.x = cvt2bf(rt[0], rt[1]); w.y = cvt2bf(rt[2], rt[3]); w.z = cvt2bf(rt[4], rt[5]); w.w = cvt2bf(rt[6], rt[7]); *(LAS u32x4*)(I_R + i * P + n8 * 2) = w;
            u32x4 wb, wk;
            wb.x = cvt2bf(bt[0], bt[1]); wb.y = cvt2bf(bt[2], bt[3]); wb.z = cvt2bf(bt[4], bt[5]); wb.w = cvt2bf(bt[6], bt[7]); *(LAS u32x4*)(I_B + i * P + n8 * 2) = wb;
            wk.x = cvt2bf(kt[0], kt[1]); wk.y = cvt2bf(kt[2], kt[3]); wk.z = cvt2bf(kt[4], kt[5]); wk.w = cvt2bf(kt[6], kt[7]); *(LAS u32x4*)(I_K + i * P + n8 * 2) = wk;
            const unsigned tb[4] = {wb.x, wb.y, wb.z, wb.w}, tk[4] = {wk.x, wk.y, wk.z, wk.w}, tv[4] = {vw.x, vw.y, vw.z, vw.w};
#pragma unroll
            for (int e = 0; e < 8; ++e) { const int sh = (e & 1) * 16; const int ro = (n8 + e) * P + ((((i >> 3) ^ ((n8 >> 3) & 7)) << 4) | ((i & 7) * 2));
                *(LAS unsigned short*)(I_BT + ro) = (unsigned short)(tb[e >> 1] >> sh); *(LAS unsigned short*)(I_KT + ro) = (unsigned short)(tk[e >> 1] >> sh); *(LAS unsigned short*)(I_VT + ro) = (unsigned short)(tv[e >> 1] >> sh); }
        }
        __syncthreads();
        {
            const int lane = lane_id(), r = lane & 31, hh = lane >> 5;
            const int combo = c.wave >> 1, jt = c.wave & 1;
            const LAS unsigned char* Ximg = (combo & 1) ? I_K : I_B; const LAS unsigned char* Yimg = (combo >> 1) ? I_R : I_A;
            LAS unsigned char* Oimg = (combo == 1) ? I_AK : (combo == 2 ? I_RB : I_RK);
            const bool incl = combo >= 2;
#pragma unroll
            for (int tt = 0; tt < 2; ++tt) {
                f32x16 d;
#pragma unroll
                for (int e = 0; e < 16; ++e) d[e] = 0.f;
                if (tt >= jt) {
#pragma unroll
                    for (int s = 0; s < 4; ++s) d = __builtin_amdgcn_mfma_f32_32x32x16_bf16(frag144(Ximg, 32 * jt + r, s, hh), frag144(Yimg, 32 * tt + r, s, hh), d, 0, 0, 0);
                }
                const int t = 32 * tt + r;
#pragma unroll
                for (int e = 0; e < 16; ++e) { const int j = 32 * jt + (e & 3) + 8 * (e >> 2) + 4 * hh; const bool keep = incl ? (j <= t) : (j < t); d[e] = keep ? d[e] : 0.f; }
                if (combo == 0) {
#pragma unroll
                    for (int g = 0; g < 4; ++g) { u32x2 w; w.x = cvt2bf(d[4 * g], d[4 * g + 1]); w.y = cvt2bf(d[4 * g + 2], d[4 * g + 3]); *(LAS u32x2*)(I_AB + t * P + (32 * jt + 8 * g + 4 * hh) * 2) = w;
                        if ((2 * jt + (g >> 1)) == (t >> 4)) *(LAS f32x4*)(ADG + (t >> 4) * 256 + (t & 15) * 16 + ((8 * g + 4 * hh) & 15)) = (f32x4){d[4 * g], d[4 * g + 1], d[4 * g + 2], d[4 * g + 3]}; }
                } else {
#pragma unroll
                    for (int g = 0; g < 4; ++g) { u32x2 w; w.x = cvt2bf(d[4 * g], d[4 * g + 1]); w.y = cvt2bf(d[4 * g + 2], d[4 * g + 3]); *(LAS u32x2*)(Oimg + t * P + (32 * jt + 8 * g + 4 * hh) * 2) = w; }
                }
            }
        }
        __syncthreads();
        { const int tz = c.wave * 64 + lane_id(); for (int o = tz * 16; o < 128 * P; o += 512 * 16) *(LAS u32x4*)(I_XT + o) = (u32x4){0u, 0u, 0u, 0u}; }
        if (c.wave == 4) s1_tinv(ADG, TB);
        if (c.wave < 4) {
            const int lane = lane_id(), r = lane & 31, hh = lane >> 5;
            const int vt = c.wave >> 1, tt = c.wave & 1;
            f32x16 d;
#pragma unroll
            for (int e = 0; e < 16; ++e) d[e] = 0.f;
#pragma unroll
            for (int s = 0; s < 4; ++s) d = __builtin_amdgcn_mfma_f32_32x32x16_bf16(frag144s(I_VT, 32 * vt + r, s, hh), frag144(I_AK, 32 * tt + r, s, hh), d, 0, 0, 0);
            const int t = 32 * tt + r;
#pragma unroll
            for (int g = 0; g < 4; ++g) *(LAS f32x4*)(RZ + t * 68 + 32 * vt + 8 * g + 4 * hh) = (f32x4){d[4 * g], d[4 * g + 1], d[4 * g + 2], d[4 * g + 3]};
        }
        __syncthreads();
        if (u + c.G < BG * NH * (SEQ / 64)) { const int tid = c.wave * 64 + lane_id(); S1_LOAD(u + c.G); }
        s1_solve(c, I_A, I_AB, TB, RZ, AT, I_XT);
        __syncthreads();
        {
            const int lane = lane_id(), r = lane & 31, hh = lane >> 5;
            const int rt = (c.wave >> 1) & 1, ct = c.wave & 1; const bool mhi = c.wave >= 4;
            int u2 = u; asm volatile("" : "+s"(u2));
            const size_t ub = (size_t)u2 * 4096;
#pragma unroll
            for (int it = 0; it < 2; ++it) {
                const int mat = it == 0 ? (mhi ? 3 : 1) : (mhi ? 2 : 0);
                f32x16 d;
                const int cl = 32 * ct + r;
                if (mat == 0) {
#pragma unroll
                    for (int g = 0; g < 4; ++g) { const f32x4 v = unpack4(*(const LAS u32x2*)(I_R + cl * P + (32 * rt + 8 * g + 4 * hh) * 2)); d[4 * g] = v.x; d[4 * g + 1] = v.y; d[4 * g + 2] = v.z; d[4 * g + 3] = v.w; }
#pragma unroll
                    for (int s = 0; s < 4; ++s) d = __builtin_amdgcn_mfma_f32_32x32x16_bf16(frag144(I_XT, 32 * rt + r, s, hh), frag144(I_RB, cl, s, hh), d, 0, 0, 0);
                } else {
#pragma unroll
                    for (int e = 0; e < 16; ++e) d[e] = 0.f;
                    if (mat == 1) {
#pragma unroll
                        for (int s = 0; s < 4; ++s) d = __builtin_amdgcn_mfma_f32_32x32x16_bf16(frag144(I_XT, 64 + 32 * rt + r, s, hh), frag144(I_RB, cl, s, hh), d, 0, 0, 0);
#pragma unroll
                        for (int s = 0; s < 4; ++s) d = __builtin_amdgcn_mfma_f32_32x32x16_bf16(frag144s(I_VT, 32 * rt + r, s, hh), frag144(I_RK, cl, s, hh), d, 0, 0, 0);
                    } else if (mat == 2) {
#pragma unroll
                        for (int s = 0; s < 4; ++s) d = __builtin_amdgcn_mfma_f32_32x32x16_bf16(frag144(I_XT, 32 * rt + r, s, hh), frag144s(I_BT, cl, s, hh), d, 0, 0, 0);
                        const float pl = PL[cl];
#pragma unroll
                        for (int e = 0; e < 16; ++e) { const int k = 32 * rt + (e & 3) + 8 * (e >> 2) + 4 * hh; d[e] = (d[e] + (k == cl ? 1.f : 0.f)) * pl; }
                    } else {
#pragma unroll
                        for (int s = 0; s < 4; ++s) d = __builtin_amdgcn_mfma_f32_32x32x16_bf16(frag144s(I_BT, 32 * rt + r, s, hh), frag144(I_XT, 64 + cl, s, hh), d, 0, 0, 0);
#pragma unroll
                        for (int s = 0; s < 4; ++s) d = __builtin_amdgcn_mfma_f32_32x32x16_bf16(frag144s(I_KT, 32 * rt + r, s, hh), frag144s(I_VT, cl, s, hh), d, 0, 0, 0);
#pragma unroll
                        for (int g = 0; g < 4; ++g) { const f32x4 pl = *(const LAS f32x4*)(PL + 32 * rt + 8 * g + 4 * hh); d[4 * g] *= pl.x; d[4 * g + 1] *= pl.y; d[4 * g + 2] *= pl.z; d[4 * g + 3] *= pl.w; }
                    }
                }
                bf16_t* ob = (mat == 0 ? RH : mat == 1 ? YL : mat == 2 ? MM : NT) + ub + (size_t)cl * 64 + 32 * rt + 4 * hh;
#pragma unroll
                for (int g = 0; g < 4; g += 2) { u32x2 w0, w1; w0.x = cvt2bf(d[4 * g], d[4 * g + 1]); w0.y = cvt2bf(d[4 * g + 2], d[4 * g + 3]); w1.x = cvt2bf(d[4 * g + 4], d[4 * g + 5]); w1.y = cvt2bf(d[4 * g + 6], d[4 * g + 7]);
                    store_pair16(ob + 8 * g, hh, w0, w1); }
            }
        }
    }
}
__device__ __forceinline__ bf16x8 ldfrag8(const bf16_t* p) { const u32x2 lo = *(const u32x2*)p, hi = *(const u32x2*)(p + 8); u32x4 v; v.x = lo.x; v.y = lo.y; v.z = hi.x; v.w = hi.y; return __builtin_bit_cast(bf16x8, v); }
__device__ __forceinline__ bf16x8 packacc(const f32x16& x, int s) { u32x4 w; w.x = cvt2bf(x[8 * s], x[8 * s + 1]); w.y = cvt2bf(x[8 * s + 2], x[8 * s + 3]); w.z = cvt2bf(x[8 * s + 4], x[8 * s + 5]); w.w = cvt2bf(x[8 * s + 6], x[8 * s + 7]); return __builtin_bit_cast(bf16x8, w); }
__device__ __forceinline__ int s2_off(int row, int chunk, int sub) { return row * 128 + ((chunk ^ ((row ^ (row >> 3)) & 7)) << 4) + sub; }
__device__ __forceinline__ bf16x8 s2_frag(const LAS unsigned char* mat, int row, int ch, int hh) {
    const u32x2 lo = *(const LAS u32x2*)(mat + s2_off(row, ch, 8 * hh)), hi = *(const LAS u32x2*)(mat + s2_off(row, ch + 1, 8 * hh)); u32x4 v; v.x = lo.x; v.y = lo.y; v.z = hi.x; v.w = hi.y; return __builtin_bit_cast(bf16x8, v); }
__device__ __forceinline__ void p_scan_s2(const Ctx& c, const InL& in, const bf16_t* RH, const bf16_t* YL, const bf16_t* MM, const bf16_t* NT, const float* bonus, const bf16_t* Vb, const bf16_t* Gt, bf16_t* Z, LAS unsigned char* lds) {
    PHASE_IDS;
    constexpr int NCH = SEQ / 64, SLOT = 32768;
    for (int bh = c.bid; bh < BG * NH; bh += c.G) {
        const int bl = bh / NH, h = bh % NH;
        __syncthreads();
#define S2_ISSUE(ch) do { int ln_ = lane; asm volatile("" : "+v"(ln_)); const size_t ub_ = ((size_t)bh * NCH + (ch)) * 4096; LAS unsigned char* sl_ = lds + ((ch) & 3) * SLOT; \
        _Pragma("unroll") for (int j_ = 0; j_ < 8; ++j_) { const int d_ = ((c.wave - 4) * 8 + j_) * 64 + ln_, q_ = d_ >> 9, row_ = (d_ >> 3) & 63, cp_ = d_ & 7; \
            const bf16_t* src_ = (q_ == 0 ? RH : q_ == 1 ? YL : q_ == 2 ? MM : NT) + ub_ + row_ * 64 + ((cp_ ^ ((row_ ^ (row_ >> 3)) & 7)) << 3); \
            __builtin_amdgcn_global_load_lds((const unsigned*)src_, (LAS unsigned*)(sl_ + ((c.wave - 4) * 8 + j_) * 1024), 16, 0, 0); } } while (0)
        if (c.wave >= 4) { S2_ISSUE(0); S2_ISSUE(1); S2_ISSUE(2); asm volatile("s_waitcnt vmcnt(16)" ::: "memory"); }
        __syncthreads();
        f32x4 plw = {0.f, 0.f, 0.f, 0.f}, plb = {0.f, 0.f, 0.f, 0.f};
        if (c.wave == 2 || c.wave == 3) { int lp = lane; asm volatile("" : "+v"(lp)); plw = *(const f32x4*)(IN(rw_lnx_w) + h * HD + (lp & 15) * 4); plb = *(const f32x4*)(IN(rw_lnx_b) + h * HD + (lp & 15) * 4);
            asm volatile("" : "+v"(plw), "+v"(plb)); }
        f32x16 H0, H1;
#pragma unroll
        for (int e = 0; e < 16; ++e) { H0[e] = 0.f; H1[e] = 0.f; }
#pragma unroll 1
        for (int ch = 0; ch <= NCH; ++ch) {
            if (c.wave >= 4) {
                if (ch < NCH) {
                if (ch + 3 < NCH) S2_ISSUE(ch + 3);
                const int pend = (ch + 3 < NCH ? ch + 3 : NCH - 1) - (ch + 1);
                if (pend >= 2) asm volatile("s_waitcnt vmcnt(16)" ::: "memory"); else if (pend == 1) asm volatile("s_waitcnt vmcnt(8)" ::: "memory"); else asm volatile("s_waitcnt vmcnt(0)" ::: "memory");
                }
            } else if (c.wave >= 2) {
                if (ch >= 1) {
                    int lp = lane; asm volatile("" : "+v"(lp));
                    const LAS unsigned char* yb = lds + LDS_YB + ((ch + 1) & 1) * (64 * 136) + (32 * (c.wave - 2) + (lp >> 4)) * 136 + (lp & 15) * 8;
                    const size_t rowp = (size_t)bl * SEQ + (ch - 1) * 64 + 32 * (c.wave - 2) + (lp >> 4), offp = rowp * DM + h * HD + (lp & 15) * 4;
                    u32x2 pv[8], pg[8], yw[8]; float pb[8]; f32x4 tn[8];
#pragma unroll
                    for (int q = 0; q < 8; ++q) { pv[q] = *(const u32x2*)(Vb + offp + (size_t)4 * q * DM); pg[q] = *(const u32x2*)(Gt + offp + (size_t)4 * q * DM); pb[q] = bonus[(rowp + 4 * q) * NH + h]; }
                    asm volatile("ds_read_b64 %0, %8\n\tds_read_b64 %1, %8 offset:544\n\tds_read_b64 %2, %8 offset:1088\n\tds_read_b64 %3, %8 offset:1632\n\tds_read_b64 %4, %8 offset:2176\n\tds_read_b64 %5, %8 offset:2720\n\t"
                                 "ds_read_b64 %6, %8 offset:3264\n\tds_read_b64 %7, %8 offset:3808\n\ts_waitcnt lgkmcnt(0)"
                                 : "=&v"(yw[0]), "=&v"(yw[1]), "=&v"(yw[2]), "=&v"(yw[3]), "=&v"(yw[4]), "=&v"(yw[5]), "=&v"(yw[6]), "=&v"(yw[7]) : "v"((unsigned)(size_t)yb) : "memory");
#pragma unroll
                    for (int q = 0; q < 8; ++q) {
                        const f32x4 y4 = unpack4(yw[q]);
                        const float mu = sum16((y4.x + y4.y) + (y4.z + y4.w)) * (1.f / 64.f);
                        const f32x4 dy = y4 - mu; const float var = sum16((dy.x * dy.x + dy.y * dy.y) + (dy.z * dy.z + dy.w * dy.w)) * (1.f / 64.f);
                        tn[q] = dy * rsqrtf(var + GN_EPS) * plw + plb;
                    }
                    asm volatile("" : "+v"(tn[0]), "+v"(tn[1]), "+v"(tn[2]), "+v"(tn[3]), "+v"(tn[4]), "+v"(tn[5]), "+v"(tn[6]), "+v"(tn[7]) :: "memory");
                    asm volatile("" : "+v"(pv[0]), "+v"(pv[1]), "+v"(pv[2]), "+v"(pv[3]), "+v"(pv[4]), "+v"(pv[5]), "+v"(pv[6]), "+v"(pv[7]), "+v"(pg[0]), "+v"(pg[1]), "+v"(pg[2]), "+v"(pg[3]), "+v"(pg[4]), "+v"(pg[5]), "+v"(pg[6]), "+v"(pg[7]),
                                 "+v"(pb[0]), "+v"(pb[1]), "+v"(pb[2]), "+v"(pb[3]), "+v"(pb[4]), "+v"(pb[5]), "+v"(pb[6]), "+v"(pb[7]) :: "memory");
                    bf16_t* zo = Z + offp;
#pragma unroll
                    for (int q = 0; q < 8; ++q) { const f32x4 z = (tn[q] + pb[q] * unpack4(pv[q])) * unpack4(pg[q]); *(u32x2*)(zo + (size_t)4 * q * DM) = pack4(z); }
                }
            } else if (ch < NCH) {
                int lo_ = lane; asm volatile("" : "+v"(lo_)); const int r = lo_ & 31, hh = lo_ >> 5, vt = c.wave;
                const LAS unsigned char* sl = lds + (ch & 3) * SLOT; const LAS unsigned char* rh = sl; const LAS unsigned char* yl = sl + 8192; const LAS unsigned char* mm = sl + 16384; const LAS unsigned char* nt = sl + 24576;
                bf16x8 hp[2][2];
#pragma unroll
                for (int s = 0; s < 2; ++s) { hp[0][s] = packacc(H0, s); hp[1][s] = packacc(H1, s); }
#pragma unroll
                for (int tt = 0; tt < 2; ++tt) {
                    f32x16 a; const int t = 32 * tt + r;
#pragma unroll
                    for (int g = 0; g < 4; ++g) { const f32x4 v = unpack4(*(const LAS u32x2*)(yl + s2_off(t, 4 * vt + g, 8 * hh))); a[4 * g] = v.x; a[4 * g + 1] = v.y; a[4 * g + 2] = v.z; a[4 * g + 3] = v.w; }
#pragma unroll
                    for (int kt = 0; kt < 2; ++kt)
#pragma unroll
                        for (int s = 0; s < 2; ++s) a = __builtin_amdgcn_mfma_f32_32x32x16_bf16(hp[kt][s], s2_frag(rh, t, 4 * kt + 2 * s, hh), a, 0, 0, 0);
                    LAS unsigned char* yo = lds + LDS_YB + (ch & 1) * (64 * 136) + t * 136 + (32 * vt + 4 * hh) * 2;
#pragma unroll
                    for (int g = 0; g < 4; ++g) { u32x2 w; w.x = cvt2bf(a[4 * g], a[4 * g + 1]); w.y = cvt2bf(a[4 * g + 2], a[4 * g + 3]); *(LAS u32x2*)(yo + 16 * g) = w; }
                }
                f32x16 n0, n1;
#pragma unroll
                for (int kq = 0; kq < 2; ++kq) {
                    f32x16 a; const int v = 32 * vt + r;
#pragma unroll
                    for (int g = 0; g < 4; ++g) { const f32x4 x = unpack4(*(const LAS u32x2*)(nt + s2_off(v, 4 * kq + g, 8 * hh))); a[4 * g] = x.x; a[4 * g + 1] = x.y; a[4 * g + 2] = x.z; a[4 * g + 3] = x.w; }
#pragma unroll
                    for (int kt = 0; kt < 2; ++kt)
#pragma unroll
                        for (int s = 0; s < 2; ++s) a = __builtin_amdgcn_mfma_f32_32x32x16_bf16(s2_frag(mm, 32 * kq + r, 4 * kt + 2 * s, hh), hp[kt][s], a, 0, 0, 0);
                    if (kq == 0) n0 = a; else n1 = a;
                }
                H0 = n0; H1 = n1;
            }
            asm volatile("s_waitcnt lgkmcnt(0)" ::: "memory"); __builtin_amdgcn_s_barrier(); asm volatile("" ::: "memory");
        }
#undef S2_ISSUE
    }
}
__device__ __forceinline__ void p_scan_post(const Ctx& c, const InL& in, const bf16_t* Yb, const float* bonus, const bf16_t* Vb, const bf16_t* Gt, bf16_t* Z) {
    PHASE_IDS;
    const int gt = c.bid * 512 + tid, NT_ = c.G * 512;
    const int col = (gt & 255) * 4;
    const f32x4 lw = *(const f32x4*)(IN(rw_lnx_w) + col), lb = *(const f32x4*)(IN(rw_lnx_b) + col);
    for (int it = gt; it < TG * 256; it += 4 * NT_) {
        u32x2 yw[4], vw[4], gw[4]; float bo[4];
#pragma unroll
        for (int q = 0; q < 4; ++q) { const int row = (it + q * NT_) >> 8; const size_t off = (size_t)row * DM + col;
            yw[q] = *(const u32x2*)(Yb + off); vw[q] = *(const u32x2*)(Vb + off); gw[q] = *(const u32x2*)(Gt + off); bo[q] = bonus[(size_t)row * NH + (col >> 6)]; }
#pragma unroll
        for (int q = 0; q < 4; ++q) { const int row = (it + q * NT_) >> 8; const size_t off = (size_t)row * DM + col;
            const f32x4 y4 = unpack4(yw[q]), v4 = unpack4(vw[q]), g4 = unpack4(gw[q]);
            const float mu = sum16((y4.x + y4.y) + (y4.z + y4.w)) * (1.f / 64.f);
            const f32x4 dy = y4 - mu; const float var = sum16((dy.x * dy.x + dy.y * dy.y) + (dy.z * dy.z + dy.w * dy.w)) * (1.f / 64.f);
            const f32x4 z = (dy * rsqrtf(var + GN_EPS) * lw + lb + bo[q] * v4) * g4;
            *(u32x2*)(Z + off) = pack4(z); }
    }
}

template <class Sched> __device__ __forceinline__ void p_select(const Ctx& c, const Sched& S, const float* logit, const float* bg, const float* be, unsigned* gcnt, int* tok_e, int* tok_p, float* tok_w, int* rowtab, LAS unsigned char* lds) {
    PHASE_IDS;
    for (int i = c.bid * 512 + tid; i < MAXSLOT; i += c.G * 512) { rowtab[i] = 0; rowtab[STAB_OFF + i] = -1; }
    LAS int* lcnt = (LAS int*)(lds + LDS_HIST); LAS int* lbase = lcnt + NB;
    for (int it = 0; ; ++it) {
        pg8::Unit su; if (!S.next(it, su)) break; const int tb = su.pm * 256;
        if (tid < NB) lcnt[tid] = 0;
        __syncthreads();
        const bool act_ = tid < 256; const int t = tb + (act_ ? tid : 0); const f32x4* lr = (const f32x4*)(logit + (size_t)t * 64);
        const f32x4 gl = lr[0] + *(const f32x4*)bg;
        int grp = 0; float gm = gl.x; if (gl.y > gm) { gm = gl.y; grp = 1; } if (gl.z > gm) { gm = gl.z; grp = 2; } if (gl.w > gm) { gm = gl.w; grp = 3; }
        const float pg = 1.f / ((__expf(gl.x - gm) + __expf(gl.y - gm)) + (__expf(gl.z - gm) + __expf(gl.w - gm)));
        const float* er = logit + (size_t)t * 64 + 4 + 8 * grp; const float* eb = be + 8 * grp;
        float ev[8];
#pragma unroll
        for (int e = 0; e < 8; ++e) ev[e] = er[e] + eb[e];
        int i0 = 0; float m0 = ev[0];
#pragma unroll
        for (int e = 1; e < 8; ++e) if (ev[e] > m0) { m0 = ev[e]; i0 = e; }
        int i1 = -1; float m1 = -3.0e38f;
#pragma unroll
        for (int e = 0; e < 8; ++e) if (e != i0 && ev[e] > m1) { m1 = ev[e]; i1 = e; }
        const float e1 = __expf(m1 - m0), w0 = pg / (1.f + e1), w1 = pg * e1 / (1.f + e1);
        const int ea = grp * 8 + i0, eb2 = NE + grp * 8 + i1;
        int la = 0, lb = 0; if (act_) { la = atomicAdd((int*)&lcnt[ea], 1); lb = atomicAdd((int*)&lcnt[eb2], 1); }
        __syncthreads();
        if (tid < NB) lbase[tid] = (int)atomicAdd(&gcnt[tid], (unsigned)lcnt[tid]);
        __syncthreads();
        if (act_) { tok_e[2 * t] = ea; tok_e[2 * t + 1] = eb2; tok_p[2 * t] = lbase[ea] + la; tok_p[2 * t + 1] = lbase[eb2] + lb; tok_w[2 * t] = w0; tok_w[2 * t + 1] = w1; }
        __syncthreads();
    }
}
__device__ __forceinline__ void moe_table(const Ctx& c, unsigned* gcnt, LAS unsigned char* lds) {
    PHASE_IDS;
    LAS int* toff = (LAS int*)(lds + LDS_TOFF);
    LAS int* tmp = (LAS int*)(lds + LDS_HIST);
    __syncthreads();
    if (tid < NB) tmp[tid] = ((int)__hip_atomic_load(gcnt + tid, RLX_AGENT) + 255) >> 8;
    __syncthreads();
    if (tid == 0) { int o = 0; for (int e = 0; e < NB; ++e) { toff[e] = o; o += tmp[e]; } toff[NB] = o; }
    __syncthreads();
    { LAS unsigned char* texp = (LAS unsigned char*)(lds + LDS_TEXP); const int ntile = toff[NB];
      for (int m = tid; m < ntile; m += 512) { int e = 0; for (int k = 1; k < NB; ++k) if (toff[k] <= m) e = k; texp[m] = (unsigned char)(e & (NE - 1)); } }
    __syncthreads();
}
__device__ __forceinline__ void p_gather(const Ctx& c, const float* ssq, const int* tok_e, const int* tok_p, const float* tok_w, int* tok_s, float* gate, int* rowtab, LAS unsigned char* lds) {
    PHASE_IDS;
    const LAS int* toff = (const LAS int*)(lds + LDS_TOFF);
    for (int i = c.bid * 512 + tid; i < 2 * T; i += c.G * 512) {
        const int slot = toff[tok_e[i]] * 256 + tok_p[i];
        tok_s[i] = slot; rowtab[slot] = (i >> 1) * (DM * 2); rowtab[STAB_OFF + slot] = i >> 1;
        { const float rs_ = pg8::rstd16(ssq, i >> 1); gate[2 * slot] = rs_; gate[2 * slot + 1] = tok_w[i] * rs_; }
    }
}
struct OrderMoE {
    const LAS int* toff; int G, c, npn; long sA, sBe, sBn; int mlo, mhi;
    __device__ __forceinline__ bool next(int i, pg8::Unit& u) const {
        const int cv = (G % 8 == 0) ? (c % 8) * (G / 8) + c / 8 : c;
        const int L = i * G + cv, m = mlo + L / npn; if (m >= mhi) return false;
        const int e = __builtin_amdgcn_readfirstlane((int)((const LAS unsigned char*)toff)[(LDS_TEXP - LDS_TOFF) + m]);
        u.pm = m; u.pn = L % npn; u.offA = m * sA; u.offB = e * sBe + u.pn * sBn; return true;
    }
};
template <bool FINAL> __device__ __forceinline__ void p_combine(const Ctx& c, bf16_t* h, float* outf, const bf16_t* Y, const int* tok_s, const float* gain, bf16_t* o) {
    PHASE_IDS;
    const int NGW = c.G * 8;
    for (int m0 = c.bid * 8 + c.wave; m0 < T; m0 += 4 * NGW) {
        int s0[4], s1[4];
#pragma unroll
        for (int q = 0; q < 4; ++q) { const int m = m0 + q * NGW; s0[q] = tok_s[2 * m]; s1[q] = tok_s[2 * m + 1]; }
        u32x2 rh[4][4], ya[4][4], yb[4][4];
#pragma unroll
        for (int q = 0; q < 4; ++q) { const int m = m0 + q * NGW; const u32x2* hp = (const u32x2*)(h + (size_t)m * DM) + lane; const u32x2* y0 = (const u32x2*)(Y + (size_t)s0[q] * DM) + lane; const u32x2* y1 = (const u32x2*)(Y + (size_t)s1[q] * DM) + lane;
#pragma unroll
            for (int j = 0; j < 4; ++j) { rh[q][j] = hp[64 * j]; ya[q][j] = y0[64 * j]; yb[q][j] = y1[64 * j]; } }
#pragma unroll
        for (int q = 0; q < 4; ++q) { const int m = m0 + q * NGW; f32x4 v[4]; float ss = 0.f;
#pragma unroll
            for (int j = 0; j < 4; ++j) { v[j] = unpack4(rh[q][j]) + unpack4(ya[q][j]) + unpack4(yb[q][j]); ss += (v[j].x * v[j].x + v[j].y * v[j].y) + (v[j].z * v[j].z + v[j].w * v[j].w); }
            const float rs = rsqrtf(wave_sum(ss) * (1.f / DM) + NORM_EPS);
#pragma unroll
            for (int j = 0; j < 4; ++j) { const f32x4 g = ((const f32x4*)gain)[lane + 64 * j];
                if (FINAL) ((f32x4*)(outf + (size_t)m * DM))[lane + 64 * j] = v[j] * rs * g;
                else { ((u32x2*)(h + (size_t)m * DM))[lane + 64 * j] = pack4(v[j]); ((u32x2*)(o + (size_t)m * DM))[lane + 64 * j] = pack4(v[j] * rs * g); } } }
    }
}
__device__ __forceinline__ void p_final(const Ctx& c, const bf16_t* h, const float* ssq, const float* gain, float* outf) {
    PHASE_IDS;
    const int NGW = c.G * 8;
    f32x4 g[4];
#pragma unroll
    for (int j = 0; j < 4; ++j) g[j] = ((const f32x4*)gain)[lane + 64 * j];
    for (int m0 = c.bid * 8 + c.wave; m0 < T; m0 += 4 * NGW) {
        u32x2 rh[4][4]; float rs[4];
#pragma unroll
        for (int q = 0; q < 4; ++q) { const int m = m0 + q * NGW; const u32x2* hp = (const u32x2*)(h + (size_t)m * DM) + lane; rs[q] = pg8::rstd16(ssq, m);
#pragma unroll
            for (int j = 0; j < 4; ++j) rh[q][j] = hp[64 * j]; }
#pragma unroll
        for (int q = 0; q < 4; ++q) { const int m = m0 + q * NGW;
#pragma unroll
            for (int j = 0; j < 4; ++j) __builtin_nontemporal_store(unpack4(rh[q][j]) * rs[q] * g[j], (f32x4*)(outf + (size_t)m * DM) + lane + 64 * j); }
    }
}
constexpr float STICK_EXIT = 30.f * 1.4426950408889634f;
__device__ __forceinline__ void p_stick2(const Ctx& c, const bf16_t* Q, const bf16_t* Kb, const bf16_t* Vb, bf16_t* O, unsigned* queue, LAS unsigned char* lds) {
    PHASE_IDS;
    const int r = lane & 31, hh = lane >> 5;
    LAS unsigned char* Kw = lds + c.wave * 9216; LAS unsigned char* Vt = Kw + 4608;
    f16x8 Lf[2];
#pragma unroll
    for (int s = 0; s < 2; ++s)
#pragma unroll
        for (int j = 0; j < 8; ++j) Lf[s][j] = (16 * s + 8 * (j >> 2) + 4 * hh + (j & 3) >= r) ? (_Float16)1.0f : (_Float16)0.0f;
    constexpr int NUNIT = BATCH * NH * (SEQ / 32), QLEN = NUNIT / 8, QBATCH = 4;
    int qi = c.bid & 7, qtries = 0, ubase = 0, uleft = 0;
    for (;;) {
        if (uleft == 0) {
            unsigned got = 0u; bool ok = false;
            while (qtries < 8) {
                if (lane == 0) got = __hip_atomic_fetch_add(queue + 64 * qi, (unsigned)QBATCH, RLX_AGENT);
                got = (unsigned)__builtin_amdgcn_readfirstlane((int)got);
                if (got < (unsigned)QLEN) { ok = true; break; }
                qi = (qi + 1) & 7; ++qtries;
            }
            if (!ok) break;
            ubase = qi * QLEN + (int)got; uleft = QBATCH;
        }
        const int u = ubase; ++ubase; --uleft;
        const int qb = u % (SEQ / 32), h = (u / (SEQ / 32)) % NH, b = u / ((SEQ / 32) * NH);
        const size_t rowbase = (size_t)b * SEQ; const int q0 = qb * 32;
        bf16x8 qf[4];
#pragma unroll
        for (int s = 0; s < 4; ++s) qf[s] = *(const bf16x8*)(Q + (rowbase + q0 + r) * DM + h * HD + 16 * s + 8 * hh);
        float carry = 0.f; f32x16 o0, o1;
#pragma unroll
        for (int i = 0; i < 16; ++i) { o0[i] = 0.f; o1[i] = 0.f; }
        u32x4 nk[4], nv[4];
#define STICK_LOAD(jt_) do { _Pragma("unroll") for (int i_ = 0; i_ < 4; ++i_) { const int chunk_ = lane + 64 * i_; const size_t g_ = (rowbase + (jt_) * 32 + (chunk_ >> 3)) * DM + h * HD + (chunk_ & 7) * 8; \
            nk[i_] = *(const u32x4*)(Kb + g_); nv[i_] = *(const u32x4*)(Vb + g_); } } while (0)
        STICK_LOAD(qb);
        for (int jt = qb; jt >= 0; --jt) {
#pragma unroll
            for (int i = 0; i < 4; ++i) { const int chunk = lane + 64 * i, row = chunk >> 3, cc = chunk & 7;
                const u32x4 kv = nk[i], vv = nv[i];
                *(LAS u32x4*)(Kw + row * 144 + cc * 16) = kv;
                const unsigned px = (unsigned)__builtin_amdgcn_update_dpp(0, (int)vv.x, 0x128, 0xF, 0xF, true), py = (unsigned)__builtin_amdgcn_update_dpp(0, (int)vv.y, 0x128, 0xF, 0xF, true);
                const unsigned pz = (unsigned)__builtin_amdgcn_update_dpp(0, (int)vv.z, 0x128, 0xF, 0xF, true), pw = (unsigned)__builtin_amdgcn_update_dpp(0, (int)vv.w, 0x128, 0xF, 0xF, true);
                const bool odd = (row & 1) != 0; const unsigned a0 = odd ? pz : vv.x, a1 = odd ? pw : vv.y, b0 = odd ? vv.z : px, b1 = odd ? vv.w : py;
                LAS unsigned* vt = (LAS unsigned*)(Vt + (cc * 8 + (odd ? 4 : 0)) * 72 + (row & ~1) * 2);
                vt[0 * 18] = (a0 & 0xffffu) | (b0 << 16); vt[1 * 18] = (a0 >> 16) | (b0 & 0xffff0000u); vt[2 * 18] = (a1 & 0xffffu) | (b1 << 16); vt[3 * 18] = (a1 >> 16) | (b1 & 0xffff0000u); }
            if (jt > 0) STICK_LOAD(jt - 1);
            f32x16 p;
#pragma unroll
            for (int i = 0; i < 16; ++i) p[i] = 0.f;
#pragma unroll
            for (int s = 0; s < 4; ++s) { const bf16x8 kf = *(const LAS bf16x8*)(Kw + r * 144 + s * 32 + hh * 16); p = __builtin_amdgcn_mfma_f32_32x32x16_bf16(kf, qf[s], p, 0, 0, 0); }
            const bool diag = (jt == qb);
            float sp[16]; f32x16 cum;
#pragma unroll
            for (int i = 0; i < 16; ++i) { const int kr = (i & 3) + 8 * (i >> 2) + 4 * hh; const bool valid = !diag || (kr < r); const float z = p[i];
                sp[i] = valid ? (fmaxf(z, 0.f) + __builtin_amdgcn_logf(1.f + __builtin_amdgcn_exp2f(-fabsf(z)))) : 0.f; cum[i] = carry; }
#pragma unroll
            for (int s = 0; s < 2; ++s) { u32x4 w; w.x = cvt2h(sp[8 * s], sp[8 * s + 1]); w.y = cvt2h(sp[8 * s + 2], sp[8 * s + 3]); w.z = cvt2h(sp[8 * s + 4], sp[8 * s + 5]); w.w = cvt2h(sp[8 * s + 6], sp[8 * s + 7]);
                cum = __builtin_amdgcn_mfma_f32_32x32x16_f16(Lf[s], __builtin_bit_cast(f16x8, w), cum, 0, 0, 0); }
            float att[16];
#pragma unroll
            for (int i = 0; i < 16; ++i) { const int kr = (i & 3) + 8 * (i >> 2) + 4 * hh; const bool valid = !diag || (kr < r); att[i] = valid ? __builtin_amdgcn_exp2f(p[i] - cum[i]) : 0.f; }
            { const unsigned cu_ = __float_as_uint(cum[0]); carry = __uint_as_float(__builtin_amdgcn_permlane32_swap(cu_, cu_, false, false)[0]); }
#pragma unroll
            for (int s = 0; s < 2; ++s) { u32x4 w; w.x = cvt2bf(att[8 * s], att[8 * s + 1]); w.y = cvt2bf(att[8 * s + 2], att[8 * s + 3]); w.z = cvt2bf(att[8 * s + 4], att[8 * s + 5]); w.w = cvt2bf(att[8 * s + 6], att[8 * s + 7]);
                const bf16x8 af = __builtin_bit_cast(bf16x8, w);
                { const u32x2 lo = *(const LAS u32x2*)(Vt + r * 72 + (16 * s + 4 * hh) * 2), hi = *(const LAS u32x2*)(Vt + r * 72 + (16 * s + 8 + 4 * hh) * 2);
                  u32x4 v; v.x = lo.x; v.y = lo.y; v.z = hi.x; v.w = hi.y; o0 = __builtin_amdgcn_mfma_f32_32x32x16_bf16(__builtin_bit_cast(bf16x8, v), af, o0, 0, 0, 0); }
                { const u32x2 lo = *(const LAS u32x2*)(Vt + (32 + r) * 72 + (16 * s + 4 * hh) * 2), hi = *(const LAS u32x2*)(Vt + (32 + r) * 72 + (16 * s + 8 + 4 * hh) * 2);
                  u32x4 v; v.x = lo.x; v.y = lo.y; v.z = hi.x; v.w = hi.y; o1 = __builtin_amdgcn_mfma_f32_32x32x16_bf16(__builtin_bit_cast(bf16x8, v), af, o1, 0, 0, 0); } }
            if (__all(carry > STICK_EXIT)) break;
        }
#undef STICK_LOAD
        bf16_t* orow = O + (rowbase + q0 + r) * DM + h * HD + 4 * hh;
#pragma unroll
        for (int g = 0; g < 4; g += 2) { u32x2 w0, w1, x0, x1;
            w0.x = cvt2bf(o0[4 * g], o0[4 * g + 1]); w0.y = cvt2bf(o0[4 * g + 2], o0[4 * g + 3]); w1.x = cvt2bf(o0[4 * g + 4], o0[4 * g + 5]); w1.y = cvt2bf(o0[4 * g + 6], o0[4 * g + 7]);
            x0.x = cvt2bf(o1[4 * g], o1[4 * g + 1]); x0.y = cvt2bf(o1[4 * g + 2], o1[4 * g + 3]); x1.x = cvt2bf(o1[4 * g + 4], o1[4 * g + 5]); x1.y = cvt2bf(o1[4 * g + 6], o1[4 * g + 7]);
            store_pair16(orow + 8 * g, hh, w0, w1); store_pair16(orow + 32 + 8 * g, hh, x0, x1); }
    }
}

struct OrderPre {
    int G, c; bool vo;
    __device__ __forceinline__ bool next(int i, pg8::Unit& u) const {
        const int cv = (G % 8 == 0) ? (c % 8) * (G / 8) + c / 8 : c;
        const int L = i * G + cv; if (L >= BATCH * 16) return false;
        const int b = L / 16, s1 = (L / 4) % 4, s0 = L % 4;
        const long om = ((long)b * NMEM * DM + (vo ? s0 : s1) * XD) * 2, ow = ((long)(vo ? s1 : s0) * 256 * DM + (vo ? s0 : s1) * XD) * 2;
        u.pm = b * 4 + s1; u.pn = s0; u.offA = vo ? ow : om; u.offB = vo ? om : ow; return true;
    }
};
struct OrderXS {
    int G, c;
    __device__ __forceinline__ bool next(int i, pg8::Unit& u) const {
        const int cv = (G % 8 == 0) ? (c % 8) * (G / 8) + c / 8 : c;
        const int L = i * G + cv; if (L >= BATCH * 4 * (SEQ / 256)) return false;
        const int b = L / 32, hh = (L / 8) % 4, it = L % 8;
        u.pm = b * 8 + it; u.pn = hh; u.offA = (long)u.pm * 256 * DM * 2; u.offB = ((long)b * DM + hh * 256) * DM * 2; return true;
    }
};

constexpr int NPHASE = 2 + 7 * NGRP + 7 + 3 + 8;
#define AR(i) ((bf16_t*)(ws + WS_ARENA + (size_t)(i) * BUF))
#define HB(i) ((bf16_t*)(ws + WS_ARENA + (size_t)(i) * HBUF))
#define SSQ(i) ((float*)(ws + WS_SSQ) + (size_t)(i) * T * 16)
#define HBR ((bf16_t*)(ws + WS_HB))
#define PH_BEGIN if (lo <= ph && ph < hi) {
#define PH_END   if (!MK_MULTI && ph + 1 < hi) xcd_barrier(bar); } ++ph;

template <int L> __device__ __forceinline__ void xa_fold(const Ctx& c, unsigned char* ws, LAS unsigned char* lds) {
    using namespace pg8;
    bf16_t* KQ = AR(2); bf16_t* VO = AR(2) + (size_t)BATCH * DM * DM;
    { Gemm gm{(const bf16_t*)(ws + WS_MEMK), (const bf16_t*)(ws + WS_XAWQ) + (size_t)L * DM * DM, DM, DM, XD}; OrderPre S{c.G, c.bid, false}; EpiBf16 E{KQ, DM, 0, 0, 1.f, nullptr}; gemm_phase<EpiBf16, OrderPre, true>(lds, c.wave, gm, S, E); }
    { Gemm gm{(const bf16_t*)(ws + WS_XAWO) + (size_t)L * DM * DM, (const bf16_t*)(ws + WS_MEMVT), DM, DM, XD}; OrderPre S{c.G, c.bid, true}; EpiBf16 E{VO, DM, 0, 0, 1.f, nullptr}; gemm_phase<EpiBf16, OrderPre, true>(lds, c.wave, gm, S, E); }
}
template <int GI> __device__ __forceinline__ void rwkv_group(const Ctx& c, const InL& in, unsigned char* ws, float* hres, LAS unsigned char* lds, const XcdBarrier& bar, int lo, int hi, int& ph) {
    using namespace pg8;
    bf16_t* pq = HB(7); bf16_t* act = HB(7) + (size_t)TG * 512;
    PH_BEGIN p_norm_shift(c, in, GI, HB(0), HB(1), HB(2), HB(3)); PH_END
    PH_BEGIN
    { Gemm gm{HB(1), (const bf16_t*)(ws + WS_WR), DM, DM, DM}; OrderRKV S; S.init(TG, 3 * DM, DM, DM, c.G, c.bid); S.aStep = (long)HBUF;
      EpiBf16 E{HB(4), DM, DM, HBUF / 2, 1.f, nullptr}; gemm_phase<EpiBf16, OrderRKV, true>(lds, c.wave, gm, S, E); }
    { Gemm gm{HB(0), (const bf16_t*)(ws + WS_WPQ), DM, DM, DM}; OrderMN S; S.init(TG, 512, DM, DM, c.G, c.bid); EpiBf16 E{pq, 512, 0, 0, 1.f, nullptr}; gemm_phase<EpiBf16, OrderMN, true>(lds, c.wave, gm, S, E); }
    PH_END
    PH_BEGIN p_lora_act(c, pq, act); PH_END
    PH_BEGIN
    { Gemm gm{act, (const bf16_t*)(ws + WS_WL2), 256, 256, 128}; OrderLora2 S; S.init(TG, 3072, 256, 256, c.G, c.bid); EpiLora E{HB(0), (size_t)TG * DM, IN(rw_w0), IN(rw_a0)}; gemm_phase<EpiLora, OrderLora2, true>(lds, c.wave, gm, S, E); }
    PH_END
    PH_BEGIN p_scan_s1(c, in, HB(4), HB(5), HB(6), HB(0), HB(1), HB(7), HB(8), HB(9), HB(10), (float*)(ws + WS_BONUS), lds);
    PH_END
    PH_BEGIN p_scan_s2(c, in, HB(7), HB(8), HB(9), HB(10), (const float*)(ws + WS_BONUS), HB(6), HB(2), HB(3), lds); PH_END
    PH_BEGIN
    { Gemm gm{HB(3), (const bf16_t*)(ws + WS_WO0), DM, DM, DM}; OrderMN S; S.init(TG, DM, DM, DM, c.G, c.bid);
      EpiResB E{IN(x) + (size_t)GI * TG * DM, HBR + (size_t)GI * TG * DM, DM, SSQ(0) + (size_t)GI * TG * 16}; gemm_phase<EpiResB, OrderMN, true>(lds, c.wave, gm, S, E); }
    if (GI == NGRP - 1) xa_fold<0>(c, ws, lds);
    PH_END
}
template <int L> __device__ __forceinline__ void layer_tail(const Ctx& c, const InL& in, unsigned char* ws, float* outp, LAS unsigned char* lds, const XcdBarrier& bar, int lo, int hi, int& ph) {
    using namespace pg8;
    unsigned* ctl = (unsigned*)(ws + WS_CTL);
    bf16_t* KQ = AR(2); bf16_t* VO = AR(2) + (size_t)BATCH * DM * DM;
    PH_BEGIN
    { Gemm gm{HBR, KQ, DM, DM, DM}; OrderXS S{c.G, c.bid}; EpiSoftmax E{AR(0), DM, 0.0625f, (LAS float*)(lds + LDS_SM), SSQ(0)}; gemm_phase<EpiSoftmax, OrderXS, true>(lds, c.wave, gm, S, E); }
    PH_END
    PH_BEGIN
    { Gemm gm{AR(0), VO, DM, DM, DM}; OrderXS S{c.G, c.bid}; EpiResB E{nullptr, HBR, DM, SSQ(1)}; gemm_phase<EpiResB, OrderXS, true>(lds, c.wave, gm, S, E); }
    PH_END
    bf16_t* xs = AR(1); bf16_t* hid = (bf16_t*)(ws + WS_ARENA + BUF + (size_t)MAXSLOT * DM * 2);
    unsigned* gcnt = ctl + CW_CNT + 128 * L;
    float* logit = (float*)(ws + WS_LOGIT); int* tok_e = (int*)(ws + WS_TOKE); int* tok_p = (int*)(ws + WS_TOKP); float* tok_w = (float*)(ws + WS_TOKW); int* tok_s = (int*)(ws + WS_TOKS); float* gate = (float*)(ws + WS_GATE);
    PH_BEGIN
    { Gemm gm{HBR, (const bf16_t*)(ws + WS_ROUTE) + (size_t)L * 256 * DM, DM, DM, DM}; OrderMN S; S.init(T, 256, DM, DM, c.G, c.bid); EpiRoute E{logit, SSQ(1)}; gemm_phase<EpiRoute, OrderMN, true>(lds, c.wave, gm, S, E);
      __builtin_amdgcn_fence(__ATOMIC_ACQUIRE, "agent");
      p_select(c, S, logit, IN(moe_bg) + L * NG, IN(moe_be) + L * NE, gcnt, tok_e, tok_p, tok_w, (int*)(ws + WS_ROWTAB), lds); }
    PH_END
    PH_BEGIN moe_table(c, gcnt, lds); p_gather(c, SSQ(1), tok_e, tok_p, tok_w, tok_s, gate, (int*)(ws + WS_ROWTAB), lds); PH_END
    PH_BEGIN
    { moe_table(c, gcnt, lds); const LAS int* toff = (const LAS int*)(lds + LDS_TOFF);
      Gemm gm{HBR, (const bf16_t*)(ws + WS_W13) + (size_t)L * NE * 512 * DM, DM, DM, DM}; OrderMoE S{toff, c.G, c.bid, 2, (long)256 * DM * 2, (long)512 * DM * 2, (long)256 * DM * 2, 0, __builtin_amdgcn_readfirstlane(toff[NB])};
      EpiSwiGLU E{hid, gate}; gemm_phase_g<EpiSwiGLU, OrderMoE, true>(lds, c.wave, gm, S, E, (const int*)(ws + WS_ROWTAB), (LAS unsigned*)(lds + LDS_GTAB)); }
    PH_END
    PH_BEGIN
    { moe_table(c, gcnt, lds); const LAS int* toff = (const LAS int*)(lds + LDS_TOFF);
      Gemm gm{hid, (const bf16_t*)(ws + WS_W2) + (size_t)L * NE * DM * DF, DF, DF, DF}; OrderMoE S{toff, c.G, c.bid, 4, (long)256 * DF * 2, (long)DM * DF * 2, (long)256 * DF * 2, 0, __builtin_amdgcn_readfirstlane(toff[NE])};
      EpiScatter E{HBR, (const int*)(ws + WS_ROWTAB) + STAB_OFF, nullptr, (LAS int*)(lds + LDS_GTAB)}; gemm_phase<EpiScatter, OrderMoE, true>(lds, c.wave, gm, S, E); }
    PH_END
    PH_BEGIN
    { moe_table(c, gcnt, lds); const LAS int* toff = (const LAS int*)(lds + LDS_TOFF);
      Gemm gm{hid, (const bf16_t*)(ws + WS_W2) + (size_t)L * NE * DM * DF, DF, DF, DF}; OrderMoE S{toff, c.G, c.bid, 4, (long)256 * DF * 2, (long)DM * DF * 2, (long)256 * DF * 2, __builtin_amdgcn_readfirstlane(toff[NE]), __builtin_amdgcn_readfirstlane(toff[NB])};
      EpiScatter E{HBR, (const int*)(ws + WS_ROWTAB) + STAB_OFF, SSQ(0), (LAS int*)(lds + LDS_GTAB)}; gemm_phase<EpiScatter, OrderMoE, true>(lds, c.wave, gm, S, E); }
    PH_END
    if (L == 1) { PH_BEGIN p_final(c, HBR, SSQ(0), IN(norm_final), outp); PH_END }
}

__global__ void __launch_bounds__(512, 2) fwd_kernel(Args args) {
    extern __shared__ __attribute__((aligned(16))) unsigned char lds_raw[];
    LAS unsigned char* lds = (LAS unsigned char*)lds_raw;
    Ctx c; c.wave = __builtin_amdgcn_readfirstlane((int)(threadIdx.x >> 6)); c.bid = blockIdx.x; c.G = gridDim.x; c.gw = c.bid * 8 + c.wave; c.NGW = c.G * 8;
    unsigned char* ws = args.ws; float* hres = args.out;
    unsigned* ctl = (unsigned*)(ws + WS_CTL);
    { const int t0 = c.wave * 64 + lane_id();
      for (int u = t0; u < (LDS_BYTES - LDSCTL_OFF) / 4; u += 512) ((LAS unsigned*)(lds + LDSCTL_OFF))[u] = 0u;
      __syncthreads();
      if (t0 < 37) ((LAS unsigned long long*)(lds + LDS_INP))[t0] = ((const unsigned long long*)__builtin_amdgcn_kernarg_segment_ptr())[t0];
      __syncthreads(); }
    InL in; in.p = (const LAS unsigned long long*)(lds + LDS_INP);
    XcdBarrier bar; bar.bar = ctl + CW_BAR; bar.x = 0; bar.st = nullptr;
    if (!MK_MULTI) bar = xcd_barrier_post(ctl + CW_BAR, (volatile LAS unsigned*)(lds + LDS_XB));
    const int lo = args.ph_lo, hi = args.ph_hi; int ph = 0;
    using namespace pg8;
    PH_BEGIN
    p_prologue(c, in, ws, lds);
    PH_END
    PH_BEGIN
    { Gemm g{(const bf16_t*)(ws + WS_MEMN), (const bf16_t*)(ws + WS_XAWKV), DM, DM, DM}; OrderMN S; S.init(BATCH * NMEM, 2 * DM, DM, DM, c.G, c.bid);
      EpiBf16 E{(bf16_t*)(ws + WS_MEMK), DM, DM, (WS_MEMVT - WS_MEMK) / 2, 1.f, nullptr}; gemm_phase<EpiBf16, OrderMN, true>(lds, c.wave, g, S, E); }
    PH_END
    rwkv_group<0>(c, in, ws, hres, lds, bar, lo, hi, ph);
    rwkv_group<1>(c, in, ws, hres, lds, bar, lo, hi, ph);
    layer_tail<0>(c, in, ws, hres, lds, bar, lo, hi, ph);
    PH_BEGIN
    { Gemm gm{HBR, (const bf16_t*)(ws + WS_SBQKV), DM, DM, DM}; OrderMN S; S.init(T, 3 * DM, DM, DM, c.G, c.bid); EpiBf16 E{AR(1), DM, DM, (size_t)T * DM, 0.125f * 1.4426950408889634f, SSQ(0)}; gemm_phase<EpiBf16, OrderMN, true>(lds, c.wave, gm, S, E); }
    PH_END
    PH_BEGIN
    p_stick2(c, AR(1), AR(2), AR(3), AR(0), (unsigned*)(ws + WS_CTL) + CW_STQ, lds);
    PH_END
    PH_BEGIN
    { Gemm gm{AR(0), (const bf16_t*)(ws + WS_SBWO), DM, DM, DM}; OrderMN S; S.init(T, DM, DM, DM, c.G, c.bid); EpiResB E{nullptr, HBR, DM, SSQ(0)}; gemm_phase<EpiResB, OrderMN, true>(lds, c.wave, gm, S, E); }
    xa_fold<1>(c, ws, lds);
    PH_END
    layer_tail<1>(c, in, ws, hres, lds, bar, lo, hi, ph);
}
#undef PH_BEGIN
#undef PH_END

extern "C" void kernel_launch(void* const* d_in, const int* in_sizes, int n_in, void* d_out, int out_size, void* d_ws, size_t ws_size, hipStream_t stream) {
    static int grid = 0;
    if (grid == 0) {
        if (n_in != 37 || out_size != T * DM || ws_size < WS_END) { fprintf(stderr, "kernel_launch: unexpected shapes (n_in %d, out %d, ws %zu < %zu)\n", n_in, out_size, ws_size, (size_t)WS_END); grid = -1; return; }
        int dev = 0, cus = 0, per_cu = 0;
        if (hipGetDevice(&dev) != hipSuccess || hipDeviceGetAttribute(&cus, hipDeviceAttributeMultiprocessorCount, dev) != hipSuccess) { grid = -1; return; }
        if (hipFuncSetAttribute((const void*)fwd_kernel, hipFuncAttributeMaxDynamicSharedMemorySize, LDS_BYTES) != hipSuccess) { fprintf(stderr, "kernel_launch: hipFuncSetAttribute failed\n"); grid = -1; return; }
        if (hipOccupancyMaxActiveBlocksPerMultiprocessor(&per_cu, (const void*)fwd_kernel, 512, LDS_BYTES) != hipSuccess || per_cu < 1) fprintf(stderr, "kernel_launch: occupancy query reports %d\n", per_cu);
        (void)hipGetLastError();
        grid = 1; while (grid * 2 <= cus && grid * 2 <= 256) grid *= 2;
    }
    if (grid < 0) return;
    if (hipMemsetAsync((char*)d_ws + WS_CTL, 0, CTL_ZERO_BYTES, stream) != hipSuccess) return;
    Args a{};
    const float** ip = (const float**)&a.in;
    for (int i = 0; i < 37; ++i) ip[i] = (const float*)d_in[i];
    a.out = (float*)d_out; a.ws = (unsigned char*)d_ws;
#if MK_MULTI
    for (int p = 0; p < NPHASE; ++p) { a.ph_lo = p; a.ph_hi = p + 1; hipLaunchKernelGGL(fwd_kernel, dim3(grid), dim3(512), LDS_BYTES, stream, a); }
#else
    a.ph_lo = 0; a.ph_hi = NPHASE; hipLaunchKernelGGL(fwd_kernel, dim3(grid), dim3(512), LDS_BYTES, stream, a);
#endif
}
```

```cpp
#include <hip/hip_runtime.h>
#include <cstdio>
#include <cstdint>
#include <cstddef>

#ifndef MK_MULTI
#define MK_MULTI 0
#endif

#define GAS __attribute__((address_space(1)))
#define LAS __attribute__((address_space(3)))
typedef unsigned short bf16_t;
typedef short bf16x8 __attribute__((ext_vector_type(8)));
typedef float f32x4 __attribute__((ext_vector_type(4)));
typedef float f32x2 __attribute__((ext_vector_type(2)));
typedef unsigned u32x4 __attribute__((ext_vector_type(4)));
typedef unsigned u32x2 __attribute__((ext_vector_type(2)));

constexpr int BATCH = 32, SEQ = 2048, DM = 1024, T = BATCH * SEQ;
constexpr int NH = 16, HD = 64;
constexpr int NMEM = 256, XH = 4, XD = 256;
constexpr int NG = 4, NEG = 8, NE = 32, DF = 256;
constexpr int NGRP = 2;
constexpr int TG = T / NGRP, BG = BATCH / NGRP;
constexpr float NORM_EPS = 1e-6f, GN_EPS = 64e-5f;
constexpr int STAB_OFF = 256 * 1024;
constexpr int NB = 2 * NE;
constexpr int MAXSLOT = 2 * T + NB * 256;

namespace pg8 {
constexpr int BM = 256, BK = 64, HALF = 128, HTB = HALF * BK * 2, STAGE_BYTES = 8 * HTB, NXCD = 8, WGM = 8;
__host__ __device__ __forceinline__ int lds_byte(int r, int c) { const int st = (r >> 4) * 2 + (c >> 5), rr = r & 15, cc = c & 31, ob = rr * 64 + cc * 2; return st * 1024 + (ob ^ (((ob >> 9) & 1) << 5)); }
__host__ __device__ __forceinline__ void stage_rc(int b, int& R, int& C) { const int st = b / 1024, sb = b % 1024, swz = sb ^ (((sb >> 9) & 1) << 5); R = (st >> 1) * 16 + swz / 64; C = (st & 1) * 32 + (swz % 64) / 2; }
__host__ __device__ __forceinline__ int perm32(int rho) { const int n = rho >> 4, i = rho & 15; return 8 * (i >> 2) + 4 * n + (i & 3); }

struct Unit { int pm, pn; long offA, offB; };
struct Gemm { const bf16_t* A; const bf16_t* Bt; int lda, ldb, K; };

__device__ __forceinline__ unsigned cvt_pk_bf16(float lo, float hi) { unsigned r; asm volatile("v_cvt_pk_bf16_f32 %0, %1, %2" : "=v"(r) : "v"(lo), "v"(hi)); return r; }

struct OrderMN {
    int nM, nN, nwg, G, c; long sA, sB;
    __device__ void init(int M, int N, int lda, int ldb, int G_, int c_) { nM = M / BM; nN = N / BM; nwg = nM * nN; G = G_; c = c_; sA = (long)BM * lda * 2; sB = (long)BM * ldb * 2; }
    __device__ __forceinline__ bool next(int i, Unit& u) const {
        const long L = (long)i * G + c; if (L >= nwg) return false;
        int wgid = (int)L; { const int q = nwg / NXCD, r = nwg % NXCD, xcd = wgid % NXCD, off = wgid / NXCD; wgid = (xcd < r ? xcd * (q + 1) : r * (q + 1) + (xcd - r) * q) + off; }
        const int nig = WGM * nN, gid = wgid / nig, fm = gid * WGM, gsz = (nM - fm) < WGM ? (nM - fm) : WGM;
        u.pm = fm + ((wgid % nig) % gsz); u.pn = (wgid % nig) / gsz; u.offA = u.pm * sA; u.offB = u.pn * sB; return true;
    }
};

struct OrderLora2 : OrderMN {
    __device__ __forceinline__ bool next(int i, Unit& u) const { if (!OrderMN::next(i, u)) return false; if (u.pn >= 8) { u.offA += 256; u.offB += 256; } return true; }
};
struct OrderRKV : OrderMN {
    long aStep;
    __device__ __forceinline__ bool next(int i, Unit& u) const { if (!OrderMN::next(i, u)) return false; u.offA += (long)(u.pn >> 2) * aStep; return true; }
};
__device__ __forceinline__ float xadd16(float x) { const unsigned u = __float_as_uint(x); const auto r = __builtin_amdgcn_permlane16_swap(u, u, false, false); return __uint_as_float(r[0]) + __uint_as_float(r[1]); }
__device__ __forceinline__ float xadd32(float x) { const unsigned u = __float_as_uint(x); const auto r = __builtin_amdgcn_permlane32_swap(u, u, false, false); return __uint_as_float(r[0]) + __uint_as_float(r[1]); }
__device__ __forceinline__ float xmax16(float x) { const unsigned u = __float_as_uint(x); const auto r = __builtin_amdgcn_permlane16_swap(u, u, false, false); return fmaxf(__uint_as_float(r[0]), __uint_as_float(r[1])); }
__device__ __forceinline__ float xmax32(float x) { const unsigned u = __float_as_uint(x); const auto r = __builtin_amdgcn_permlane32_swap(u, u, false, false); return fmaxf(__uint_as_float(r[0]), __uint_as_float(r[1])); }
__device__ __forceinline__ float rstd16(const float* ssq, int row) { const f32x4* p = (const f32x4*)(ssq + (size_t)row * 16); const f32x4 a = p[0], b = p[1], c = p[2], d = p[3];
    const f32x4 s = (a + b) + (c + d); return rsqrtf(((s[0] + s[1]) + (s[2] + s[3])) * (1.f / 1024.f) + 1e-6f); }
__device__ __forceinline__ f32x4 rstd16q_ld(const float* ssq, int row, int fq) { return *(const f32x4*)(ssq + (size_t)row * 16 + 4 * fq); }
__device__ __forceinline__ float rstd16q_fin(f32x4 a) { return rsqrtf(xadd32(xadd16((a[0] + a[1]) + (a[2] + a[3]))) * (1.f / 1024.f) + 1e-6f); }
struct EpiBf16 {
    static constexpr bool PERM = true;
    static constexpr bool HAS_PRE = false;
    bf16_t* O; int ldc; int split_cols; size_t split_stride; float scale0; const float* ssq;
    __device__ __forceinline__ void operator()(const f32x4 (&acc)[2][2][4][2], const Unit& u, int wr, int wc, int fr, int fq) const {
        const int row0 = u.pm * BM + wr * 64 + fr; int colt = u.pn * BM; bf16_t* base = O;
        float sc0 = scale0; if (split_cols) { const int t = colt / split_cols; base += (size_t)t * split_stride; colt -= t * split_cols; if (t != 0) sc0 = 1.f; }
        const int col0 = colt + wc * 32 + 8 * fq;
        f32x4 qa[2][4];
        if (ssq) {
#pragma unroll
            for (int ai = 0; ai < 2; ++ai)
#pragma unroll
                for (int m = 0; m < 4; ++m) qa[ai][m] = rstd16q_ld(ssq, row0 + ai * HALF + m * 16, fq);
            asm volatile("" ::: "memory"); }
#pragma unroll
        for (int ai = 0; ai < 2; ++ai)
#pragma unroll
            for (int m = 0; m < 4; ++m) { const int row = row0 + ai * HALF + m * 16; bf16_t* rowp = base + (size_t)row * ldc + col0;
                const float sc = ssq ? sc0 * rstd16q_fin(qa[ai][m]) : sc0;
#pragma unroll
                for (int bj = 0; bj < 2; ++bj) { const f32x4 v0 = acc[ai][bj][m][0] * sc, v1 = acc[ai][bj][m][1] * sc;
                    u32x4 w; w.x = cvt_pk_bf16(v0[0], v0[1]); w.y = cvt_pk_bf16(v0[2], v0[3]); w.z = cvt_pk_bf16(v1[0], v1[1]); w.w = cvt_pk_bf16(v1[2], v1[3]);
                    *(u32x4*)(rowp + bj * HALF) = w; } }
    }
};
__device__ __forceinline__ float sigmoidf_(float x) { return __builtin_amdgcn_rcpf(1.f + __expf(-x)); }
struct EpiSoftmax {
    static constexpr bool PERM = true;
    static constexpr bool HAS_PRE = false;
    bf16_t* O; int ldc; float scale; LAS float* sm; const float* ssq;
    __device__ __forceinline__ void operator()(f32x4 (&acc)[2][2][4][2], const Unit& u, int wr, int wc, int fr, int fq) const {
        const int rl0 = wr * 64 + fr;
        f32x4 qa[2][4];
        if (ssq) {
#pragma unroll
            for (int ai = 0; ai < 2; ++ai)
#pragma unroll
                for (int m = 0; m < 4; ++m) qa[ai][m] = rstd16q_ld(ssq, u.pm * BM + rl0 + ai * HALF + m * 16, fq);
            asm volatile("" ::: "memory"); }
#pragma unroll
        for (int ai = 0; ai < 2; ++ai)
#pragma unroll
            for (int m = 0; m < 4; ++m) { float mx = -3.0e38f; const float sc = ssq ? scale * rstd16q_fin(qa[ai][m]) : scale;
#pragma unroll
                for (int bj = 0; bj < 2; ++bj)
#pragma unroll
                    for (int n = 0; n < 2; ++n) { acc[ai][bj][m][n] = acc[ai][bj][m][n] * sc; const f32x4 v = acc[ai][bj][m][n]; mx = fmaxf(mx, fmaxf(fmaxf(v[0], v[1]), fmaxf(v[2], v[3]))); }
                mx = xmax32(xmax16(mx));
                if (fq == 0) sm[(rl0 + ai * HALF + m * 16) * 4 + wc] = mx; }
        asm volatile("s_waitcnt lgkmcnt(0)" ::: "memory"); __builtin_amdgcn_s_barrier(); asm volatile("" ::: "memory");
#pragma unroll
        for (int ai = 0; ai < 2; ++ai)
#pragma unroll
            for (int m = 0; m < 4; ++m) { const int rl = rl0 + ai * HALF + m * 16; const f32x4 q = *(const LAS f32x4*)(sm + rl * 4); const float M = fmaxf(fmaxf(q[0], q[1]), fmaxf(q[2], q[3])); float sum = 0.f;
#pragma unroll
                for (int bj = 0; bj < 2; ++bj)
#pragma unroll
                    for (int n = 0; n < 2; ++n) { f32x4 v = acc[ai][bj][m][n]; v[0] = __expf(v[0] - M); v[1] = __expf(v[1] - M); v[2] = __expf(v[2] - M); v[3] = __expf(v[3] - M); acc[ai][bj][m][n] = v; sum += (v[0] + v[1]) + (v[2] + v[3]); }
                sum = xadd32(xadd16(sum));
                if (fq == 0) sm[1024 + rl * 4 + wc] = sum; }
        asm volatile("s_waitcnt lgkmcnt(0)" ::: "memory"); __builtin_amdgcn_s_barrier(); asm volatile("" ::: "memory");
        const int row0 = u.pm * BM + rl0, col0 = u.pn * BM + wc * 32 + 8 * fq;
#pragma unroll
        for (int ai = 0; ai < 2; ++ai)
#pragma unroll
            for (int m = 0; m < 4; ++m) { const int rl = rl0 + ai * HALF + m * 16; const f32x4 q = *(const LAS f32x4*)(sm + 1024 + rl * 4); const float inv = __builtin_amdgcn_rcpf((q[0] + q[1]) + (q[2] + q[3]));
                bf16_t* rowp = O + (size_t)(row0 + ai * HALF + m * 16) * ldc + col0;
#pragma unroll
                for (int bj = 0; bj < 2; ++bj) { const f32x4 v0 = acc[ai][bj][m][0] * inv, v1 = acc[ai][bj][m][1] * inv;
                    u32x4 w; w.x = cvt_pk_bf16(v0[0], v0[1]); w.y = cvt_pk_bf16(v0[2], v0[3]); w.z = cvt_pk_bf16(v1[0], v1[1]); w.w = cvt_pk_bf16(v1[2], v1[3]);
                    *(u32x4*)(rowp + bj * HALF) = w; } }
    }
};
struct EpiLora {
    static constexpr bool PERM = true;
    static constexpr bool HAS_PRE = false;
    bf16_t* O; size_t stride; const float* w0; const float* a0;
    __device__ __forceinline__ void operator()(const f32x4 (&acc)[2][2][4][2], const Unit& u, int wr, int wc, int fr, int fq) const {
        const int row0 = u.pm * BM + wr * 64 + fr; int colt = u.pn * BM; const int t = colt / 1024; colt -= t * 1024; bf16_t* base = O + (size_t)t * stride;
        const int col0 = colt + wc * 32 + 8 * fq; const float* bias = (t == 0) ? w0 : a0;
        f32x4 bv[2][2];
#pragma unroll
        for (int bj = 0; bj < 2; ++bj)
#pragma unroll
            for (int n = 0; n < 2; ++n) bv[bj][n] = (t < 2) ? *(const f32x4*)(bias + col0 + bj * HALF + 4 * n) : (f32x4){0.f, 0.f, 0.f, 0.f};
#pragma unroll
        for (int ai = 0; ai < 2; ++ai)
#pragma unroll
            for (int m = 0; m < 4; ++m) { bf16_t* rowp = base + (size_t)(row0 + ai * HALF + m * 16) * 1024 + col0;
#pragma unroll
                for (int bj = 0; bj < 2; ++bj) { f32x4 v0 = acc[ai][bj][m][0] + bv[bj][0], v1 = acc[ai][bj][m][1] + bv[bj][1];
                    if (t < 2) { const float s = (t == 0) ? -0.6065306597f : 1.f;
#pragma unroll
                        for (int e = 0; e < 4; ++e) { v0[e] = s * sigmoidf_(v0[e]); v1[e] = s * sigmoidf_(v1[e]); } }
                    u32x4 w; w.x = cvt_pk_bf16(v0[0], v0[1]); w.y = cvt_pk_bf16(v0[2], v0[3]); w.z = cvt_pk_bf16(v1[0], v1[1]); w.w = cvt_pk_bf16(v1[2], v1[3]);
                    *(u32x4*)(rowp + bj * HALF) = w; } }
    }
};
struct EpiResB {
    static constexpr bool PERM = true;
    static constexpr bool HAS_PRE = false;
    const float* basef; bf16_t* hb; int ldc; float* ssq;
    __device__ __forceinline__ void operator()(const f32x4 (&acc)[2][2][4][2], const Unit& u, int wr, int wc, int fr, int fq) const {
        const int row0 = u.pm * BM + wr * 64 + fr, col0 = u.pn * BM + wc * 32 + 8 * fq;
        if (basef) {
#pragma unroll
            for (int aim = 0; aim < 4; ++aim) { const int ai = aim >> 1, mb = (aim & 1) * 2; f32x4 bq[4][2][2];
#pragma unroll
                for (int m = mb; m < mb + 2; ++m) { const size_t off = (size_t)(row0 + ai * HALF + m * 16) * ldc + col0;
#pragma unroll
                    for (int bj = 0; bj < 2; ++bj) { bq[m][bj][0] = *(const f32x4*)(basef + off + bj * HALF); bq[m][bj][1] = *(const f32x4*)(basef + off + bj * HALF + 4); } }
                asm volatile("" ::: "memory");
#pragma unroll
                for (int m = mb; m < mb + 2; ++m) { const int row = row0 + ai * HALF + m * 16; const size_t off = (size_t)row * ldc + col0; float sq = 0.f;
#pragma unroll
                    for (int bj = 0; bj < 2; ++bj) { const f32x4 o0 = bq[m][bj][0] + acc[ai][bj][m][0], o1 = bq[m][bj][1] + acc[ai][bj][m][1];
                        u32x4 w; w.x = cvt_pk_bf16(o0[0], o0[1]); w.y = cvt_pk_bf16(o0[2], o0[3]); w.z = cvt_pk_bf16(o1[0], o1[1]); w.w = cvt_pk_bf16(o1[2], o1[3]);
                        *(u32x4*)(hb + off + bj * HALF) = w;
                        sq += ((o0[0] * o0[0] + o0[1] * o0[1]) + (o0[2] * o0[2] + o0[3] * o0[3])) + ((o1[0] * o1[0] + o1[1] * o1[1]) + (o1[2] * o1[2] + o1[3] * o1[3])); }
                    sq = xadd32(xadd16(sq)); if (fq == 0) ssq[(size_t)row * 16 + u.pn * 4 + wc] = sq; } }
        } else {
#pragma unroll
            for (int ai = 0; ai < 2; ++ai) { u32x4 bw[4][2];
#pragma unroll
                for (int m = 0; m < 4; ++m) { const size_t off = (size_t)(row0 + ai * HALF + m * 16) * ldc + col0;
#pragma unroll
                    for (int bj = 0; bj < 2; ++bj) bw[m][bj] = *(const u32x4*)(hb + off + bj * HALF); }
                asm volatile("" ::: "memory");
#pragma unroll
                for (int m = 0; m < 4; ++m) { const int row = row0 + ai * HALF + m * 16; const size_t off = (size_t)row * ldc + col0; float sq = 0.f;
#pragma unroll
                    for (int bj = 0; bj < 2; ++bj) { const u32x4 w = bw[m][bj];
                        const f32x4 b0 = (f32x4){__uint_as_float(w.x << 16), __uint_as_float(w.x & 0xffff0000u), __uint_as_float(w.y << 16), __uint_as_float(w.y & 0xffff0000u)};
                        const f32x4 b1 = (f32x4){__uint_as_float(w.z << 16), __uint_as_float(w.z & 0xffff0000u), __uint_as_float(w.w << 16), __uint_as_float(w.w & 0xffff0000u)};
                        const f32x4 o0 = b0 + acc[ai][bj][m][0], o1 = b1 + acc[ai][bj][m][1];
                        u32x4 wo; wo.x = cvt_pk_bf16(o0[0], o0[1]); wo.y = cvt_pk_bf16(o0[2], o0[3]); wo.z = cvt_pk_bf16(o1[0], o1[1]); wo.w = cvt_pk_bf16(o1[2], o1[3]);
                        *(u32x4*)(hb + off + bj * HALF) = wo;
                        sq += ((o0[0] * o0[0] + o0[1] * o0[1]) + (o0[2] * o0[2] + o0[3] * o0[3])) + ((o1[0] * o1[0] + o1[1] * o1[1]) + (o1[2] * o1[2] + o1[3] * o1[3])); }
                    sq = xadd32(xadd16(sq)); if (fq == 0) ssq[(size_t)row * 16 + u.pn * 4 + wc] = sq; } }
        }
    }
};
struct EpiScatter {
    static constexpr bool PERM = true;
    static constexpr bool HAS_PRE = true;
    bf16_t* hb; const int* stab; float* ssq; LAS int* tab;
    __device__ __forceinline__ void prefetch(const Unit& u, int wid) const {
        if (wid < 4) { int l; asm volatile("v_mbcnt_lo_u32_b32 %0, -1, 0\n\tv_mbcnt_hi_u32_b32 %0, -1, %0" : "=v"(l));
            __builtin_amdgcn_global_load_lds((const unsigned*)(stab + u.pm * BM + wid * 64 + l), (LAS unsigned*)(tab + wid * 64), 4, 0, 0); }
    }
    __device__ __forceinline__ void operator()(const f32x4 (&acc)[2][2][4][2], const Unit& u, int wr, int wc, int fr, int fq) const {
        const int col0 = u.pn * BM + wc * 32 + 8 * fq;
        int tk[2][4];
        asm volatile("ds_read_b32 %0, %8\n\tds_read_b32 %1, %8 offset:64\n\tds_read_b32 %2, %8 offset:128\n\tds_read_b32 %3, %8 offset:192\n\tds_read_b32 %4, %8 offset:512\n\tds_read_b32 %5, %8 offset:576\n\t"
                     "ds_read_b32 %6, %8 offset:640\n\tds_read_b32 %7, %8 offset:704\n\ts_waitcnt lgkmcnt(0)"
                     : "=&v"(tk[0][0]), "=&v"(tk[0][1]), "=&v"(tk[0][2]), "=&v"(tk[0][3]), "=&v"(tk[1][0]), "=&v"(tk[1][1]), "=&v"(tk[1][2]), "=&v"(tk[1][3]) : "v"((unsigned)(size_t)tab + (unsigned)(wr * 64 + fr) * 4u) : "memory");
#pragma unroll
        for (int ai = 0; ai < 2; ++ai)
#pragma unroll
            for (int m = 0; m < 4; ++m) { const int tok = tk[ai][m]; float sq = 0.f;
                if (tok >= 0) { const size_t off = (size_t)tok * DM + col0;
#pragma unroll
                    for (int bj = 0; bj < 2; ++bj) { const u32x4 w0 = *(const u32x4*)(hb + off + bj * HALF);
                        const f32x4 b0 = (f32x4){__uint_as_float(w0.x << 16), __uint_as_float(w0.x & 0xffff0000u), __uint_as_float(w0.y << 16), __uint_as_float(w0.y & 0xffff0000u)};
                        const f32x4 b1 = (f32x4){__uint_as_float(w0.z << 16), __uint_as_float(w0.z & 0xffff0000u), __uint_as_float(w0.w << 16), __uint_as_float(w0.w & 0xffff0000u)};
                        const f32x4 o0 = b0 + acc[ai][bj][m][0], o1 = b1 + acc[ai][bj][m][1];
                        u32x4 w; w.x = cvt_pk_bf16(o0[0], o0[1]); w.y = cvt_pk_bf16(o0[2], o0[3]); w.z = cvt_pk_bf16(o1[0], o1[1]); w.w = cvt_pk_bf16(o1[2], o1[3]);
                        *(u32x4*)(hb + off + bj * HALF) = w;
                        sq += ((o0[0] * o0[0] + o0[1] * o0[1]) + (o0[2] * o0[2] + o0[3] * o0[3])) + ((o1[0] * o1[0] + o1[1] * o1[1]) + (o1[2] * o1[2] + o1[3] * o1[3])); } }
                if (ssq) { sq = xadd32(xadd16(sq)); if (fq == 0 && tok >= 0) ssq[(size_t)tok * 16 + u.pn * 4 + wc] = sq; } }
    }
};
struct EpiRoute {
    static constexpr bool PERM = false;
    static constexpr bool HAS_PRE = false;
    float* out; const float* ssq;
    __device__ __forceinline__ void operator()(const f32x4 (&acc)[2][2][4][2], const Unit& u, int wr, int wc, int fr, int fq) const {
        if (wc >= 2) return;
        const int row0 = u.pm * BM + wr * 64 + fr, col0 = wc * 32 + 4 * fq;
        f32x4 qa[2][4];
#pragma unroll
        for (int ai = 0; ai < 2; ++ai)
#pragma unroll
            for (int m = 0; m < 4; ++m) qa[ai][m] = rstd16q_ld(ssq, row0 + ai * HALF + m * 16, fq);
        asm volatile("" ::: "memory");
#pragma unroll
        for (int ai = 0; ai < 2; ++ai)
#pragma unroll
            for (int m = 0; m < 4; ++m) { const int row = row0 + ai * HALF + m * 16; float* rowp = out + (size_t)row * 64 + col0; const float rs = rstd16q_fin(qa[ai][m]);
#pragma unroll
                for (int n = 0; n < 2; ++n) *(f32x4*)(rowp + n * 16) = acc[ai][0][m][n] * rs; }
    }
};
struct EpiSwiGLU {
    static constexpr bool PERM = true;
    static constexpr bool HAS_PRE = false;
    bf16_t* hid; const float* gate;
    __device__ __forceinline__ void operator()(const f32x4 (&acc)[2][2][4][2], const Unit& u, int wr, int wc, int fr, int fq) const {
        const int row0 = u.pm * BM + wr * 64 + fr, col0 = u.pn * 128 + wc * 32 + 8 * fq;
        f32x2 gq[2][4];
#pragma unroll
        for (int ai = 0; ai < 2; ++ai)
#pragma unroll
            for (int m = 0; m < 4; ++m) gq[ai][m] = *(const f32x2*)(gate + 2 * (size_t)(row0 + ai * HALF + m * 16));
        asm volatile("" ::: "memory");
#pragma unroll
        for (int ai = 0; ai < 2; ++ai)
#pragma unroll
            for (int m = 0; m < 4; ++m) { const int row = row0 + ai * HALF + m * 16; const f32x2 gr = gq[ai][m]; const float rs = gr.x, g = gr.y;
                f32x4 h0, h1;
#pragma unroll
                for (int e = 0; e < 4; ++e) { const float a0 = acc[ai][0][m][0][e] * rs, a1 = acc[ai][0][m][1][e] * rs;
                    h0[e] = a0 * sigmoidf_(a0) * acc[ai][1][m][0][e] * g; h1[e] = a1 * sigmoidf_(a1) * acc[ai][1][m][1][e] * g; }
                u32x4 w; w.x = cvt_pk_bf16(h0[0], h0[1]); w.y = cvt_pk_bf16(h0[2], h0[3]); w.z = cvt_pk_bf16(h1[0], h1[1]); w.w = cvt_pk_bf16(h1[2], h1[3]);
                *(u32x4*)(hid + (size_t)row * 256 + col0) = w; }
    }
};

template <class Epi, class Sched, bool ALIGN_EPI>
__device__ __forceinline__ void gemm_phase(LAS unsigned char* lds, const int wid, const Gemm g, const Sched& S, const Epi& E) {
    int lane; asm volatile("v_mbcnt_lo_u32_b32 %0, -1, 0\n\tv_mbcnt_hi_u32_b32 %0, -1, %0" : "=v"(lane));
    const int tid = wid * 64 + lane, wr = wid >> 2, wc = wid & 3, fr = lane & 15, fq = lane >> 4;
    const int K = g.K, nt = K / BK;
    unsigned voffA[2], voffB[2];
#pragma unroll
    for (int i = 0; i < 2; ++i) { int R, C; stage_rc(tid * 16 + i * 8192, R, C); const int Rb = Epi::PERM ? ((R & ~31) + perm32(R & 31)) : R;
        voffA[i] = (unsigned)(R * g.lda + C) * 2u; voffB[i] = (unsigned)(Rb * g.ldb + C) * 2u; }
    const size_t kstep = (size_t)(BK * 2);
    const size_t hstepA = (size_t)HALF * g.lda * 2, hstepB = (size_t)HALF * g.ldb * 2;
    const unsigned ldsw = (unsigned)wid * 1024u;
    const int aoff = lds_byte(wr * 64 + fr, fq * 8), boff = lds_byte(wc * 32 + fr, fq * 8);
#define PG8_SA(b, h) (((b) * 2 + (h)) * HTB)
#define PG8_SB(b, h) ((4 + (b) * 2 + (h)) * HTB)
#define PG8_STAGE(bufoff, gbase, voff) do { _Pragma("unroll") for (int _i = 0; _i < 2; ++_i) \
        __builtin_amdgcn_global_load_lds((const unsigned*)((const char*)(gbase) + (voff)[_i]), (LAS unsigned*)(lds + (bufoff) + ldsw + _i * 8192), 16, 0, 0); } while (0)
#define PG8_LDA(dst, b, h) do { _Pragma("unroll") for (int m = 0; m < 4; ++m) _Pragma("unroll") for (int k = 0; k < 2; ++k) dst[m][k] = *(const LAS bf16x8*)(lds + PG8_SA(b, h) + aoff + m * 2048 + k * 1024); } while (0)
#define PG8_LDB(dst, b, h) do { _Pragma("unroll") for (int n = 0; n < 2; ++n) _Pragma("unroll") for (int k = 0; k < 2; ++k) dst[n][k] = *(const LAS bf16x8*)(lds + PG8_SB(b, h) + boff + n * 2048 + k * 1024); } while (0)
#define PG8_MMA(ai, bj, At, Bt) do { __builtin_amdgcn_s_setprio(1); _Pragma("unroll") for (int m = 0; m < 4; ++m) _Pragma("unroll") for (int n = 0; n < 2; ++n) _Pragma("unroll") for (int k = 0; k < 2; ++k) \
        acc[ai][bj][m][n] = __builtin_amdgcn_mfma_f32_16x16x32_bf16(Bt[n][k], At[m][k], acc[ai][bj][m][n], 0, 0, 0); __builtin_amdgcn_s_setprio(0); } while (0)
#define PG8_WAIT_V(n) asm volatile("s_waitcnt vmcnt(" #n ")" ::: "memory")
#define PG8_WAIT_L(n) asm volatile("s_waitcnt lgkmcnt(" #n ")" ::: "memory")
#define PG8_BAR __builtin_amdgcn_s_barrier()
#define PG8_SCHED __builtin_amdgcn_sched_barrier(0)
    Unit cur, nxt; int ui = 0;
    if (!S.next(0, cur)) return;
    f32x4 acc[2][2][4][2];
#pragma unroll
    for (int a = 0; a < 2; ++a)
#pragma unroll
        for (int b = 0; b < 2; ++b)
#pragma unroll
            for (int m = 0; m < 4; ++m)
#pragma unroll
                for (int n = 0; n < 2; ++n) acc[a][b][m][n] = (f32x4){0.f, 0.f, 0.f, 0.f};
    bf16x8 At[4][2], B0[2][2], B1[2][2];
    const char* cA = (const char*)g.A + cur.offA; const char* cB = (const char*)g.Bt + cur.offB;
    PG8_STAGE(PG8_SB(0, 0), cB, voffB); PG8_STAGE(PG8_SB(0, 1), cB + hstepB, voffB); PG8_STAGE(PG8_SA(0, 0), cA, voffA); PG8_STAGE(PG8_SA(0, 1), cA + hstepA, voffA);
    if (wr == 1) PG8_BAR;
    PG8_WAIT_V(2); PG8_BAR;
    PG8_STAGE(PG8_SB(1, 0), cB + kstep, voffB); PG8_STAGE(PG8_SA(1, 0), cA + kstep, voffA); PG8_STAGE(PG8_SB(1, 1), cB + hstepB + kstep, voffB);
    PG8_WAIT_V(6); PG8_BAR;
    for (;;) {
        const bool has_next = S.next(ui + 1, nxt);
        const char* nA = has_next ? (const char*)g.A + nxt.offA : cA; const char* nB = has_next ? (const char*)g.Bt + nxt.offB : cB;
        if constexpr (Epi::HAS_PRE) E.prefetch(cur, wid);
        for (int t = 0; t < nt; t += 2) {
            const bool last = (t == nt - 2);
            const char* a1 = cA + (size_t)(t + 1) * kstep;
            const char* a2 = last ? nA : cA + (size_t)(t + 2) * kstep; const char* b2 = last ? nB : cB + (size_t)(t + 2) * kstep;
            const char* a3 = a2 + kstep; const char* b3 = b2 + kstep;
            PG8_LDB(B0, 0, 0); PG8_LDB(B1, 0, 1); PG8_SCHED; PG8_LDA(At, 0, 0); PG8_STAGE(PG8_SA(1, 1), a1 + hstepA, voffA);
            PG8_WAIT_V(8); PG8_WAIT_L(0); PG8_BAR; PG8_MMA(0, 0, At, B0); PG8_MMA(0, 1, At, B1); PG8_BAR; PG8_SCHED;
            PG8_LDA(At, 0, 1); PG8_STAGE(PG8_SB(0, 0), b2, voffB); PG8_STAGE(PG8_SB(0, 1), b2 + hstepB, voffB); PG8_STAGE(PG8_SA(0, 0), a2, voffA);
            PG8_WAIT_V(8); PG8_WAIT_L(0); PG8_BAR; PG8_MMA(1, 0, At, B0); PG8_MMA(1, 1, At, B1); PG8_BAR; PG8_SCHED;
            PG8_LDB(B0, 1, 0); PG8_LDB(B1, 1, 1); PG8_SCHED; PG8_LDA(At, 1, 0); PG8_STAGE(PG8_SA(0, 1), a2 + hstepA, voffA);
            PG8_WAIT_V(8); PG8_WAIT_L(0); PG8_BAR; PG8_MMA(0, 0, At, B0); PG8_MMA(0, 1, At, B1); PG8_BAR; PG8_SCHED;
            PG8_LDA(At, 1, 1); PG8_STAGE(PG8_SB(1, 0), b3, voffB); PG8_STAGE(PG8_SB(1, 1), b3 + hstepB, voffB); PG8_STAGE(PG8_SA(1, 0), a3, voffA);
            PG8_WAIT_V(8); PG8_WAIT_L(0); PG8_BAR; PG8_MMA(1, 0, At, B0); PG8_MMA(1, 1, At, B1); PG8_BAR; PG8_SCHED;
        }
        if constexpr (ALIGN_EPI) { if (wr == 0) PG8_BAR; }
        { int l2; asm volatile("v_mbcnt_lo_u32_b32 %0, -1, 0\n\tv_mbcnt_hi_u32_b32 %0, -1, %0" : "=v"(l2)); E(acc, cur, wr, wc, l2 & 15, l2 >> 4); }
        if (!has_next) break;
#pragma unroll
        for (int a = 0; a < 2; ++a)
#pragma unroll
            for (int b = 0; b < 2; ++b)
#pragma unroll
                for (int m = 0; m < 4; ++m)
#pragma unroll
                    for (int n = 0; n < 2; ++n) acc[a][b][m][n] = (f32x4){0.f, 0.f, 0.f, 0.f};
        cur = nxt; cA = nA; cB = nB; ++ui;
        if constexpr (ALIGN_EPI) { if (wr == 1) PG8_BAR; }
    }
    PG8_WAIT_V(0);
    if constexpr (!ALIGN_EPI) { if (wr == 0) PG8_BAR; }
    PG8_BAR;
#undef PG8_SA
#undef PG8_SB
#undef PG8_STAGE
#undef PG8_LDA
#undef PG8_LDB
#undef PG8_MMA
#undef PG8_WAIT_V
#undef PG8_WAIT_L
#undef PG8_BAR
#undef PG8_SCHED
}
template <class Epi, class Sched, bool ALIGN_EPI>
__device__ __forceinline__ void gemm_phase_g(LAS unsigned char* lds, const int wid, const Gemm g, const Sched& S, const Epi& E, const int* rowtab, LAS unsigned* gtab) {
    int lane; asm volatile("v_mbcnt_lo_u32_b32 %0, -1, 0\n\tv_mbcnt_hi_u32_b32 %0, -1, %0" : "=v"(lane));
    const int tid = wid * 64 + lane, wr = wid >> 2, wc = wid & 3, fr = lane & 15, fq = lane >> 4;
    const int K = g.K, nt = K / BK;
    unsigned voffA[2], voffB[2];
#pragma unroll
    for (int i = 0; i < 2; ++i) { int R, C; stage_rc(tid * 16 + i * 8192, R, C); const int Rb = Epi::PERM ? ((R & ~31) + perm32(R & 31)) : R;
        voffA[i] = (unsigned)R | ((unsigned)(C * 2) << 16); voffB[i] = (unsigned)(Rb * g.ldb + C) * 2u; }
    const size_t kstep = (size_t)(BK * 2);
    const size_t hstepA = (size_t)HALF * g.lda * 2, hstepB = (size_t)HALF * g.ldb * 2;
    const unsigned ldsw = (unsigned)wid * 1024u;
    const int aoff = lds_byte(wr * 64 + fr, fq * 8), boff = lds_byte(wc * 32 + fr, fq * 8);
#define PG8_SA(b, h) (((b) * 2 + (h)) * HTB)
#define PG8_SB(b, h) ((4 + (b) * 2 + (h)) * HTB)
#define PG8_STAGE(bufoff, gbase, voff) do { _Pragma("unroll") for (int _i = 0; _i < 2; ++_i) \
        __builtin_amdgcn_global_load_lds((const unsigned*)((const char*)(gbase) + (voff)[_i]), (LAS unsigned*)(lds + (bufoff) + ldsw + _i * 8192), 16, 0, 0); } while (0)
#define PG8_LDA(dst, b, h) do { _Pragma("unroll") for (int m = 0; m < 4; ++m) _Pragma("unroll") for (int k = 0; k < 2; ++k) dst[m][k] = *(const LAS bf16x8*)(lds + PG8_SA(b, h) + aoff + m * 2048 + k * 1024); } while (0)
#define PG8_LDB(dst, b, h) do { _Pragma("unroll") for (int n = 0; n < 2; ++n) _Pragma("unroll") for (int k = 0; k < 2; ++k) dst[n][k] = *(const LAS bf16x8*)(lds + PG8_SB(b, h) + boff + n * 2048 + k * 1024); } while (0)
#define PG8_MMA(ai, bj, At, Bt) do { __builtin_amdgcn_s_setprio(1); _Pragma("unroll") for (int m = 0; m < 4; ++m) _Pragma("unroll") for (int n = 0; n < 2; ++n) _Pragma("unroll") for (int k = 0; k < 2; ++k) \
        acc[ai][bj][m][n] = __builtin_amdgcn_mfma_f32_16x16x32_bf16(Bt[n][k], At[m][k], acc[ai][bj][m][n], 0, 0, 0); __builtin_amdgcn_s_setprio(0); } while (0)
#define PG8_STAGE_A(bufoff, gbase, half, tb) do { _Pragma("unroll") for (int _i = 0; _i < 2; ++_i) { const unsigned _o = gtab[(tb) * 256 + (half) * 128 + (voffA[_i] & 0xffffu)] + (voffA[_i] >> 16); \
        __builtin_amdgcn_global_load_lds((const unsigned*)((const char*)(gbase) + _o), (LAS unsigned*)(lds + (bufoff) + ldsw + _i * 8192), 16, 0, 0); } } while (0)
#define PG8_WAIT_V(n) asm volatile("s_waitcnt vmcnt(" #n ")" ::: "memory")
#define PG8_WAIT_L(n) asm volatile("s_waitcnt lgkmcnt(" #n ")" ::: "memory")
#define PG8_BAR __builtin_amdgcn_s_barrier()
#define PG8_SCHED __builtin_amdgcn_sched_barrier(0)
    Unit cur, nxt; int ui = 0;
    if (!S.next(0, cur)) return;
    f32x4 acc[2][2][4][2];
#pragma unroll
    for (int a = 0; a < 2; ++a)
#pragma unroll
        for (int b = 0; b < 2; ++b)
#pragma unroll
            for (int m = 0; m < 4; ++m)
#pragma unroll
                for (int n = 0; n < 2; ++n) acc[a][b][m][n] = (f32x4){0.f, 0.f, 0.f, 0.f};
    bf16x8 At[4][2], B0[2][2], B1[2][2];
    const char* cA = (const char*)g.A; const char* cB = (const char*)g.Bt + cur.offB;
    if (tid < 256) gtab[tid] = (unsigned)rowtab[cur.pm * 256 + tid] * (unsigned)(g.lda * 2);
    asm volatile("s_waitcnt vmcnt(0) lgkmcnt(0)" ::: "memory"); __builtin_amdgcn_s_barrier(); asm volatile("" ::: "memory");
    int cb = 0;
    PG8_STAGE(PG8_SB(0, 0), cB, voffB); PG8_STAGE(PG8_SB(0, 1), cB + hstepB, voffB); PG8_STAGE_A(PG8_SA(0, 0), cA, 0, cb); PG8_STAGE_A(PG8_SA(0, 1), cA, 1, cb);
    if (wr == 1) PG8_BAR;
    PG8_WAIT_V(2); PG8_BAR;
    PG8_STAGE(PG8_SB(1, 0), cB + kstep, voffB); PG8_STAGE_A(PG8_SA(1, 0), cA + kstep, 0, cb); PG8_STAGE(PG8_SB(1, 1), cB + hstepB + kstep, voffB);
    PG8_WAIT_V(6); PG8_BAR;
    for (;;) {
        const bool has_next = S.next(ui + 1, nxt);
        const char* nA = cA; const char* nB = has_next ? (const char*)g.Bt + nxt.offB : cB;
        if (has_next && tid < 256) gtab[(cb ^ 1) * 256 + tid] = (unsigned)rowtab[nxt.pm * 256 + tid] * (unsigned)(g.lda * 2);
        const int nbq = has_next ? (cb ^ 1) : cb;
        for (int t = 0; t < nt; t += 2) {
            const bool last = (t == nt - 2);
            const char* a1 = cA + (size_t)(t + 1) * kstep; const int tb2 = last ? nbq : cb;
            const char* a2 = last ? nA : cA + (size_t)(t + 2) * kstep; const char* b2 = last ? nB : cB + (size_t)(t + 2) * kstep;
            const char* a3 = a2 + kstep; const char* b3 = b2 + kstep;
            PG8_LDB(B0, 0, 0); PG8_LDB(B1, 0, 1); PG8_SCHED; PG8_LDA(At, 0, 0); PG8_STAGE_A(PG8_SA(1, 1), a1, 1, cb);
            PG8_WAIT_V(8); PG8_WAIT_L(0); PG8_BAR; PG8_MMA(0, 0, At, B0); PG8_MMA(0, 1, At, B1); PG8_BAR; PG8_SCHED;
            PG8_LDA(At, 0, 1); PG8_STAGE(PG8_SB(0, 0), b2, voffB); PG8_STAGE(PG8_SB(0, 1), b2 + hstepB, voffB); PG8_STAGE_A(PG8_SA(0, 0), a2, 0, tb2);
            PG8_WAIT_V(8); PG8_WAIT_L(0); PG8_BAR; PG8_MMA(1, 0, At, B0); PG8_MMA(1, 1, At, B1); PG8_BAR; PG8_SCHED;
            PG8_LDB(B0, 1, 0); PG8_LDB(B1, 1, 1); PG8_SCHED; PG8_LDA(At, 1, 0); PG8_STAGE_A(PG8_SA(0, 1), a2, 1, tb2);
            PG8_WAIT_V(8); PG8_WAIT_L(0); PG8_BAR; PG8_MMA(0, 0, At, B0); PG8_MMA(0, 1, At, B1); PG8_BAR; PG8_SCHED;
            PG8_LDA(At, 1, 1); PG8_STAGE(PG8_SB(1, 0), b3, voffB); PG8_STAGE(PG8_SB(1, 1), b3 + hstepB, voffB); PG8_STAGE_A(PG8_SA(1, 0), a3, 0, tb2);
            PG8_WAIT_V(8); PG8_WAIT_L(0); PG8_BAR; PG8_MMA(1, 0, At, B0); PG8_MMA(1, 1, At, B1); PG8_BAR; PG8_SCHED;
        }
        if constexpr (ALIGN_EPI) { if (wr == 0) PG8_BAR; }
        { int l2; asm volatile("v_mbcnt_lo_u32_b32 %0, -1, 0\n\tv_mbcnt_hi_u32_b32 %0, -1, %0" : "=v"(l2)); E(acc, cur, wr, wc, l2 & 15, l2 >> 4); }
        if (!has_next) break;
#pragma unroll
        for (int a = 0; a < 2; ++a)
#pragma unroll
            for (int b = 0; b < 2; ++b)
#pragma unroll
                for (int m = 0; m < 4; ++m)
#pragma unroll
                    for (int n = 0; n < 2; ++n) acc[a][b][m][n] = (f32x4){0.f, 0.f, 0.f, 0.f};
        cur = nxt; cA = nA; cB = nB; ++ui; cb ^= 1;
        if constexpr (ALIGN_EPI) { if (wr == 1) PG8_BAR; }
    }
    PG8_WAIT_V(0);
    if constexpr (!ALIGN_EPI) { if (wr == 0) PG8_BAR; }
    PG8_BAR;
#undef PG8_SA
#undef PG8_SB
#undef PG8_STAGE
#undef PG8_LDA
#undef PG8_LDB
#undef PG8_MMA
#undef PG8_STAGE_A
#undef PG8_WAIT_V
#undef PG8_WAIT_L
#undef PG8_BAR
#undef PG8_SCHED
}
}

constexpr size_t MiB = 1u << 20;
constexpr size_t WS_CTL = 0, CTL_ZERO_BYTES = 1 * MiB;
constexpr size_t WS_SSQ = 1 * MiB;
constexpr size_t WS_WR = 9 * MiB, WS_WK = 11 * MiB, WS_WV = 13 * MiB, WS_WO0 = 15 * MiB;
constexpr size_t WS_WPQ = 17 * MiB;
constexpr size_t WS_WL2 = 18 * MiB;
constexpr size_t WS_SBQKV = 20 * MiB, WS_SBWO = 26 * MiB;
constexpr size_t WS_XAWQ = 28 * MiB, WS_XAWO = 32 * MiB, WS_XAWKV = 36 * MiB;
constexpr size_t WS_ROUTE = 40 * MiB;
constexpr size_t WS_W13 = 41 * MiB;
constexpr size_t WS_W2 = 105 * MiB;
constexpr size_t WS_MEMN = 137 * MiB, WS_MEMK = 153 * MiB, WS_MEMVT = 169 * MiB;
constexpr size_t WS_HB = 185 * MiB;
constexpr size_t WS_ARENA = 313 * MiB;
constexpr size_t WS_LOGIT = WS_ARENA + 512 * MiB;
constexpr size_t WS_TOKE = WS_LOGIT + 16 * MiB, WS_TOKP = WS_TOKE + 512 * 1024, WS_TOKW = WS_TOKE + 1 * MiB, WS_TOKS = WS_TOKW + 512 * 1024;
constexpr size_t WS_ROWTAB = WS_TOKE + 4 * MiB;
constexpr size_t WS_GATE = WS_TOKE + 2 * MiB;
constexpr size_t BUF = (size_t)T * DM * 2;
constexpr size_t HBUF = BUF / NGRP;
constexpr size_t WS_BONUS = WS_ARENA + 11 * HBUF;
constexpr size_t WS_END = WS_BONUS + 2 * MiB;   static_assert(WS_ROWTAB + 1 * MiB <= WS_BONUS && WS_END <= 1024 * MiB && (size_t)TG * 16 * 4 <= 2 * MiB, "workspace");
static_assert((size_t)MAXSLOT * 8 <= 2 * MiB, "gate table");
constexpr int CW_BAR = 4096;
constexpr int CW_CNT = 16384;
constexpr int CW_STQ = 32768;

constexpr int RING_BYTES = 131072;
constexpr int LDSCTL_OFF = RING_BYTES;
constexpr int LDS_XB = LDSCTL_OFF;
constexpr int LDS_TOFF = LDSCTL_OFF + 3072;
constexpr int LDS_FLAGS = LDSCTL_OFF + 256;
constexpr int LDS_HIST = LDSCTL_OFF + 512;
constexpr int LDS_INP = LDSCTL_OFF + 1024;
constexpr int LDS_TEXP = LDSCTL_OFF + 2048;
constexpr int LDS_GTAB = LDSCTL_OFF + 12288;
constexpr int LDS_SM = LDSCTL_OFF + 4096;
constexpr int LDS_YB = LDSCTL_OFF + 4096;
constexpr int LDS_BYTES = 153600;

#define RLX_AGENT __ATOMIC_RELAXED, __HIP_MEMORY_SCOPE_AGENT

#define XB_TMO      128
#define XB_XCNT(j)  (256  + 64 * (j))
#define XB_XSUB(j)  (1280 + 64 * (j))
#define XB_XGEN(j)  (2304 + 64 * (j))
#define XB_TOP      3328
#define XB_TOPGEN   3392
#define XCD_BAR_WORDS 3456
#define XB_SPIN_CAP (1u << 18)
__device__ __forceinline__ unsigned xb_ld(unsigned* p)              { return __hip_atomic_load(p, __ATOMIC_RELAXED, __HIP_MEMORY_SCOPE_AGENT); }
__device__ __forceinline__ unsigned xb_add(unsigned* p, unsigned v) { return __hip_atomic_fetch_add(p, v, __ATOMIC_RELAXED, __HIP_MEMORY_SCOPE_AGENT); }
__device__ __forceinline__ unsigned xb_xcc_id() { return (unsigned)__builtin_amdgcn_s_getreg((3 << 11) | 20) & 0xFu; }
#define XB_SPIN(cond, bar) do { unsigned _sp = 0; while (cond) { __builtin_amdgcn_s_sleep(1); \
    if ((++_sp & 255u) == 0u) { if (xb_ld(&(bar)[XB_TMO])) break; if (_sp > XB_SPIN_CAP) { atomicAdd(&(bar)[XB_TMO], 1u); break; } } } } while (0)
struct XcdBarrier { unsigned* bar; unsigned x; volatile LAS unsigned* st; };
__device__ __forceinline__ XcdBarrier xcd_barrier_post(unsigned* bar, volatile LAS unsigned* st) {
    XcdBarrier b; b.bar = bar; b.x = xb_xcc_id(); b.st = st;
    if (threadIdx.x == 0) (void)xb_add(&bar[XB_XCNT(b.x)], 1u);
    return b;
}
__device__ __forceinline__ void xcd_barrier_complete(unsigned* bar, unsigned x, unsigned& nloc, unsigned& nx) {
    const unsigned G = gridDim.x * gridDim.y * gridDim.z;
    unsigned sum, cnt, mine, sp = 0u;
    for (;;) {
        sum = 0u; cnt = 0u; mine = 0u;
#pragma unroll
        for (unsigned j = 0; j < 16; ++j) { const unsigned c = xb_ld(&bar[XB_XCNT(j)]); sum += c; cnt += (c > 0u) ? 1u : 0u; mine = (j == x) ? c : mine; }
        if (sum == G) break;
        __builtin_amdgcn_s_sleep(1);
        if ((++sp & 255u) == 0u) { if (xb_ld(&bar[XB_TMO])) break; if (sp > XB_SPIN_CAP) { atomicAdd(&bar[XB_TMO], 1u); break; } }
    }
    nloc = mine > 0u ? mine : 1u; nx = cnt > 0u ? cnt : 1u;
}
__device__ __forceinline__ void xcd_barrier(const XcdBarrier& b) {
    asm volatile("s_waitcnt vmcnt(0)" ::: "memory");
    __syncthreads();
    if (threadIdx.x == 0) {
        unsigned* bar = b.bar;
        __builtin_amdgcn_s_waitcnt(0);
        unsigned nloc = b.st[0], nx = b.st[1];
        if (nloc == 0u) { xcd_barrier_complete(bar, b.x, nloc, nx); b.st[0] = nloc; b.st[1] = nx; }
        const unsigned old = xb_add(&bar[XB_XSUB(b.x)], 1u);
        const unsigned gen = old / nloc;
        if (old + 1u == (gen + 1u) * nloc) {
            __builtin_amdgcn_fence(__ATOMIC_RELEASE, "agent");
            asm volatile("s_waitcnt vmcnt(0)" ::: "memory");
            const unsigned og = xb_add(&bar[XB_TOP], 1u);
            const unsigned tg = og / nx;
            if (og + 1u == (tg + 1u) * nx) xb_add(&bar[XB_TOPGEN], 1u);
            else XB_SPIN(xb_ld(&bar[XB_TOPGEN]) == tg, bar);
            __builtin_amdgcn_fence(__ATOMIC_ACQUIRE, "agent");
            xb_add(&bar[XB_XGEN(b.x)], 1u);
            asm volatile("s_waitcnt vmcnt(0)" ::: "memory");
        } else {
            XB_SPIN(xb_ld(&bar[XB_XGEN(b.x)]) == gen, bar);
            __builtin_amdgcn_fence(__ATOMIC_ACQUIRE, "agent");
            asm volatile("s_waitcnt vmcnt(0)" ::: "memory");
        }
    }
    __syncthreads();
}

__device__ __forceinline__ unsigned f2bf(float f) { unsigned u = __builtin_bit_cast(unsigned, f); return (u + 0x7fffu + ((u >> 16) & 1u)) >> 16; }
__device__ __forceinline__ unsigned pk2(float lo, float hi) { return f2bf(lo) | (f2bf(hi) << 16); }
__device__ __forceinline__ float bflo(unsigned w) { return __uint_as_float(w << 16); }
__device__ __forceinline__ float bfhi(unsigned w) { return __uint_as_float(w & 0xffff0000u); }
__device__ __forceinline__ f32x4 unpack4(u32x2 w) { return (f32x4){bflo(w.x), bfhi(w.x), bflo(w.y), bfhi(w.y)}; }
__device__ __forceinline__ u32x2 pack4(f32x4 v) { u32x2 w; w.x = pk2(v[0], v[1]); w.y = pk2(v[2], v[3]); return w; }
template <int CTRL> __device__ __forceinline__ float dppf(float v) { return __uint_as_float((unsigned)__builtin_amdgcn_update_dpp(0, (int)__float_as_uint(v), CTRL, 0xF, 0xF, true)); }
__device__ __forceinline__ float sum4(float v) { v += dppf<0xB1>(v); v += dppf<0x4E>(v); return v; }
__device__ __forceinline__ float sum8(float v) { v = sum4(v); v += dppf<0x141>(v); return v; }
__device__ __forceinline__ float sum16(float v) { v = sum8(v); v += dppf<0x140>(v); return v; }
__device__ __forceinline__ float rdlane(float v, int l) { return __int_as_float(__builtin_amdgcn_readlane(__float_as_int(v), l)); }
__device__ __forceinline__ float wave_sum(float v) { v = sum16(v); return (rdlane(v, 0) + rdlane(v, 16)) + (rdlane(v, 32) + rdlane(v, 48)); }
__device__ __forceinline__ float wave_max(float v) { v = fmaxf(v, dppf<0xB1>(v)); v = fmaxf(v, dppf<0x4E>(v)); v = fmaxf(v, dppf<0x141>(v)); v = fmaxf(v, dppf<0x140>(v));
    return fmaxf(fmaxf(rdlane(v, 0), rdlane(v, 16)), fmaxf(rdlane(v, 32), rdlane(v, 48))); }
__device__ __forceinline__ float sigm(float x) { return __builtin_amdgcn_rcpf(1.f + __expf(-x)); }

struct Ctx { int wave, bid, G, gw, NGW; };
__device__ __forceinline__ int lane_id() { int l; asm volatile("v_mbcnt_lo_u32_b32 %0, -1, 0\n\tv_mbcnt_hi_u32_b32 %0, -1, %0" : "=v"(l)); return l; }
#define PHASE_IDS const int lane = lane_id(); const int tid = c.wave * 64 + lane; (void)tid; (void)lane

__device__ __forceinline__ void store_pair16(bf16_t* p, int hh, u32x2 a, u32x2 b) {
    const auto x = __builtin_amdgcn_permlane32_swap(a.x, b.x, false, false), y = __builtin_amdgcn_permlane32_swap(a.y, b.y, false, false);
    u32x4 w; w.x = x[0]; w.y = y[0]; w.z = x[1]; w.w = y[1];
    *(u32x4*)(p + 4 * hh) = w;
}
__device__ __forceinline__ void tr_block(const float* W, int ldw, int k0, int n0, bf16_t* WT, int ldt, int drow0, LAS float* scr, int lane, const float* s, int mode) {
    LAS unsigned* Tw = (LAS unsigned*)scr; const int kq = lane >> 4, n4 = (lane & 15) * 4;
    f32x4 v0[8], v1[8];
#pragma unroll
    for (int i = 0; i < 8; ++i) { const float* p = W + (size_t)(k0 + 8 * i + 2 * kq) * ldw + n0 + n4; v0[i] = *(const f32x4*)p; v1[i] = *(const f32x4*)(p + ldw); }
    if (mode) {
#pragma unroll
        for (int i = 0; i < 8; ++i) { float m0 = s[k0 + 8 * i + 2 * kq], m1 = s[k0 + 8 * i + 2 * kq + 1]; if (mode == 1) { m0 = 1.f - m0; m1 = 1.f - m1; } v0[i] *= m0; v1[i] *= m1; }
    }
#pragma unroll
    for (int i = 0; i < 8; ++i)
#pragma unroll
        for (int e = 0; e < 4; ++e) Tw[(n4 + e) * 33 + 4 * i + kq] = pk2(v0[i][e], v1[i][e]);
    asm volatile("s_waitcnt lgkmcnt(0)" ::: "memory");
    const int nr = lane >> 3, kc = lane & 7;
#pragma unroll
    for (int j = 0; j < 8; ++j) { const int n = nr + 8 * j; const LAS unsigned* p = Tw + n * 33 + 4 * kc;
        u32x4 o; o.x = p[0]; o.y = p[1]; o.z = p[2]; o.w = p[3];
        *(u32x4*)(WT + (size_t)(drow0 + n) * ldt + k0 + 8 * kc) = o; }
    asm volatile("s_waitcnt lgkmcnt(0)" ::: "memory");
}
__device__ __forceinline__ void cp_item(const float* W, int N, bf16_t* WN, int item, int lane, const float* s) {
    const int nblk = N / 64, k0 = 64 * (item / nblk), n0 = 64 * (item % nblk), kq = lane >> 4, n4 = (lane & 15) * 4;
    f32x4 v[16];
#pragma unroll
    for (int i = 0; i < 16; ++i) v[i] = __builtin_nontemporal_load((const f32x4*)(W + (size_t)(k0 + 4 * i + kq) * N + n0 + n4));
#pragma unroll
    for (int i = 0; i < 16; ++i) *(u32x2*)(WN + (size_t)(k0 + 4 * i + kq) * N + n0 + n4) = pack4(v[i] * s[k0 + 4 * i + kq]);
}
__device__ __forceinline__ void tr_item(const float* W, int K, int N, bf16_t* WT, int drow, LAS float* scr, int item, int lane, const float* s = nullptr, int mode = 0) {
    const int nblk = N / 64, kb = item / nblk, nb = item % nblk;
    tr_block(W, N, 64 * kb, 64 * nb, WT, K, drow + 64 * nb, scr, lane, s, mode);
}

struct In {
    const float *x, *mem, *norm_mix, *norm_cross, *norm_ffn, *norm_mem, *norm_final;
    const float *rw_mix, *rw_wr, *rw_wk, *rw_wv, *rw_w0, *rw_w1, *rw_w2, *rw_a0, *rw_a1, *rw_a2, *rw_g1, *rw_g2, *rw_kk, *rw_ka, *rw_rk, *rw_lnx_w, *rw_lnx_b, *rw_wo;
    const float *sb_wqkv, *sb_wo, *xa_wq, *xa_wkv, *xa_wo, *moe_wg, *moe_bg, *moe_we, *moe_be, *moe_w1, *moe_w3, *moe_w2;
};
struct Args { In in; float* out; unsigned char* ws; int ph_lo, ph_hi; };
struct InL { const LAS unsigned long long* p;
    __device__ __forceinline__ const float* get(int i) const { const unsigned long long v = p[i]; const unsigned lo = __builtin_amdgcn_readfirstlane((unsigned)v), hi = __builtin_amdgcn_readfirstlane((unsigned)(v >> 32)); return (const float*)(((unsigned long long)hi << 32) | lo); } };
#define IN(name) (in.get((int)(offsetof(In, name) / 8)))

__device__ __forceinline__ void rms_row_to_bf16(const float* xrow, const float* gain, bf16_t* orow, int lane) {
    const f32x4* xr = (const f32x4*)xrow + lane; f32x4 v[4]; float s = 0.f;
#pragma unroll
    for (int j = 0; j < 4; ++j) { v[j] = xr[64 * j]; s += (v[j].x * v[j].x + v[j].y * v[j].y) + (v[j].z * v[j].z + v[j].w * v[j].w); }
    const float rs = rsqrtf(wave_sum(s) * (1.f / DM) + NORM_EPS);
#pragma unroll
    for (int j = 0; j < 4; ++j) { const f32x4 g = gain ? ((const f32x4*)gain)[lane + 64 * j] : (f32x4){1.f, 1.f, 1.f, 1.f}; ((u32x2*)orow)[lane + 64 * j] = pack4(v[j] * rs * g); }
}

__device__ __forceinline__ void p_prologue(const Ctx& c, const InL& in, unsigned char* ws, LAS unsigned char* lds) {
    PHASE_IDS;
    LAS float* scr = (LAS float*)(lds + c.wave * 16384);
    constexpr int I_SQ = 16 * 16;
    constexpr int I_QKV = 16 * 48, I_KV = 16 * 32;
    constexpr int I_L64 = 16 * 1, I_L128 = 16 * 2;
    constexpr int I_M13 = 16 * 4;
    constexpr int I_M2 = 4 * 16;
    constexpr int NITEMS = 4 * I_SQ + 2 * (2 * I_L64 + I_L128) + I_QKV + I_SQ + 4 * I_SQ + I_KV + 2 * 64 * I_M13 + 64 * I_M2;
    for (int it = c.gw; it < NITEMS; it += c.NGW) {
        int r = it;
        if (r < I_SQ) { tr_item(IN(rw_wr), DM, DM, (bf16_t*)(ws + WS_WR), 0, scr, r, lane); continue; } r -= I_SQ;
        if (r < I_SQ) { tr_item(IN(rw_wk), DM, DM, (bf16_t*)(ws + WS_WK), 0, scr, r, lane); continue; } r -= I_SQ;
        if (r < I_SQ) { tr_item(IN(rw_wv), DM, DM, (bf16_t*)(ws + WS_WV), 0, scr, r, lane); continue; } r -= I_SQ;
        if (r < I_SQ) { tr_item(IN(rw_wo), DM, DM, (bf16_t*)(ws + WS_WO0), 0, scr, r, lane); continue; } r -= I_SQ;
        if (r < 2 * (2 * I_L64 + I_L128)) {
            const int q = r / (2 * I_L64 + I_L128), rr = r % (2 * I_L64 + I_L128); const int mode = 1 + q; bf16_t* WT = (bf16_t*)(ws + WS_WPQ);
            if (rr < I_L64) tr_item(IN(rw_w1), DM, 64, WT, 256 * q + 0, scr, rr, lane, IN(rw_mix) + 1 * DM, mode);
            else if (rr < 2 * I_L64) tr_item(IN(rw_a1), DM, 64, WT, 256 * q + 64, scr, rr - I_L64, lane, IN(rw_mix) + 4 * DM, mode);
            else tr_item(IN(rw_g1), DM, 128, WT, 256 * q + 128, scr, rr - 2 * I_L64, lane, IN(rw_mix) + 5 * DM, mode);
            continue; } r -= 2 * (2 * I_L64 + I_L128);
        if (r < I_QKV) { tr_item(IN(sb_wqkv), DM, 3 * DM, (bf16_t*)(ws + WS_SBQKV), 0, scr, r, lane, IN(norm_mix) + DM, 2); continue; } r -= I_QKV;
        if (r < I_SQ) { tr_item(IN(sb_wo), DM, DM, (bf16_t*)(ws + WS_SBWO), 0, scr, r, lane); continue; } r -= I_SQ;
        if (r < 2 * I_SQ) { const int l = r / I_SQ; cp_item(IN(xa_wq) + (size_t)l * DM * DM, DM, (bf16_t*)(ws + WS_XAWQ) + (size_t)l * DM * DM, r % I_SQ, lane, IN(norm_cross) + l * DM); continue; } r -= 2 * I_SQ;
        if (r < 2 * I_SQ) { const int l = r / I_SQ; tr_item(IN(xa_wo) + (size_t)l * DM * DM, DM, DM, (bf16_t*)(ws + WS_XAWO) + (size_t)l * DM * DM, 0, scr, r % I_SQ, lane); continue; } r -= 2 * I_SQ;
        if (r < I_KV) { tr_item(IN(xa_wkv), DM, 2 * DM, (bf16_t*)(ws + WS_XAWKV), 0, scr, r, lane); continue; } r -= I_KV;
        if (r < 2 * 64 * I_M13) {
            const int which = r / (64 * I_M13), rr = r % (64 * I_M13), le = rr / I_M13, item = rr % I_M13;
            const float* W = (which ? IN(moe_w3) : IN(moe_w1)) + (size_t)le * DM * DF; bf16_t* WT = (bf16_t*)(ws + WS_W13) + (size_t)le * 512 * DM;
            const int nblk = DF / 64, kb = item / nblk, nb = item % nblk, n0 = 64 * nb;
            tr_block(W, DF, 64 * kb, n0, WT, DM, (n0 / 128) * 256 + (n0 % 128) + which * 128, scr, lane, IN(norm_ffn) + (le / NE) * DM, 2);
            continue; } r -= 2 * 64 * I_M13;
        { const int le = r / I_M2, item = r % I_M2; tr_item(IN(moe_w2) + (size_t)le * DF * DM, DF, DM, (bf16_t*)(ws + WS_W2) + (size_t)le * DM * DF, 0, scr, item, lane); }
    }
    const int gt = c.bid * 512 + tid, NT = c.G * 512;
    for (int i = gt; i < 2 * 256 * DM; i += NT) { const int l = i / (256 * DM), n = (i / DM) % 256, k = i % DM; float v = 0.f;
        if (n < NG) v = IN(moe_wg)[((size_t)l * DM + k) * NG + n]; else if (n < NG + NE) v = IN(moe_we)[((size_t)l * DM + k) * NE + (n - NG)];
        ((bf16_t*)(ws + WS_ROUTE))[i] = (bf16_t)f2bf(v * IN(norm_ffn)[l * DM + k]); }
    for (int i = gt; i < 3072 * 256; i += NT) { const int n = i / 256, k = i % 256, t = n / 1024, nn = n % 1024; float v = 0.f;
        if (t == 0) { if (k < 64) v = IN(rw_w2)[(size_t)k * DM + nn]; } else if (t == 1) { if (k >= 64 && k < 128) v = IN(rw_a2)[(size_t)(k - 64) * DM + nn]; } else { if (k >= 128) v = IN(rw_g2)[(size_t)(k - 128) * DM + nn]; }
        ((bf16_t*)(ws + WS_WL2))[i] = (bf16_t)f2bf(v); }
    for (int m = c.gw; m < BATCH * NMEM; m += c.NGW) rms_row_to_bf16(IN(mem) + (size_t)m * DM, IN(norm_mem), (bf16_t*)(ws + WS_MEMN) + (size_t)m * DM, lane);
}

__device__ __forceinline__ void p_norm_shift(const Ctx& c, const InL& in, int g, bf16_t* hn, bf16_t* xr, bf16_t* xk, bf16_t* xv) {
    PHASE_IDS;
    const int NGW = c.G * 8; const float* xin = IN(x); const float* gnp = IN(norm_mix); const float* mixp = IN(rw_mix);
    for (int row0 = c.bid * 8 + c.wave; row0 < TG; row0 += 2 * NGW) {
        f32x4 v[2][4], p[2][4]; bool first[2];
#pragma unroll
        for (int q = 0; q < 2; ++q) { const int t = g * TG + row0 + q * NGW; first[q] = (t % SEQ) == 0;
            const f32x4* xc = (const f32x4*)(xin + (size_t)t * DM) + lane; const f32x4* xp = (const f32x4*)(xin + (size_t)(first[q] ? t : t - 1) * DM) + lane;
#pragma unroll
            for (int j = 0; j < 4; ++j) { v[q][j] = xc[64 * j]; p[q][j] = xp[64 * j]; } }
#pragma unroll
        for (int q = 0; q < 2; ++q) { const int row = row0 + q * NGW; float s = 0.f, sp = 0.f;
#pragma unroll
            for (int j = 0; j < 4; ++j) { s += (v[q][j].x * v[q][j].x + v[q][j].y * v[q][j].y) + (v[q][j].z * v[q][j].z + v[q][j].w * v[q][j].w); sp += (p[q][j].x * p[q][j].x + p[q][j].y * p[q][j].y) + (p[q][j].z * p[q][j].z + p[q][j].w * p[q][j].w); }
            const float rs = rsqrtf(wave_sum(s) * (1.f / DM) + NORM_EPS); const float rpv = rsqrtf(wave_sum(sp) * (1.f / DM) + NORM_EPS); const float rp = first[q] ? 0.f : rpv;
#pragma unroll
            for (int j = 0; j < 4; ++j) { const int ci = lane + 64 * j; const f32x4 gn = ((const f32x4*)gnp)[ci];
                const f32x4 h = v[q][j] * rs * gn, hp = p[q][j] * rp * gn, dx = hp - h;
                const f32x4 mr = ((const f32x4*)(mixp + 0 * DM))[ci], mk = ((const f32x4*)(mixp + 2 * DM))[ci], mv = ((const f32x4*)(mixp + 3 * DM))[ci];
                const size_t o = (size_t)row * (DM / 4) + ci;
                ((u32x2*)hn)[o] = pack4(h); ((u32x2*)xr)[o] = pack4(h + dx * mr); ((u32x2*)xk)[o] = pack4(h + dx * mk); ((u32x2*)xv)[o] = pack4(h + dx * mv); } }
    }
}
__device__ __forceinline__ void p_lora_act(const Ctx& c, const bf16_t* pq, bf16_t* act) {
    PHASE_IDS;
    for (int row = c.gw; row < TG; row += c.NGW) {
        const bool first = (row % SEQ) == 0;
        f32x4 u = unpack4(((const u32x2*)(pq + (size_t)row * 512))[lane]);
        if (!first) u += unpack4(((const u32x2*)(pq + (size_t)(row - 1) * 512 + 256))[lane]);
        f32x4 o;
#pragma unroll
        for (int e = 0; e < 4; ++e) { const float x = u[e]; o[e] = (lane < 16) ? (1.f - 2.f * __builtin_amdgcn_rcpf(1.f + __expf(2.f * x))) : (lane < 32 ? x : sigm(x)); }
        ((u32x2*)(act + (size_t)row * 256))[lane] = pack4(o);
    }
}
typedef _Float16 f16x8 __attribute__((ext_vector_type(8)));
typedef float f32x16 __attribute__((ext_vector_type(16)));
typedef __bf16 bf16x2_t __attribute__((ext_vector_type(2)));
__device__ __forceinline__ unsigned cvt2bf(float lo, float hi) { f32x2 v = {lo, hi}; bf16x2_t b = __builtin_convertvector(v, bf16x2_t); return __builtin_bit_cast(unsigned, b); }
__device__ __forceinline__ unsigned cvt2h(float lo, float hi) { return __builtin_bit_cast(unsigned, __builtin_amdgcn_cvt_pkrtz(lo, hi)); }
__device__ __forceinline__ bf16x8 frag144(const LAS unsigned char* img, int row, int s, int hh) { return *(const LAS bf16x8*)(img + row * 144 + s * 32 + hh * 16); }
__device__ __forceinline__ bf16x8 frag144s(const LAS unsigned char* img, int row, int s, int hh) { return *(const LAS bf16x8*)(img + row * 144 + (((2 * s + hh) ^ ((row >> 3) & 7)) << 4)); }
__device__ __forceinline__ void s1_solve(const Ctx& c, const LAS unsigned char* I_A, const LAS unsigned char* I_AB, const LAS unsigned char* TB, const LAS float* RZ, LAS unsigned char* AT, LAS unsigned char* I_XT) {
    constexpr int P = 144;
    const int ct = c.wave; LAS unsigned char* at = AT + ct * 512;
#pragma unroll
    for (int bb = 0; bb < 4; ++bb) {
        const int lane = lane_id(), c16 = lane & 15, g4 = lane >> 4, col = 16 * ct + c16;
        f32x4 d = (f32x4){0.f, 0.f, 0.f, 0.f};
        if (bb > 0) {
#pragma unroll
            for (int s = 0; s < (16 * bb + 31) / 32; ++s) {
                const bf16x8 a = *(const LAS bf16x8*)(I_AB + (16 * bb + c16) * P + s * 64 + g4 * 16), b = *(const LAS bf16x8*)(I_XT + col * P + s * 64 + g4 * 16);
                d = __builtin_amdgcn_mfma_f32_16x16x32_bf16(a, b, d, 0, 0, 0); }
        }
        if (ct < 4) {
#pragma unroll
            for (int e = 0; e < 4; ++e) d[e] += __uint_as_float(((unsigned)*(const LAS unsigned short*)(I_A + (16 * bb + 4 * g4 + e) * P + col * 2)) << 16);
        } else {
#pragma unroll
            for (int e = 0; e < 4; ++e) d[e] += RZ[(16 * bb + 4 * g4 + e) * 68 + (col - 64)];
        }
        { u32x2 w; w.x = cvt2bf(d[0], d[1]); w.y = cvt2bf(d[2], d[3]); *(LAS u32x2*)(at + c16 * 32 + 8 * g4) = w; }
        asm volatile("s_waitcnt lgkmcnt(0)" ::: "memory");
        u32x4 bw = *(const LAS u32x4*)(at + c16 * 32 + 16 * (g4 & 1)); if (g4 >= 2) bw = (u32x4){0u, 0u, 0u, 0u};
        const bf16x8 a2 = *(const LAS bf16x8*)(TB + bb * 1024 + c16 * 64 + g4 * 16);
        const f32x4 x = __builtin_amdgcn_mfma_f32_16x16x32_bf16(a2, __builtin_bit_cast(bf16x8, bw), (f32x4){0.f, 0.f, 0.f, 0.f}, 0, 0, 0);
        { u32x2 w; w.x = cvt2bf(x[0], x[1]); w.y = cvt2bf(x[2], x[3]); *(LAS u32x2*)(I_XT + col * P + (16 * bb + 4 * g4) * 2) = w; }
        asm volatile("s_waitcnt lgkmcnt(0)" ::: "memory");
    }
}
__device__ __forceinline__ void s1_tinv(const LAS float* ADG, LAS unsigned char* TB) {
    const int lane = lane_id(), bq = lane >> 4, jc = lane & 15;
    float x[16];
#pragma unroll
    for (int ii = 0; ii < 16; ++ii) {
        const LAS f32x4* ar = (const LAS f32x4*)(ADG + bq * 256 + ii * 16); const f32x4 a0 = ar[0], a1 = ar[1], a2 = ar[2], a3 = ar[3];
        const float av[16] = {a0[0], a0[1], a0[2], a0[3], a1[0], a1[1], a1[2], a1[3], a2[0], a2[1], a2[2], a2[3], a3[0], a3[1], a3[2], a3[3]};
        float v = (ii == jc) ? 1.f : 0.f;
#pragma unroll
        for (int jj = 0; jj < ii; ++jj) v += av[jj] * x[jj];
        x[ii] = v;
        *(LAS unsigned short*)(TB + bq * 1024 + ii * 64 + jc * 2) = (unsigned short)f2bf(v);
    }
    *(LAS u32x4*)(TB + bq * 1024 + jc * 64 + 32) = (u32x4){0u, 0u, 0u, 0u}; *(LAS u32x4*)(TB + bq * 1024 + jc * 64 + 48) = (u32x4){0u, 0u, 0u, 0u};
}
__device__ __forceinline__ void p_scan_s1(const Ctx& c, const InL& in, const bf16_t* R, const bf16_t* Kb, const bf16_t* Vb, const bf16_t* WL, const bf16_t* Ab,
                                          bf16_t* RH, bf16_t* YL, bf16_t* MM, bf16_t* NT, float* bonus, LAS unsigned char* lds) {
    PHASE_IDS;
    constexpr int P = 144, IMG = 64 * P;
    LAS unsigned char* I_R = lds; LAS unsigned char* I_BT = lds + IMG; LAS unsigned char* I_KT = lds + 2 * IMG; LAS unsigned char* I_VT = lds + 3 * IMG;
    LAS unsigned char* I_AK = lds + 4 * IMG; LAS unsigned char* I_RB = lds + 5 * IMG; LAS unsigned char* I_RK = lds + 6 * IMG;
    LAS unsigned char* I_A = lds + 7 * IMG; LAS unsigned char* I_B = lds + 8 * IMG; LAS unsigned char* I_K = lds + 9 * IMG; LAS unsigned char* I_XT = I_B;
    LAS float* A4 = (LAS float*)(lds + 10 * IMG);
    LAS unsigned char* I_AB = lds + 10 * IMG; LAS float* ADG = (LAS float*)(lds + 10 * IMG + IMG); LAS unsigned char* TB = lds + 10 * IMG + IMG + 4096;
    LAS unsigned char* AT = I_AK;
    LAS float* RZ = (LAS float*)(lds + 10 * IMG + 17408);
    LAS float* PL = (LAS float*)(lds + 10 * IMG + 2 * 17408);
    LAS float* TOT = PL + 64;
    u32x4 nrw, nkw, nvw, nww, naw;
#define S1_LOAD(uu) do { const int ch_ = (uu) % (SEQ / 64), h_ = ((uu) / (SEQ / 64)) % NH, bl_ = (uu) / ((SEQ / 64) * NH); \
        const size_t off_ = ((size_t)(bl_ * SEQ + ch_ * 64 + (tid >> 3))) * DM + h_ * HD + (tid & 7) * 8; \
        nrw = *(const u32x4*)(R + off_); nkw = *(const u32x4*)(Kb + off_); nvw = *(const u32x4*)(Vb + off_); nww = *(const u32x4*)(WL + off_); naw = *(const u32x4*)(Ab + off_); } while (0)
    if (c.bid < BG * NH * (SEQ / 64)) S1_LOAD(c.bid);
    for (int u = c.bid; u < BG * NH * (SEQ / 64); u += c.G) {
        const int ch = u % (SEQ / 64), h = (u / (SEQ / 64)) % NH, bl = u / ((SEQ / 64) * NH);
        __syncthreads();
        {
            const int lane = lane_id(), tid = c.wave * 64 + lane;
            const int i = tid >> 3, n8 = (tid & 7) * 8;
            const u32x4 rw = nrw, kw = nkw, vw = nvw, ww = nww, aw = naw;
            float rr[8] = {bflo(rw.x), bfhi(rw.x), bflo(rw.y), bfhi(rw.y), bflo(rw.z), bfhi(rw.z), bflo(rw.w), bfhi(rw.w)};
            float kx[8] = {bflo(kw.x), bfhi(kw.x), bflo(kw.y), bfhi(kw.y), bflo(kw.z), bfhi(kw.z), bflo(kw.w), bfhi(kw.w)};
            float wx[8] = {bflo(ww.x), bfhi(ww.x), bflo(ww.y), bfhi(ww.y), bflo(ww.z), bfhi(ww.z), bflo(ww.w), bfhi(ww.w)};
            float ax[8] = {bflo(aw.x), bfhi(aw.x), bflo(aw.y), bfhi(aw.y), bflo(aw.z), bfhi(aw.z), bflo(aw.w), bfhi(aw.w)};
            const float* pkk = IN(rw_kk) + h * HD + n8; const float* pka = IN(rw_ka) + h * HD + n8;
            float kk[8], kp[8], bb[8]; float ssq = 0.f;
#pragma unroll
            for (int e = 0; e < 8; ++e) { kk[e] = kx[e] * pkk[e]; ssq += kk[e] * kk[e]; kp[e] = kx[e] * (1.f + (ax[e] - 1.f) * pka[e]); }
            ssq = sum8(ssq); const float inv = 1.f / fmaxf(sqrtf(ssq), 1e-12f);
            { const float* prk = IN(rw_rk) + h * HD + n8; float bo = 0.f;
#pragma unroll
              for (int e = 0; e < 8; ++e) bo += rr[e] * kp[e] * prk[e];
              bo = sum8(bo); if ((tid & 7) == 0) bonus[(size_t)(bl * SEQ + ch * 64 + i) * NH + h] = bo; }
#pragma unroll
            for (int e = 0; e < 8; ++e) { kk[e] *= inv; bb[e] = kk[e] * ax[e]; }
            LAS float* CW = A4;
            *(LAS f32x4*)(CW + i * 64 + n8) = (f32x4){wx[0], wx[1], wx[2], wx[3]}; *(LAS f32x4*)(CW + i * 64 + n8 + 4) = (f32x4){wx[4], wx[5], wx[6], wx[7]};
            __syncthreads();
            { const int n = tid & 63, seg = tid >> 6; float acc = 0.f;
#pragma unroll
              for (int e = 0; e < 8; ++e) { acc += CW[(8 * seg + e) * 64 + n]; CW[(8 * seg + e) * 64 + n] = acc; }
              TOT[seg * 64 + n] = acc; }
            __syncthreads();
            float cw[8];
            { const f32x4 c0 = *(const LAS f32x4*)(CW + i * 64 + n8), c1 = *(const LAS f32x4*)(CW + i * 64 + n8 + 4);
              cw[0] = c0.x; cw[1] = c0.y; cw[2] = c0.z; cw[3] = c0.w; cw[4] = c1.x; cw[5] = c1.y; cw[6] = c1.z; cw[7] = c1.w;
              const int seg = i >> 3;
              for (int sp = 0; sp < seg; ++sp) { const f32x4 t0 = *(const LAS f32x4*)(TOT + sp * 64 + n8), t1 = *(const LAS f32x4*)(TOT + sp * 64 + n8 + 4);
                  cw[0] += t0.x; cw[1] += t0.y; cw[2] += t0.z; cw[3] += t0.w; cw[4] += t1.x; cw[5] += t1.y; cw[6] += t1.z; cw[7] += t1.w; } }
            float at[8], bt[8], kt[8], rt[8];
#pragma unroll
            for (int e = 0; e < 8; ++e) { const float ein = __expf(cw[e]), eex = __expf(cw[e] - wx[e]), eng = __expf(-cw[e]);
                at[e] = -kk[e] * eex; bt[e] = bb[e] * eng; kt[e] = kp[e] * eng; rt[e] = rr[e] * ein; if (i == 63) PL[n8 + e] = ein; }
            u32x4 w;
            w.x = cvt2bf(at[0], at[1]); w.y = cvt2bf(at[2], at[3]); w.z = cvt2bf(at[4], at[5]); w.w = cvt2bf(at[6], at[7]); *(LAS u32x4*)(I_A + i * P + n8 * 2) = w;
            w.x = cvt2bf(rt[0], rt[1]); w.y = cvt2bf(rt[2], rt[3]); w.z = cvt2bf(rt[4], rt[5]); w.w = cvt2bf(rt[6], rt[7]); *(LAS u32x4*)(I_R + i * P + n8 * 2) = w;
            u32x4 wb, wk;
            wb.x = cvt2bf(bt[0], bt[1]); wb.y = cvt2bf(bt[2], bt[3]); wb.z = cvt2bf(bt[4], bt[5]); wb.w = cvt2bf(bt[6], bt[7]); *(LAS u32x4*)(I_B + i * P + n8 * 2) = wb;
            wk.x = cvt2bf(kt[0], kt[1]); wk.y = cvt2bf(kt[2], kt[3]); wk.z = cvt2bf(kt[4], kt[5]); wk.w = cvt2bf(kt[6], kt[7]); *(LAS u32x4*)(I_K + i * P + n8 * 2) = wk;
            const unsigned tb[4] = {wb.x, wb.y, wb.z, wb.w}, tk[4] = {wk.x, wk.y, wk.z, wk.w}, tv[4] = {vw.x, vw.y, vw.z, vw.w};
#pragma unroll
            for (int e = 0; e < 8; ++e) { const int sh = (e & 1) * 16; const int ro = (n8 + e) * P + ((((i >> 3) ^ ((n8 >> 3) & 7)) << 4) | ((i & 7) * 2));
                *(LAS unsigned short*)(I_BT + ro) = (unsigned short)(tb[e >> 1] >> sh); *(LAS unsigned short*)(I_KT + ro) = (unsigned short)(tk[e >> 1] >> sh); *(LAS unsigned short*)(I_VT + ro) = (unsigned short)(tv[e >> 1] >> sh); }
        }
        __syncthreads();
        {
            const int lane = lane_id(), r = lane & 31, hh = lane >> 5;
            const int combo = c.wave >> 1, jt = c.wave & 1;
            const LAS unsigned char* Ximg = (combo & 1) ? I_K : I_B; const LAS unsigned char* Yimg = (combo >> 1) ? I_R : I_A;
            LAS unsigned char* Oimg = (combo == 1) ? I_AK : (combo == 2 ? I_RB : I_RK);
            const bool incl = combo >= 2;
#pragma unroll
            for (int tt = 0; tt < 2; ++tt) {
                f32x16 d;
#pragma unroll
                for (int e = 0; e < 16; ++e) d[e] = 0.f;
                if (tt >= jt) {
#pragma unroll
                    for (int s = 0; s < 4; ++s) d = __builtin_amdgcn_mfma_f32_32x32x16_bf16(frag144(Ximg, 32 * jt + r, s, hh), frag144(Yimg, 32 * tt + r, s, hh), d, 0, 0, 0);
                }
                const int t = 32 * tt + r;
#pragma unroll
                for (int e = 0; e < 16; ++e) { const int j = 32 * jt + (e & 3) + 8 * (e >> 2) + 4 * hh; const bool keep = incl ? (j <= t) : (j < t); d[e] = keep ? d[e] : 0.f; }
                if (combo == 0) {
#pragma unroll
                    for (int g = 0; g < 4; ++g) { u32x2 w; w.x = cvt2bf(d[4 * g], d[4 * g + 1]); w.y = cvt2bf(d[4 * g + 2], d[4 * g + 3]); *(LAS u32x2*)(I_AB + t * P + (32 * jt + 8 * g + 4 * hh) * 2) = w;
                        if ((2 * jt + (g >> 1)) == (t >> 4)) *(LAS f32x4*)(ADG + (t >> 4) * 256 + (t & 15) * 16 + ((8 * g + 4 * hh) & 15)) = (f32x4){d[4 * g], d[4 * g + 1], d[4 * g + 2], d[4 * g + 3]}; }
                } else {
#pragma unroll
                    for (int g = 0; g < 4; ++g) { u32x2 w; w.x = cvt2bf(d[4 * g], d[4 * g + 1]); w.y = cvt2bf(d[4 * g + 2], d[4 * g + 3]); *(LAS u32x2*)(Oimg + t * P + (32 * jt + 8 * g + 4 * hh) * 2) = w; }
                }
            }
        }
        __syncthreads();
        { const int tz = c.wave * 64 + lane_id(); for (int o = tz * 16; o < 128 * P; o += 512 * 16) *(LAS u32x4*)(I_XT + o) = (u32x4){0u, 0u, 0u, 0u}; }
        if (c.wave == 4) s1_tinv(ADG, TB);
        if (c.wave < 4) {
            const int lane = lane_id(), r = lane & 31, hh = lane >> 5;
            const int vt = c.wave >> 1, tt = c.wave & 1;
            f32x16 d;
#pragma unroll
            for (int e = 0; e < 16; ++e) d[e] = 0.f;
#pragma unroll
            for (int s = 0; s < 4; ++s) d = __builtin_amdgcn_mfma_f32_32x32x16_bf16(frag144s(I_VT, 32 * vt + r, s, hh), frag144(I_AK, 32 * tt + r, s, hh), d, 0, 0, 0);
            const int t = 32 * tt + r;
#pragma unroll
            for (int g = 0; g < 4; ++g) *(LAS f32x4*)(RZ + t * 68 + 32 * vt + 8 * g + 4 * hh) = (f32x4){d[4 * g], d[4 * g + 1], d[4 * g + 2], d[4 * g + 3]};
        }
        __syncthreads();
        if (u + c.G < BG * NH * (SEQ / 64)) { const int tid = c.wave * 64 + lane_id(); S1_LOAD(u + c.G); }
        s1_solve(c, I_A, I_AB, TB, RZ, AT, I_XT);
        __syncthreads();
        {
            const int lane = lane_id(), r = lane & 31, hh = lane >> 5;
            const int rt = (c.wave >> 1) & 1, ct = c.wave & 1; const bool mhi = c.wave >= 4;
            int u2 = u; asm volatile("" : "+s"(u2));
            const size_t ub = (size_t)u2 * 4096;
#pragma unroll
            for (int it = 0; it < 2; ++it) {
                const int mat = it == 0 ? (mhi ? 3 : 1) : (mhi ? 2 : 0);
                f32x16 d;
                const int cl = 32 * ct + r;
                if (mat == 0) {
#pragma unroll
                    for (int g = 0; g < 4; ++g) { const f32x4 v = unpack4(*(const LAS u32x2*)(I_R + cl * P + (32 * rt + 8 * g + 4 * hh) * 2)); d[4 * g] = v.x; d[4 * g + 1] = v.y; d[4 * g + 2] = v.z; d[4 * g + 3] = v.w; }
#pragma unroll
                    for (int s = 0; s < 4; ++s) d = __builtin_amdgcn_mfma_f32_32x32x16_bf16(frag144(I_XT, 32 * rt + r, s, hh), frag144(I_RB, cl, s, hh), d, 0, 0, 0);
                } else {
#pragma unroll
                    for (int e = 0; e < 16; ++e) d[e] = 0.f;
                    if (mat == 1) {
#pragma unroll
                        for (int s = 0; s < 4; ++s) d = __builtin_amdgcn_mfma_f32_32x32x16_bf16(frag144(I_XT, 64 + 32 * rt + r, s, hh), frag144(I_RB, cl, s, hh), d, 0, 0, 0);
#pragma unroll
                        for (int s = 0; s < 4; ++s) d = __builtin_amdgcn_mfma_f32_32x32x16_bf16(frag144s(I_VT, 32 * rt + r, s, hh), frag144(I_RK, cl, s, hh), d, 0, 0, 0);
                    } else if (mat == 2) {
#pragma unroll
                        for (int s = 0; s < 4; ++s) d = __builtin_amdgcn_mfma_f32_32x32x16_bf16(frag144(I_XT, 32 * rt + r, s, hh), frag144s(I_BT, cl, s, hh), d, 0, 0, 0);
                        const float pl = PL[cl];
#pragma unroll
                        for (int e = 0; e < 16; ++e) { const int k = 32 * rt + (e & 3) + 8 * (e >> 2) + 4 * hh; d[e] = (d[e] + (k == cl ? 1.f : 0.f)) * pl; }
                    } else {
#pragma unroll
                        for (int s = 0; s < 4; ++s) d = __builtin_amdgcn_mfma_f32_32x32x16_bf16(frag144s(I_BT, 32 * rt + r, s, hh), frag144(I_XT, 64 + cl, s, hh), d, 0, 0, 0);
#pragma unroll
                        for (int s = 0; s < 4; ++s) d = __builtin_amdgcn_mfma_f32_32x32x16_bf16(frag144s(I_KT, 32 * rt + r, s, hh), frag144s(I_VT, cl, s, hh), d, 0, 0, 0);
#pragma unroll
                        for (int g = 0; g < 4; ++g) { const f32x4 pl = *(const LAS f32x4*)(PL + 32 * rt + 8 * g + 4 * hh); d[4 * g] *= pl.x; d[4 * g + 1] *= pl.y; d[4 * g + 2] *= pl.z; d[4 * g + 3] *= pl.w; }
                    }
                }
                bf16_t* ob = (mat == 0 ? RH : mat == 1 ? YL : mat == 2 ? MM : NT) + ub + (size_t)cl * 64 + 32 * rt + 4 * hh;
#pragma unroll
                for (int g = 0; g < 4; g += 2) { u32x2 w0, w1; w0.x = cvt2bf(d[4 * g], d[4 * g + 1]); w0.y = cvt2bf(d[4 * g + 2], d[4 * g + 3]); w1.x = cvt2bf(d[4 * g + 4], d[4 * g + 5]); w1.y = cvt2bf(d[4 * g + 6], d[4 * g + 7]);
                    store_pair16(ob + 8 * g, hh, w0, w1); }
            }
        }
    }
}
__device__ __forceinline__ bf16x8 ldfrag8(const bf16_t* p) { const u32x2 lo = *(const u32x2*)p, hi = *(const u32x2*)(p + 8); u32x4 v; v.x = lo.x; v.y = lo.y; v.z = hi.x; v.w = hi.y; return __builtin_bit_cast(bf16x8, v); }
__device__ __forceinline__ bf16x8 packacc(const f32x16& x, int s) { u32x4 w; w.x = cvt2bf(x[8 * s], x[8 * s + 1]); w.y = cvt2bf(x[8 * s + 2], x[8 * s + 3]); w.z = cvt2bf(x[8 * s + 4], x[8 * s + 5]); w.w = cvt2bf(x[8 * s + 6], x[8 * s + 7]); return __builtin_bit_cast(bf16x8, w); }
__device__ __forceinline__ int s2_off(int row, int chunk, int sub) { return row * 128 + ((chunk ^ ((row ^ (row >> 3)) & 7)) << 4) + sub; }
__device__ __forceinline__ bf16x8 s2_frag(const LAS unsigned char* mat, int row, int ch, int hh) {
    const u32x2 lo = *(const LAS u32x2*)(mat + s2_off(row, ch, 8 * hh)), hi = *(const LAS u32x2*)(mat + s2_off(row, ch + 1, 8 * hh)); u32x4 v; v.x = lo.x; v.y = lo.y; v.z = hi.x; v.w = hi.y; return __builtin_bit_cast(bf16x8, v); }
__device__ __forceinline__ void p_scan_s2(const Ctx& c, const InL& in, const bf16_t* RH, const bf16_t* YL, const bf16_t* MM, const bf16_t* NT, const float* bonus, const bf16_t* Vb, const bf16_t* Gt, bf16_t* Z, LAS unsigned char* lds) {
    PHASE_IDS;
    constexpr int NCH = SEQ / 64, SLOT = 32768;
    for (int bh = c.bid; bh < BG * NH; bh += c.G) {
        const int bl = bh / NH, h = bh % NH;
        __syncthreads();
#define S2_ISSUE(ch) do { int ln_ = lane; asm volatile("" : "+v"(ln_)); const size_t ub_ = ((size_t)bh * NCH + (ch)) * 4096; LAS unsigned char* sl_ = lds + ((ch) & 3) * SLOT; \
        _Pragma("unroll") for (int j_ = 0; j_ < 8; ++j_) { const int d_ = ((c.wave - 4) * 8 + j_) * 64 + ln_, q_ = d_ >> 9, row_ = (d_ >> 3) & 63, cp_ = d_ & 7; \
            const bf16_t* src_ = (q_ == 0 ? RH : q_ == 1 ? YL : q_ == 2 ? MM : NT) + ub_ + row_ * 64 + ((cp_ ^ ((row_ ^ (row_ >> 3)) & 7)) << 3); \
            __builtin_amdgcn_global_load_lds((const unsigned*)src_, (LAS unsigned*)(sl_ + ((c.wave - 4) * 8 + j_) * 1024), 16, 0, 0); } } while (0)
        if (c.wave >= 4) { S2_ISSUE(0); S2_ISSUE(1); S2_ISSUE(2); asm volatile("s_waitcnt vmcnt(16)" ::: "memory"); }
        __syncthreads();
        f32x4 plw = {0.f, 0.f, 0.f, 0.f}, plb = {0.f, 0.f, 0.f, 0.f};
        if (c.wave == 2 || c.wave == 3) { int lp = lane; asm volatile("" : "+v"(lp)); plw = *(const f32x4*)(IN(rw_lnx_w) + h * HD + (lp & 15) * 4); plb = *(const f32x4*)(IN(rw_lnx_b) + h * HD + (lp & 15) * 4);
            asm volatile("" : "+v"(plw), "+v"(plb)); }
        f32x16 H0, H1;
#pragma unroll
        for (int e = 0; e < 16; ++e) { H0[e] = 0.f; H1[e] = 0.f; }
#pragma unroll 1
        for (int ch = 0; ch <= NCH; ++ch) {
            if (c.wave >= 4) {
                if (ch < NCH) {
                if (ch + 3 < NCH) S2_ISSUE(ch + 3);
                const int pend = (ch + 3 < NCH ? ch + 3 : NCH - 1) - (ch + 1);
                if (pend >= 2) asm volatile("s_waitcnt vmcnt(16)" ::: "memory"); else if (pend == 1) asm volatile("s_waitcnt vmcnt(8)" ::: "memory"); else asm volatile("s_waitcnt vmcnt(0)" ::: "memory");
                }
            } else if (c.wave >= 2) {
                if (ch >= 1) {
                    int lp = lane; asm volatile("" : "+v"(lp));
                    const LAS unsigned char* yb = lds + LDS_YB + ((ch + 1) & 1) * (64 * 136) + (32 * (c.wave - 2) + (lp >> 4)) * 136 + (lp & 15) * 8;
                    const size_t rowp = (size_t)bl * SEQ + (ch - 1) * 64 + 32 * (c.wave - 2) + (lp >> 4), offp = rowp * DM + h * HD + (lp & 15) * 4;
                    u32x2 pv[8], pg[8], yw[8]; float pb[8]; f32x4 tn[8];
#pragma unroll
                    for (int q = 0; q < 8; ++q) { pv[q] = *(const u32x2*)(Vb + offp + (size_t)4 * q * DM); pg[q] = *(const u32x2*)(Gt + offp + (size_t)4 * q * DM); pb[q] = bonus[(rowp + 4 * q) * NH + h]; }
                    asm volatile("ds_read_b64 %0, %8\n\tds_read_b64 %1, %8 offset:544\n\tds_read_b64 %2, %8 offset:1088\n\tds_read_b64 %3, %8 offset:1632\n\tds_read_b64 %4, %8 offset:2176\n\tds_read_b64 %5, %8 offset:2720\n\t"
                                 "ds_read_b64 %6, %8 offset:3264\n\tds_read_b64 %7, %8 offset:3808\n\ts_waitcnt lgkmcnt(0)"
                                 : "=&v"(yw[0]), "=&v"(yw[1]), "=&v"(yw[2]), "=&v"(yw[3]), "=&v"(yw[4]), "=&v"(yw[5]), "=&v"(yw[6]), "=&v"(yw[7]) : "v"((unsigned)(size_t)yb) : "memory");
#pragma unroll
                    for (int q = 0; q < 8; ++q) {
                        const f32x4 y4 = unpack4(yw[q]);
                        const float mu = sum16((y4.x + y4.y) + (y4.z + y4.w)) * (1.f / 64.f);
                        const f32x4 dy = y4 - mu; const float var = sum16((dy.x * dy.x + dy.y * dy.y) + (dy.z * dy.z + dy.w * dy.w)) * (1.f / 64.f);
                        tn[q] = dy * rsqrtf(var + GN_EPS) * plw + plb;
                    }
                    asm volatile("" : "+v"(tn[0]), "+v"(tn[1]), "+v"(tn[2]), "+v"(tn[3]), "+v"(tn[4]), "+v"(tn[5]), "+v"(tn[6]), "+v"(tn[7]) :: "memory");
                    asm volatile("" : "+v"(pv[0]), "+v"(pv[1]), "+v"(pv[2]), "+v"(pv[3]), "+v"(pv[4]), "+v"(pv[5]), "+v"(pv[6]), "+v"(pv[7]), "+v"(pg[0]), "+v"(pg[1]), "+v"(pg[2]), "+v"(pg[3]), "+v"(pg[4]), "+v"(pg[5]), "+v"(pg[6]), "+v"(pg[7]),
                                 "+v"(pb[0]), "+v"(pb[1]), "+v"(pb[2]), "+v"(pb[3]), "+v"(pb[4]), "+v"(pb[5]), "+v"(pb[6]), "+v"(pb[7]) :: "memory");
                    bf16_t* zo = Z + offp;
#pragma unroll
                    for (int q = 0; q < 8; ++q) { const f32x4 z = (tn[q] + pb[q] * unpack4(pv[q])) * unpack4(pg[q]); *(u32x2*)(zo + (size_t)4 * q * DM) = pack4(z); }
                }
            } else if (ch < NCH) {
                int lo_ = lane; asm volatile("" : "+v"(lo_)); const int r = lo_ & 31, hh = lo_ >> 5, vt = c.wave;
                const LAS unsigned char* sl = lds + (ch & 3) * SLOT; const LAS unsigned char* rh = sl; const LAS unsigned char* yl = sl + 8192; const LAS unsigned char* mm = sl + 16384; const LAS unsigned char* nt = sl + 24576;
                bf16x8 hp[2][2];
#pragma unroll
                for (int s = 0; s < 2; ++s) { hp[0][s] = packacc(H0, s); hp[1][s] = packacc(H1, s); }
#pragma unroll
                for (int tt = 0; tt < 2; ++tt) {
                    f32x16 a; const int t = 32 * tt + r;
#pragma unroll
                    for (int g = 0; g < 4; ++g) { const f32x4 v = unpack4(*(const LAS u32x2*)(yl + s2_off(t, 4 * vt + g, 8 * hh))); a[4 * g] = v.x; a[4 * g + 1] = v.y; a[4 * g + 2] = v.z; a[4 * g + 3] = v.w; }
#pragma unroll
                    for (int kt = 0; kt < 2; ++kt)
#pragma unroll
                        for (int s = 0; s < 2; ++s) a = __builtin_amdgcn_mfma_f32_32x32x16_bf16(hp[kt][s], s2_frag(rh, t, 4 * kt + 2 * s, hh), a, 0, 0, 0);
                    LAS unsigned char* yo = lds + LDS_YB + (ch & 1) * (64 * 136) + t * 136 + (32 * vt + 4 * hh) * 2;
#pragma unroll
                    for (int g = 0; g < 4; ++g) { u32x2 w; w.x = cvt2bf(a[4 * g], a[4 * g + 1]); w.y = cvt2bf(a[4 * g + 2], a[4 * g + 3]); *(LAS u32x2*)(yo + 16 * g) = w; }
                }
                f32x16 n0, n1;
#pragma unroll
                for (int kq = 0; kq < 2; ++kq) {
                    f32x16 a; const int v = 32 * vt + r;
#pragma unroll
                    for (int g = 0; g < 4; ++g) { const f32x4 x = unpack4(*(const LAS u32x2*)(nt + s2_off(v, 4 * kq + g, 8 * hh))); a[4 * g] = x.x; a[4 * g + 1] = x.y; a[4 * g + 2] = x.z; a[4 * g + 3] = x.w; }
#pragma unroll
                    for (int kt = 0; kt < 2; ++kt)
#pragma unroll
                        for (int s = 0; s < 2; ++s) a = __builtin_amdgcn_mfma_f32_32x32x16_bf16(s2_frag(mm, 32 * kq + r, 4 * kt + 2 * s, hh), hp[kt][s], a, 0, 0, 0);
                    if (kq == 0) n0 = a; else n1 = a;
                }
                H0 = n0; H1 = n1;
            }
            asm volatile("s_waitcnt lgkmcnt(0)" ::: "memory"); __builtin_amdgcn_s_barrier(); asm volatile("" ::: "memory");
        }
#undef S2_ISSUE
    }
}
__device__ __forceinline__ void p_scan_post(const Ctx& c, const InL& in, const bf16_t* Yb, const float* bonus, const bf16_t* Vb, const bf16_t* Gt, bf16_t* Z) {
    PHASE_IDS;
    const int gt = c.bid * 512 + tid, NT_ = c.G * 512;
    const int col = (gt & 255) * 4;
    const f32x4 lw = *(const f32x4*)(IN(rw_lnx_w) + col), lb = *(const f32x4*)(IN(rw_lnx_b) + col);
    for (int it = gt; it < TG * 256; it += 4 * NT_) {
        u32x2 yw[4], vw[4], gw[4]; float bo[4];
#pragma unroll
        for (int q = 0; q < 4; ++q) { const int row = (it + q * NT_) >> 8; const size_t off = (size_t)row * DM + col;
            yw[q] = *(const u32x2*)(Yb + off); vw[q] = *(const u32x2*)(Vb + off); gw[q] = *(const u32x2*)(Gt + off); bo[q] = bonus[(size_t)row * NH + (col >> 6)]; }
#pragma unroll
        for (int q = 0; q < 4; ++q) { const int row = (it + q * NT_) >> 8; const size_t off = (size_t)row * DM + col;
            const f32x4 y4 = unpack4(yw[q]), v4 = unpack4(vw[q]), g4 = unpack4(gw[q]);
            const float mu = sum16((y4.x + y4.y) + (y4.z + y4.w)) * (1.f / 64.f);
            const f32x4 dy = y4 - mu; const float var = sum16((dy.x * dy.x + dy.y * dy.y) + (dy.z * dy.z + dy.w * dy.w)) * (1.f / 64.f);
            const f32x4 z = (dy * rsqrtf(var + GN_EPS) * lw + lb + bo[q] * v4) * g4;
            *(u32x2*)(Z + off) = pack4(z); }
    }
}

template <class Sched> __device__ __forceinline__ void p_select(const Ctx& c, const Sched& S, const float* logit, const float* bg, const float* be, unsigned* gcnt, int* tok_e, int* tok_p, float* tok_w, int* rowtab, LAS unsigned char* lds) {
    PHASE_IDS;
    for (int i = c.bid * 512 + tid; i < MAXSLOT; i += c.G * 512) { rowtab[i] = 0; rowtab[STAB_OFF + i] = -1; }
    LAS int* lcnt = (LAS int*)(lds + LDS_HIST); LAS int* lbase = lcnt + NB;
    for (int it = 0; ; ++it) {
        pg8::Unit su; if (!S.next(it, su)) break; const int tb = su.pm * 256;
        if (tid < NB) lcnt[tid] = 0;
        __syncthreads();
        const bool act_ = tid < 256; const int t = tb + (act_ ? tid : 0); const f32x4* lr = (const f32x4*)(logit + (size_t)t * 64);
        const f32x4 gl = lr[0] + *(const f32x4*)bg;
        int grp = 0; float gm = gl.x; if (gl.y > gm) { gm = gl.y; grp = 1; } if (gl.z > gm) { gm = gl.z; grp = 2; } if (gl.w > gm) { gm = gl.w; grp = 3; }
        const float pg = 1.f / ((__expf(gl.x - gm) + __expf(gl.y - gm)) + (__expf(gl.z - gm) + __expf(gl.w - gm)));
        const float* er = logit + (size_t)t * 64 + 4 + 8 * grp; const float* eb = be + 8 * grp;
        float ev[8];
#pragma unroll
        for (int e = 0; e < 8; ++e) ev[e] = er[e] + eb[e];
        int i0 = 0; float m0 = ev[0];
#pragma unroll
        for (int e = 1; e < 8; ++e) if (ev[e] > m0) { m0 = ev[e]; i0 = e; }
        int i1 = -1; float m1 = -3.0e38f;
#pragma unroll
        for (int e = 0; e < 8; ++e) if (e != i0 && ev[e] > m1) { m1 = ev[e]; i1 = e; }
        const float e1 = __expf(m1 - m0), w0 = pg / (1.f + e1), w1 = pg * e1 / (1.f + e1);
        const int ea = grp * 8 + i0, eb2 = NE + grp * 8 + i1;
        int la = 0, lb = 0; if (act_) { la = atomicAdd((int*)&lcnt[ea], 1); lb = atomicAdd((int*)&lcnt[eb2], 1); }
        __syncthreads();
        if (tid < NB) lbase[tid] = (int)atomicAdd(&gcnt[tid], (unsigned)lcnt[tid]);
        __syncthreads();
        if (act_) { tok_e[2 * t] = ea; tok_e[2 * t + 1] = eb2; tok_p[2 * t] = lbase[ea] + la; tok_p[2 * t + 1] = lbase[eb2] + lb; tok_w[2 * t] = w0; tok_w[2 * t + 1] = w1; }
        __syncthreads();
    }
}
__device__ __forceinline__ void moe_table(const Ctx& c, unsigned* gcnt, LAS unsigned char* lds) {
    PHASE_IDS;
    LAS int* toff = (LAS int*)(lds + LDS_TOFF);
    LAS int* tmp = (LAS int*)(lds + LDS_HIST);
    __syncthreads();
    if (tid < NB) tmp[tid] = ((int)__hip_atomic_load(gcnt + tid, RLX_AGENT) + 255) >> 8;
    __syncthreads();
    if (tid == 0) { int o = 0; for (int e = 0; e < NB; ++e) { toff[e] = o; o += tmp[e]; } toff[NB] = o; }
    __syncthreads();
    { LAS unsigned char* texp = (LAS unsigned char*)(lds + LDS_TEXP); const int ntile = toff[NB];
      for (int m = tid; m < ntile; m += 512) { int e = 0; for (int k = 1; k < NB; ++k) if (toff[k] <= m) e = k; texp[m] = (unsigned char)(e & (NE - 1)); } }
    __syncthreads();
}
__device__ __forceinline__ void p_gather(const Ctx& c, const float* ssq, const int* tok_e, const int* tok_p, const float* tok_w, int* tok_s, float* gate, int* rowtab, LAS unsigned char* lds) {
    PHASE_IDS;
    const LAS int* toff = (const LAS int*)(lds + LDS_TOFF);
    for (int i = c.bid * 512 + tid; i < 2 * T; i += c.G * 512) {
        const int slot = toff[tok_e[i]] * 256 + tok_p[i];
        tok_s[i] = slot; rowtab[slot] = i >> 1; rowtab[STAB_OFF + slot] = i >> 1; { const float rs_ = pg8::rstd16(ssq, i >> 1); gate[2 * slot] = rs_; gate[2 * slot + 1] = tok_w[i] * rs_; }
    }
}
struct OrderMoE {
    const LAS int* toff; int G, c, npn; long sA, sBe, sBn; int mlo, mhi;
    __device__ __forceinline__ bool next(int i, pg8::Unit& u) const {
        const int cv = (G % 8 == 0) ? (c % 8) * (G / 8) + c / 8 : c;
        const int L = i * G + cv, m = mlo + L / npn; if (m >= mhi) return false;
        const int e = __builtin_amdgcn_readfirstlane((int)((const LAS unsigned char*)toff)[(LDS_TEXP - LDS_TOFF) + m]);
        u.pm = m; u.pn = L % npn; u.offA = m * sA; u.offB = e * sBe + u.pn * sBn; return true;
    }
};
template <bool FINAL> __device__ __forceinline__ void p_combine(const Ctx& c, bf16_t* h, float* outf, const bf16_t* Y, const int* tok_s, const float* gain, bf16_t* o) {
    PHASE_IDS;
    const int NGW = c.G * 8;
    for (int m0 = c.bid * 8 + c.wave; m0 < T; m0 += 4 * NGW) {
        int s0[4], s1[4];
#pragma unroll
        for (int q = 0; q < 4; ++q) { const int m = m0 + q * NGW; s0[q] = tok_s[2 * m]; s1[q] = tok_s[2 * m + 1]; }
        u32x2 rh[4][4], ya[4][4], yb[4][4];
#pragma unroll
        for (int q = 0; q < 4; ++q) { const int m = m0 + q * NGW; const u32x2* hp = (const u32x2*)(h + (size_t)m * DM) + lane; const u32x2* y0 = (const u32x2*)(Y + (size_t)s0[q] * DM) + lane; const u32x2* y1 = (const u32x2*)(Y + (size_t)s1[q] * DM) + lane;
#pragma unroll
            for (int j = 0; j < 4; ++j) { rh[q][j] = hp[64 * j]; ya[q][j] = y0[64 * j]; yb[q][j] = y1[64 * j]; } }
#pragma unroll
        for (int q = 0; q < 4; ++q) { const int m = m0 + q * NGW; f32x4 v[4]; float ss = 0.f;
#pragma unroll
            for (int j = 0; j < 4; ++j) { v[j] = unpack4(rh[q][j]) + unpack4(ya[q][j]) + unpack4(yb[q][j]); ss += (v[j].x * v[j].x + v[j].y * v[j].y) + (v[j].z * v[j].z + v[j].w * v[j].w); }
            const float rs = rsqrtf(wave_sum(ss) * (1.f / DM) + NORM_EPS);
#pragma unroll
            for (int j = 0; j < 4; ++j) { const f32x4 g = ((const f32x4*)gain)[lane + 64 * j];
                if (FINAL) ((f32x4*)(outf + (size_t)m * DM))[lane + 64 * j] = v[j] * rs * g;
                else { ((u32x2*)(h + (size_t)m * DM))[lane + 64 * j] = pack4(v[j]); ((u32x2*)(o + (size_t)m * DM))[lane + 64 * j] = pack4(v[j] * rs * g); } } }
    }
}
__device__ __forceinline__ void p_final(const Ctx& c, const bf16_t* h, const float* ssq, const float* gain, float* outf) {
    PHASE_IDS;
    const int NGW = c.G * 8;
    f32x4 g[4];
#pragma unroll
    for (int j = 0; j < 4; ++j) g[j] = ((const f32x4*)gain)[lane + 64 * j];
    for (int m0 = c.bid * 8 + c.wave; m0 < T; m0 += 4 * NGW) {
        u32x2 rh[4][4]; float rs[4];
#pragma unroll
        for (int q = 0; q < 4; ++q) { const int m = m0 + q * NGW; const u32x2* hp = (const u32x2*)(h + (size_t)m * DM) + lane; rs[q] = pg8::rstd16(ssq, m);
#pragma unroll
            for (int j = 0; j < 4; ++j) rh[q][j] = hp[64 * j]; }
#pragma unroll
        for (int q = 0; q < 4; ++q) { const int m = m0 + q * NGW;
#pragma unroll
            for (int j = 0; j < 4; ++j) __builtin_nontemporal_store(unpack4(rh[q][j]) * rs[q] * g[j], (f32x4*)(outf + (size_t)m * DM) + lane + 64 * j); }
    }
}
constexpr float STICK_EXIT = 30.f * 1.4426950408889634f;
__device__ __forceinline__ void p_stick2(const Ctx& c, const bf16_t* Q, const bf16_t* Kb, const bf16_t* Vb, bf16_t* O, unsigned* queue, LAS unsigned char* lds) {
    PHASE_IDS;
    const int r = lane & 31, hh = lane >> 5;
    LAS unsigned char* Kw = lds + c.wave * 9216; LAS unsigned char* Vt = Kw + 4608;
    f16x8 Lf[2];
#pragma unroll
    for (int s = 0; s < 2; ++s)
#pragma unroll
        for (int j = 0; j < 8; ++j) Lf[s][j] = (16 * s + 8 * (j >> 2) + 4 * hh + (j & 3) >= r) ? (_Float16)1.0f : (_Float16)0.0f;
    constexpr int NUNIT = BATCH * NH * (SEQ / 32), QLEN = NUNIT / 8, QBATCH = 4;
    int qi = c.bid & 7, qtries = 0, ubase = 0, uleft = 0;
    for (;;) {
        if (uleft == 0) {
            unsigned got = 0u; bool ok = false;
            while (qtries < 8) {
                if (lane == 0) got = __hip_atomic_fetch_add(queue + 64 * qi, (unsigned)QBATCH, RLX_AGENT);
                got = (unsigned)__builtin_amdgcn_readfirstlane((int)got);
                if (got < (unsigned)QLEN) { ok = true; break; }
                qi = (qi + 1) & 7; ++qtries;
            }
            if (!ok) break;
            ubase = qi * QLEN + (int)got; uleft = QBATCH;
        }
        const int u = ubase; ++ubase; --uleft;
        const int qb = u % (SEQ / 32), h = (u / (SEQ / 32)) % NH, b = u / ((SEQ / 32) * NH);
        const size_t rowbase = (size_t)b * SEQ; const int q0 = qb * 32;
        bf16x8 qf[4];
#pragma unroll
        for (int s = 0; s < 4; ++s) qf[s] = *(const bf16x8*)(Q + (rowbase + q0 + r) * DM + h * HD + 16 * s + 8 * hh);
        float carry = 0.f; f32x16 o0, o1;
#pragma unroll
        for (int i = 0; i < 16; ++i) { o0[i] = 0.f; o1[i] = 0.f; }
        u32x4 nk[4], nv[4];
#define STICK_LOAD(jt_) do { _Pragma("unroll") for (int i_ = 0; i_ < 4; ++i_) { const int chunk_ = lane + 64 * i_; const size_t g_ = (rowbase + (jt_) * 32 + (chunk_ >> 3)) * DM + h * HD + (chunk_ & 7) * 8; \
            nk[i_] = *(const u32x4*)(Kb + g_); nv[i_] = *(const u32x4*)(Vb + g_); } } while (0)
        STICK_LOAD(qb);
        for (int jt = qb; jt >= 0; --jt) {
#pragma unroll
            for (int i = 0; i < 4; ++i) { const int chunk = lane + 64 * i, row = chunk >> 3, cc = chunk & 7;
                const u32x4 kv = nk[i], vv = nv[i];
                *(LAS u32x4*)(Kw + row * 144 + cc * 16) = kv;
                const unsigned px = (unsigned)__builtin_amdgcn_update_dpp(0, (int)vv.x, 0x128, 0xF, 0xF, true), py = (unsigned)__builtin_amdgcn_update_dpp(0, (int)vv.y, 0x128, 0xF, 0xF, true);
                const unsigned pz = (unsigned)__builtin_amdgcn_update_dpp(0, (int)vv.z, 0x128, 0xF, 0xF, true), pw = (unsigned)__builtin_amdgcn_update_dpp(0, (int)vv.w, 0x128, 0xF, 0xF, true);
                const bool odd = (row & 1) != 0; const unsigned a0 = odd ? pz : vv.x, a1 = odd ? pw : vv.y, b0 = odd ? vv.z : px, b1 = odd ? vv.w : py;
                LAS unsigned* vt = (LAS unsigned*)(Vt + (cc * 8 + (odd ? 4 : 0)) * 72 + (row & ~1) * 2);
                vt[0 * 18] = (a0 & 0xffffu) | (b0 << 16); vt[1 * 18] = (a0 >> 16) | (b0 & 0xffff0000u); vt[2 * 18] = (a1 & 0xffffu) | (b1 << 16); vt[3 * 18] = (a1 >> 16) | (b1 & 0xffff0000u); }
            if (jt > 0) STICK_LOAD(jt - 1);
            f32x16 p;
#pragma unroll
            for (int i = 0; i < 16; ++i) p[i] = 0.f;
#pragma unroll
            for (int s = 0; s < 4; ++s) { const bf16x8 kf = *(const LAS bf16x8*)(Kw + r * 144 + s * 32 + hh * 16); p = __builtin_amdgcn_mfma_f32_32x32x16_bf16(kf, qf[s], p, 0, 0, 0); }
            const bool diag = (jt == qb);
            float sp[16]; f32x16 cum;
#pragma unroll
            for (int i = 0; i < 16; ++i) { const int kr = (i & 3) + 8 * (i >> 2) + 4 * hh; const bool valid = !diag || (kr < r); const float z = p[i];
                sp[i] = valid ? (fmaxf(z, 0.f) + __builtin_amdgcn_logf(1.f + __builtin_amdgcn_exp2f(-fabsf(z)))) : 0.f; cum[i] = carry; }
#pragma unroll
            for (int s = 0; s < 2; ++s) { u32x4 w; w.x = cvt2h(sp[8 * s], sp[8 * s + 1]); w.y = cvt2h(sp[8 * s + 2], sp[8 * s + 3]); w.z = cvt2h(sp[8 * s + 4], sp[8 * s + 5]); w.w = cvt2h(sp[8 * s + 6], sp[8 * s + 7]);
                cum = __builtin_amdgcn_mfma_f32_32x32x16_f16(Lf[s], __builtin_bit_cast(f16x8, w), cum, 0, 0, 0); }
            float att[16];
#pragma unroll
            for (int i = 0; i < 16; ++i) { const int kr = (i & 3) + 8 * (i >> 2) + 4 * hh; const bool valid = !diag || (kr < r); att[i] = valid ? __builtin_amdgcn_exp2f(p[i] - cum[i]) : 0.f; }
            { const unsigned cu_ = __float_as_uint(cum[0]); carry = __uint_as_float(__builtin_amdgcn_permlane32_swap(cu_, cu_, false, false)[0]); }
#pragma unroll
            for (int s = 0; s < 2; ++s) { u32x4 w; w.x = cvt2bf(att[8 * s], att[8 * s + 1]); w.y = cvt2bf(att[8 * s + 2], att[8 * s + 3]); w.z = cvt2bf(att[8 * s + 4], att[8 * s + 5]); w.w = cvt2bf(att[8 * s + 6], att[8 * s + 7]);
                const bf16x8 af = __builtin_bit_cast(bf16x8, w);
                { const u32x2 lo = *(const LAS u32x2*)(Vt + r * 72 + (16 * s + 4 * hh) * 2), hi = *(const LAS u32x2*)(Vt + r * 72 + (16 * s + 8 + 4 * hh) * 2);
                  u32x4 v; v.x = lo.x; v.y = lo.y; v.z = hi.x; v.w = hi.y; o0 = __builtin_amdgcn_mfma_f32_32x32x16_bf16(__builtin_bit_cast(bf16x8, v), af, o0, 0, 0, 0); }
                { const u32x2 lo = *(const LAS u32x2*)(Vt + (32 + r) * 72 + (16 * s + 4 * hh) * 2), hi = *(const LAS u32x2*)(Vt + (32 + r) * 72 + (16 * s + 8 + 4 * hh) * 2);
                  u32x4 v; v.x = lo.x; v.y = lo.y; v.z = hi.x; v.w = hi.y; o1 = __builtin_amdgcn_mfma_f32_32x32x16_bf16(__builtin_bit_cast(bf16x8, v), af, o1, 0, 0, 0); } }
            if (__all(carry > STICK_EXIT)) break;
        }
#undef STICK_LOAD
        bf16_t* orow = O + (rowbase + q0 + r) * DM + h * HD + 4 * hh;
#pragma unroll
        for (int g = 0; g < 4; g += 2) { u32x2 w0, w1, x0, x1;
            w0.x = cvt2bf(o0[4 * g], o0[4 * g + 1]); w0.y = cvt2bf(o0[4 * g + 2], o0[4 * g + 3]); w1.x = cvt2bf(o0[4 * g + 4], o0[4 * g + 5]); w1.y = cvt2bf(o0[4 * g + 6], o0[4 * g + 7]);
            x0.x = cvt2bf(o1[4 * g], o1[4 * g + 1]); x0.y = cvt2bf(o1[4 * g + 2], o1[4 * g + 3]); x1.x = cvt2bf(o1[4 * g + 4], o1[4 * g + 5]); x1.y = cvt2bf(o1[4 * g + 6], o1[4 * g + 7]);
            store_pair16(orow + 8 * g, hh, w0, w1); store_pair16(orow + 32 + 8 * g, hh, x0, x1); }
    }
}

struct OrderPre {
    int G, c; bool vo;
    __device__ __forceinline__ bool next(int i, pg8::Unit& u) const {
        const int cv = (G % 8 == 0) ? (c % 8) * (G / 8) + c / 8 : c;
        const int L = i * G + cv; if (L >= BATCH * 16) return false;
        const int b = L / 16, s1 = (L / 4) % 4, s0 = L % 4;
        const long om = ((long)b * NMEM * DM + (vo ? s0 : s1) * XD) * 2, ow = ((long)(vo ? s1 : s0) * 256 * DM + (vo ? s0 : s1) * XD) * 2;
        u.pm = b * 4 + s1; u.pn = s0; u.offA = vo ? ow : om; u.offB = vo ? om : ow; return true;
    }
};
struct OrderXS {
    int G, c;
    __device__ __forceinline__ bool next(int i, pg8::Unit& u) const {
        const int cv = (G % 8 == 0) ? (c % 8) * (G / 8) + c / 8 : c;
        const int L = i * G + cv; if (L >= BATCH * 4 * (SEQ / 256)) return false;
        const int b = L / 32, hh = (L / 8) % 4, it = L % 8;
        u.pm = b * 8 + it; u.pn = hh; u.offA = (long)u.pm * 256 * DM * 2; u.offB = ((long)b * DM + hh * 256) * DM * 2; return true;
    }
};

constexpr int NPHASE = 2 + 7 * NGRP + 7 + 3 + 8;
#define AR(i) ((bf16_t*)(ws + WS_ARENA + (size_t)(i) * BUF))
#define HB(i) ((bf16_t*)(ws + WS_ARENA + (size_t)(i) * HBUF))
#define SSQ(i) ((float*)(ws + WS_SSQ) + (size_t)(i) * T * 16)
#define HBR ((bf16_t*)(ws + WS_HB))
#define PH_BEGIN if (lo <= ph && ph < hi) {
#define PH_END   if (!MK_MULTI && ph + 1 < hi) xcd_barrier(bar); } ++ph;

template <int L> __device__ __forceinline__ void xa_fold(const Ctx& c, unsigned char* ws, LAS unsigned char* lds) {
    using namespace pg8;
    bf16_t* KQ = AR(2); bf16_t* VO = AR(2) + (size_t)BATCH * DM * DM;
    { Gemm gm{(const bf16_t*)(ws + WS_MEMK), (const bf16_t*)(ws + WS_XAWQ) + (size_t)L * DM * DM, DM, DM, XD}; OrderPre S{c.G, c.bid, false}; EpiBf16 E{KQ, DM, 0, 0, 1.f, nullptr}; gemm_phase<EpiBf16, OrderPre, true>(lds, c.wave, gm, S, E); }
    { Gemm gm{(const bf16_t*)(ws + WS_XAWO) + (size_t)L * DM * DM, (const bf16_t*)(ws + WS_MEMVT), DM, DM, XD}; OrderPre S{c.G, c.bid, true}; EpiBf16 E{VO, DM, 0, 0, 1.f, nullptr}; gemm_phase<EpiBf16, OrderPre, true>(lds, c.wave, gm, S, E); }
}
template <int GI> __device__ __forceinline__ void rwkv_group(const Ctx& c, const InL& in, unsigned char* ws, float* hres, LAS unsigned char* lds, const XcdBarrier& bar, int lo, int hi, int& ph) {
    using namespace pg8;
    bf16_t* pq = HB(7); bf16_t* act = HB(7) + (size_t)TG * 512;
    PH_BEGIN p_norm_shift(c, in, GI, HB(0), HB(1), HB(2), HB(3)); PH_END
    PH_BEGIN
    { Gemm gm{HB(1), (const bf16_t*)(ws + WS_WR), DM, DM, DM}; OrderRKV S; S.init(TG, 3 * DM, DM, DM, c.G, c.bid); S.aStep = (long)HBUF;
      EpiBf16 E{HB(4), DM, DM, HBUF / 2, 1.f, nullptr}; gemm_phase<EpiBf16, OrderRKV, true>(lds, c.wave, gm, S, E); }
    { Gemm gm{HB(0), (const bf16_t*)(ws + WS_WPQ), DM, DM, DM}; OrderMN S; S.init(TG, 512, DM, DM, c.G, c.bid); EpiBf16 E{pq, 512, 0, 0, 1.f, nullptr}; gemm_phase<EpiBf16, OrderMN, true>(lds, c.wave, gm, S, E); }
    PH_END
    PH_BEGIN p_lora_act(c, pq, act); PH_END
    PH_BEGIN
    { Gemm gm{act, (const bf16_t*)(ws + WS_WL2), 256, 256, 128}; OrderLora2 S; S.init(TG, 3072, 256, 256, c.G, c.bid); EpiLora E{HB(0), (size_t)TG * DM, IN(rw_w0), IN(rw_a0)}; gemm_phase<EpiLora, OrderLora2, true>(lds, c.wave, gm, S, E); }
    PH_END
    PH_BEGIN p_scan_s1(c, in, HB(4), HB(5), HB(6), HB(0), HB(1), HB(7), HB(8), HB(9), HB(10), (float*)(ws + WS_BONUS), lds);
    PH_END
    PH_BEGIN p_scan_s2(c, in, HB(7), HB(8), HB(9), HB(10), (const float*)(ws + WS_BONUS), HB(6), HB(2), HB(3), lds); PH_END
    PH_BEGIN
    { Gemm gm{HB(3), (const bf16_t*)(ws + WS_WO0), DM, DM, DM}; OrderMN S; S.init(TG, DM, DM, DM, c.G, c.bid);
      EpiResB E{IN(x) + (size_t)GI * TG * DM, HBR + (size_t)GI * TG * DM, DM, SSQ(0) + (size_t)GI * TG * 16}; gemm_phase<EpiResB, OrderMN, true>(lds, c.wave, gm, S, E); }
    if (GI == NGRP - 1) xa_fold<0>(c, ws, lds);
    PH_END
}
template <int L> __device__ __forceinline__ void layer_tail(const Ctx& c, const InL& in, unsigned char* ws, float* outp, LAS unsigned char* lds, const XcdBarrier& bar, int lo, int hi, int& ph) {
    using namespace pg8;
    unsigned* ctl = (unsigned*)(ws + WS_CTL);
    bf16_t* KQ = AR(2); bf16_t* VO = AR(2) + (size_t)BATCH * DM * DM;
    PH_BEGIN
    { Gemm gm{HBR, KQ, DM, DM, DM}; OrderXS S{c.G, c.bid}; EpiSoftmax E{AR(0), DM, 0.0625f, (LAS float*)(lds + LDS_SM), SSQ(0)}; gemm_phase<EpiSoftmax, OrderXS, true>(lds, c.wave, gm, S, E); }
    PH_END
    PH_BEGIN
    { Gemm gm{AR(0), VO, DM, DM, DM}; OrderXS S{c.G, c.bid}; EpiResB E{nullptr, HBR, DM, SSQ(1)}; gemm_phase<EpiResB, OrderXS, true>(lds, c.wave, gm, S, E); }
    PH_END
    bf16_t* xs = AR(1); bf16_t* hid = (bf16_t*)(ws + WS_ARENA + BUF + (size_t)MAXSLOT * DM * 2);
    unsigned* gcnt = ctl + CW_CNT + 128 * L;
    float* logit = (float*)(ws + WS_LOGIT); int* tok_e = (int*)(ws + WS_TOKE); int* tok_p = (int*)(ws + WS_TOKP); float* tok_w = (float*)(ws + WS_TOKW); int* tok_s = (int*)(ws + WS_TOKS); float* gate = (float*)(ws + WS_GATE);
    PH_BEGIN
    { Gemm gm{HBR, (const bf16_t*)(ws + WS_ROUTE) + (size_t)L * 256 * DM, DM, DM, DM}; OrderMN S; S.init(T, 256, DM, DM, c.G, c.bid); EpiRoute E{logit, SSQ(1)}; gemm_phase<EpiRoute, OrderMN, true>(lds, c.wave, gm, S, E);
      __builtin_amdgcn_fence(__ATOMIC_ACQUIRE, "agent");
      p_select(c, S, logit, IN(moe_bg) + L * NG, IN(moe_be) + L * NE, gcnt, tok_e, tok_p, tok_w, (int*)(ws + WS_ROWTAB), lds); }
    PH_END
    PH_BEGIN moe_table(c, gcnt, lds); p_gather(c, SSQ(1), tok_e, tok_p, tok_w, tok_s, gate, (int*)(ws + WS_ROWTAB), lds); PH_END
    PH_BEGIN
    { moe_table(c, gcnt, lds); const LAS int* toff = (const LAS int*)(lds + LDS_TOFF);
      Gemm gm{HBR, (const bf16_t*)(ws + WS_W13) + (size_t)L * NE * 512 * DM, DM, DM, DM}; OrderMoE S{toff, c.G, c.bid, 2, (long)256 * DM * 2, (long)512 * DM * 2, (long)256 * DM * 2, 0, __builtin_amdgcn_readfirstlane(toff[NB])};
      EpiSwiGLU E{hid, gate}; gemm_phase_g<EpiSwiGLU, OrderMoE, true>(lds, c.wave, gm, S, E, (const int*)(ws + WS_ROWTAB), (LAS unsigned*)(lds + LDS_GTAB)); }
    PH_END
    PH_BEGIN
    { moe_table(c, gcnt, lds); const LAS int* toff = (const LAS int*)(lds + LDS_TOFF);
      Gemm gm{hid, (const bf16_t*)(ws + WS_W2) + (size_t)L * NE * DM * DF, DF, DF, DF}; OrderMoE S{toff, c.G, c.bid, 4, (long)256 * DF * 2, (long)DM * DF * 2, (long)256 * DF * 2, 0, __builtin_amdgcn_readfirstlane(toff[NE])};
      EpiScatter E{HBR, (const int*)(ws + WS_ROWTAB) + STAB_OFF, nullptr, (LAS int*)(lds + LDS_GTAB)}; gemm_phase<EpiScatter, OrderMoE, true>(lds, c.wave, gm, S, E); }
    PH_END
    PH_BEGIN
    { moe_table(c, gcnt, lds); const LAS int* toff = (const LAS int*)(lds + LDS_TOFF);
      Gemm gm{hid, (const bf16_t*)(ws + WS_W2) + (size_t)L * NE * DM * DF, DF, DF, DF}; OrderMoE S{toff, c.G, c.bid, 4, (long)256 * DF * 2, (long)DM * DF * 2, (long)256 * DF * 2, __builtin_amdgcn_readfirstlane(toff[NE]), __builtin_amdgcn_readfirstlane(toff[NB])};
      EpiScatter E{HBR, (const int*)(ws + WS_ROWTAB) + STAB_OFF, SSQ(0), (LAS int*)(lds + LDS_GTAB)}; gemm_phase<EpiScatter, OrderMoE, true>(lds, c.wave, gm, S, E); }
    PH_END
    if (L == 1) { PH_BEGIN p_final(c, HBR, SSQ(0), IN(norm_final), outp); PH_END }
}

__global__ void __launch_bounds__(512, 2) fwd_kernel(Args args) {
    extern __shared__ __attribute__((aligned(16))) unsigned char lds_raw[];
    LAS unsigned char* lds = (LAS unsigned char*)lds_raw;
    Ctx c; c.wave = __builtin_amdgcn_readfirstlane((int)(threadIdx.x >> 6)); c.bid = blockIdx.x; c.G = gridDim.x; c.gw = c.bid * 8 + c.wave; c.NGW = c.G * 8;
    unsigned char* ws = args.ws; float* hres = args.out;
    unsigned* ctl = (unsigned*)(ws + WS_CTL);
    { const int t0 = c.wave * 64 + lane_id();
      for (int u = t0; u < (LDS_BYTES - LDSCTL_OFF) / 4; u += 512) ((LAS unsigned*)(lds + LDSCTL_OFF))[u] = 0u;
      __syncthreads();
      if (t0 < 37) ((LAS unsigned long long*)(lds + LDS_INP))[t0] = ((const unsigned long long*)__builtin_amdgcn_kernarg_segment_ptr())[t0];
      __syncthreads(); }
    InL in; in.p = (const LAS unsigned long long*)(lds + LDS_INP);
    XcdBarrier bar; bar.bar = ctl + CW_BAR; bar.x = 0; bar.st = nullptr;
    if (!MK_MULTI) bar = xcd_barrier_post(ctl + CW_BAR, (volatile LAS unsigned*)(lds + LDS_XB));
    const int lo = args.ph_lo, hi = args.ph_hi; int ph = 0;
    using namespace pg8;
    PH_BEGIN
    p_prologue(c, in, ws, lds);
    PH_END
    PH_BEGIN
    { Gemm g{(const bf16_t*)(ws + WS_MEMN), (const bf16_t*)(ws + WS_XAWKV), DM, DM, DM}; OrderMN S; S.init(BATCH * NMEM, 2 * DM, DM, DM, c.G, c.bid);
      EpiBf16 E{(bf16_t*)(ws + WS_MEMK), DM, DM, (WS_MEMVT - WS_MEMK) / 2, 1.f, nullptr}; gemm_phase<EpiBf16, OrderMN, true>(lds, c.wave, g, S, E); }
    PH_END
    rwkv_group<0>(c, in, ws, hres, lds, bar, lo, hi, ph);
    rwkv_group<1>(c, in, ws, hres, lds, bar, lo, hi, ph);
    layer_tail<0>(c, in, ws, hres, lds, bar, lo, hi, ph);
    PH_BEGIN
    { Gemm gm{HBR, (const bf16_t*)(ws + WS_SBQKV), DM, DM, DM}; OrderMN S; S.init(T, 3 * DM, DM, DM, c.G, c.bid); EpiBf16 E{AR(1), DM, DM, (size_t)T * DM, 0.125f * 1.4426950408889634f, SSQ(0)}; gemm_phase<EpiBf16, OrderMN, true>(lds, c.wave, gm, S, E); }
    PH_END
    PH_BEGIN
    p_stick2(c, AR(1), AR(2), AR(3), AR(0), (unsigned*)(ws + WS_CTL) + CW_STQ, lds);
    PH_END
    PH_BEGIN
    { Gemm gm{AR(0), (const bf16_t*)(ws + WS_SBWO), DM, DM, DM}; OrderMN S; S.init(T, DM, DM, DM, c.G, c.bid); EpiResB E{nullptr, HBR, DM, SSQ(0)}; gemm_phase<EpiResB, OrderMN, true>(lds, c.wave, gm, S, E); }
    xa_fold<1>(c, ws, lds);
    PH_END
    layer_tail<1>(c, in, ws, hres, lds, bar, lo, hi, ph);
}
#undef PH_BEGIN
#undef PH_END

extern "C" void kernel_launch(void* const* d_in, const int* in_sizes, int n_in, void* d_out, int out_size, void* d_ws, size_t ws_size, hipStream_t stream) {
    static int grid = 0;
    if (grid == 0) {
        if (n_in != 37 || out_size != T * DM || ws_size < WS_END) { fprintf(stderr, "kernel_launch: unexpected shapes (n_in %d, out %d, ws %zu < %zu)\n", n_in, out_size, ws_size, (size_t)WS_END); grid = -1; return; }
        int dev = 0, cus = 0, per_cu = 0;
        if (hipGetDevice(&dev) != hipSuccess || hipDeviceGetAttribute(&cus, hipDeviceAttributeMultiprocessorCount, dev) != hipSuccess) { grid = -1; return; }
        if (hipFuncSetAttribute((const void*)fwd_kernel, hipFuncAttributeMaxDynamicSharedMemorySize, LDS_BYTES) != hipSuccess) { fprintf(stderr, "kernel_launch: hipFuncSetAttribute failed\n"); grid = -1; return; }
        if (hipOccupancyMaxActiveBlocksPerMultiprocessor(&per_cu, (const void*)fwd_kernel, 512, LDS_BYTES) != hipSuccess || per_cu < 1) fprintf(stderr, "kernel_launch: occupancy query reports %d\n", per_cu);
        (void)hipGetLastError();
        grid = 1; while (grid * 2 <= cus && grid * 2 <= 256) grid *= 2;
    }
    if (grid < 0) return;
    if (hipMemsetAsync((char*)d_ws + WS_CTL, 0, CTL_ZERO_BYTES, stream) != hipSuccess) return;
    Args a{};
    const float** ip = (const float**)&a.in;
    for (int i = 0; i < 37; ++i) ip[i] = (const float*)d_in[i];
    a.out = (float*)d_out; a.ws = (unsigned char*)d_ws;
#if MK_MULTI
    for (int p = 0; p < NPHASE; ++p) { a.ph_lo = p; a.ph_hi = p + 1; hipLaunchKernelGGL(fwd_kernel, dim3(grid), dim3(512), LDS_BYTES, stream, a); }
#else
    a.ph_lo = 0; a.ph_hi = NPHASE; hipLaunchKernelGGL(fwd_kernel, dim3(grid), dim3(512), LDS_BYTES, stream, a);
#endif
}
```

```cpp
#include <hip/hip_runtime.h>
#include <cstdio>
#include <cstdint>
#include <cstddef>

#ifndef MK_MULTI
#define MK_MULTI 0
#endif

#define GAS __attribute__((address_space(1)))
#define LAS __attribute__((address_space(3)))
typedef unsigned short bf16_t;
typedef short bf16x8 __attribute__((ext_vector_type(8)));
typedef float f32x4 __attribute__((ext_vector_type(4)));
typedef float f32x2 __attribute__((ext_vector_type(2)));
typedef unsigned u32x4 __attribute__((ext_vector_type(4)));
typedef unsigned u32x2 __attribute__((ext_vector_type(2)));

constexpr int BATCH = 32, SEQ = 2048, DM = 1024, T = BATCH * SEQ;
constexpr int NH = 16, HD = 64;
constexpr int NMEM = 256, XH = 4, XD = 256;
constexpr int NG = 4, NEG = 8, NE = 32, DF = 256;
constexpr int NGRP = 2;
constexpr int TG = T / NGRP, BG = BATCH / NGRP;
constexpr float NORM_EPS = 1e-6f, GN_EPS = 64e-5f;
constexpr int STAB_OFF = 256 * 1024;
constexpr int NB = 2 * NE;
constexpr int MAXSLOT = 2 * T + NB * 256;

namespace pg8 {
constexpr int BM = 256, BK = 64, HALF = 128, HTB = HALF * BK * 2, STAGE_BYTES = 8 * HTB, NXCD = 8, WGM = 8;
__host__ __device__ __forceinline__ int lds_byte(int r, int c) { const int st = (r >> 4) * 2 + (c >> 5), rr = r & 15, cc = c & 31, ob = rr * 64 + cc * 2; return st * 1024 + (ob ^ (((ob >> 9) & 1) << 5)); }
__host__ __device__ __forceinline__ void stage_rc(int b, int& R, int& C) { const int st = b / 1024, sb = b % 1024, swz = sb ^ (((sb >> 9) & 1) << 5); R = (st >> 1) * 16 + swz / 64; C = (st & 1) * 32 + (swz % 64) / 2; }
__host__ __device__ __forceinline__ int perm32(int rho) { const int n = rho >> 4, i = rho & 15; return 8 * (i >> 2) + 4 * n + (i & 3); }

struct Unit { int pm, pn; long offA, offB; };
struct Gemm { const bf16_t* A; const bf16_t* Bt; int lda, ldb, K; };

__device__ __forceinline__ unsigned cvt_pk_bf16(float lo, float hi) { unsigned r; asm volatile("v_cvt_pk_bf16_f32 %0, %1, %2" : "=v"(r) : "v"(lo), "v"(hi)); return r; }

struct OrderMN {
    int nM, nN, nwg, G, c; long sA, sB;
    __device__ void init(int M, int N, int lda, int ldb, int G_, int c_) { nM = M / BM; nN = N / BM; nwg = nM * nN; G = G_; c = c_; sA = (long)BM * lda * 2; sB = (long)BM * ldb * 2; }
    __device__ __forceinline__ bool next(int i, Unit& u) const {
        const long L = (long)i * G + c; if (L >= nwg) return false;
        int wgid = (int)L; { const int q = nwg / NXCD, r = nwg % NXCD, xcd = wgid % NXCD, off = wgid / NXCD; wgid = (xcd < r ? xcd * (q + 1) : r * (q + 1) + (xcd - r) * q) + off; }
        const int nig = WGM * nN, gid = wgid / nig, fm = gid * WGM, gsz = (nM - fm) < WGM ? (nM - fm) : WGM;
        u.pm = fm + ((wgid % nig) % gsz); u.pn = (wgid % nig) / gsz; u.offA = u.pm * sA; u.offB = u.pn * sB; return true;
    }
};

struct OrderLora2 : OrderMN {
    __device__ __forceinline__ bool next(int i, Unit& u) const { if (!OrderMN::next(i, u)) return false; if (u.pn >= 8) { u.offA += 256; u.offB += 256; } return true; }
};
struct OrderRKV : OrderMN {
    long aStep;
    __device__ __forceinline__ bool next(int i, Unit& u) const { if (!OrderMN::next(i, u)) return false; u.offA += (long)(u.pn >> 2) * aStep; return true; }
};
__device__ __forceinline__ float xadd16(float x) { const unsigned u = __float_as_uint(x); const auto r = __builtin_amdgcn_permlane16_swap(u, u, false, false); return __uint_as_float(r[0]) + __uint_as_float(r[1]); }
__device__ __forceinline__ float xadd32(float x) { const unsigned u = __float_as_uint(x); const auto r = __builtin_amdgcn_permlane32_swap(u, u, false, false); return __uint_as_float(r[0]) + __uint_as_float(r[1]); }
__device__ __forceinline__ float xmax16(float x) { const unsigned u = __float_as_uint(x); const auto r = __builtin_amdgcn_permlane16_swap(u, u, false, false); return fmaxf(__uint_as_float(r[0]), __uint_as_float(r[1])); }
__device__ __forceinline__ float xmax32(float x) { const unsigned u = __float_as_uint(x); const auto r = __builtin_amdgcn_permlane32_swap(u, u, false, false); return fmaxf(__uint_as_float(r[0]), __uint_as_float(r[1])); }
__device__ __forceinline__ float rstd16(const float* ssq, int row) { const f32x4* p = (const f32x4*)(ssq + (size_t)row * 16); const f32x4 a = p[0], b = p[1], c = p[2], d = p[3];
    const f32x4 s = (a + b) + (c + d); return rsqrtf(((s[0] + s[1]) + (s[2] + s[3])) * (1.f / 1024.f) + 1e-6f); }
__device__ __forceinline__ f32x4 rstd16q_ld(const float* ssq, int row, int fq) { return *(const f32x4*)(ssq + (size_t)row * 16 + 4 * fq); }
__device__ __forceinline__ float rstd16q_fin(f32x4 a) { return rsqrtf(xadd32(xadd16((a[0] + a[1]) + (a[2] + a[3]))) * (1.f / 1024.f) + 1e-6f); }
struct EpiBf16 {
    static constexpr bool PERM = true;
    static constexpr bool HAS_PRE = false;
    bf16_t* O; int ldc; int split_cols; size_t split_stride; float scale0; const float* ssq;
    __device__ __forceinline__ void operator()(const f32x4 (&acc)[2][2][4][2], const Unit& u, int wr, int wc, int fr, int fq) const {
        const int row0 = u.pm * BM + wr * 64 + fr; int colt = u.pn * BM; bf16_t* base = O;
        float sc0 = scale0; if (split_cols) { const int t = colt / split_cols; base += (size_t)t * split_stride; colt -= t * split_cols; if (t != 0) sc0 = 1.f; }
        const int col0 = colt + wc * 32 + 8 * fq;
        f32x4 qa[2][4];
        if (ssq) {
#pragma unroll
            for (int ai = 0; ai < 2; ++ai)
#pragma unroll
                for (int m = 0; m < 4; ++m) qa[ai][m] = rstd16q_ld(ssq, row0 + ai * HALF + m * 16, fq);
            asm volatile("" ::: "memory"); }
#pragma unroll
        for (int ai = 0; ai < 2; ++ai)
#pragma unroll
            for (int m = 0; m < 4; ++m) { const int row = row0 + ai * HALF + m * 16; bf16_t* rowp = base + (size_t)row * ldc + col0;
                const float sc = ssq ? sc0 * rstd16q_fin(qa[ai][m]) : sc0;
#pragma unroll
                for (int bj = 0; bj < 2; ++bj) { const f32x4 v0 = acc[ai][bj][m][0] * sc, v1 = acc[ai][bj][m][1] * sc;
                    u32x4 w; w.x = cvt_pk_bf16(v0[0], v0[1]); w.y = cvt_pk_bf16(v0[2], v0[3]); w.z = cvt_pk_bf16(v1[0], v1[1]); w.w = cvt_pk_bf16(v1[2], v1[3]);
                    *(u32x4*)(rowp + bj * HALF) = w; } }
    }
};
__device__ __forceinline__ float sigmoidf_(float x) { return __builtin_amdgcn_rcpf(1.f + __expf(-x)); }
struct EpiSoftmax {
    static constexpr bool PERM = true;
    static constexpr bool HAS_PRE = false;
    bf16_t* O; int ldc; float scale; LAS float* sm; const float* ssq;
    __device__ __forceinline__ void operator()(f32x4 (&acc)[2][2][4][2], const Unit& u, int wr, int wc, int fr, int fq) const {
        const int rl0 = wr * 64 + fr;
        f32x4 qa[2][4];
        if (ssq) {
#pragma unroll
            for (int ai = 0; ai < 2; ++ai)
#pragma unroll
                for (int m = 0; m < 4; ++m) qa[ai][m] = rstd16q_ld(ssq, u.pm * BM + rl0 + ai * HALF + m * 16, fq);
            asm volatile("" ::: "memory"); }
        float mw[2][4];
#pragma unroll
        for (int ai = 0; ai < 2; ++ai)
#pragma unroll
            for (int m = 0; m < 4; ++m) { float mx = -3.0e38f; const float sc = ssq ? scale * rstd16q_fin(qa[ai][m]) : scale;
#pragma unroll
                for (int bj = 0; bj < 2; ++bj)
#pragma unroll
                    for (int n = 0; n < 2; ++n) { acc[ai][bj][m][n] = acc[ai][bj][m][n] * sc; const f32x4 v = acc[ai][bj][m][n]; mx = fmaxf(mx, fmaxf(fmaxf(v[0], v[1]), fmaxf(v[2], v[3]))); }
                mx = xmax32(xmax16(mx)); mw[ai][m] = mx; float sum = 0.f;
#pragma unroll
                for (int bj = 0; bj < 2; ++bj)
#pragma unroll
                    for (int n = 0; n < 2; ++n) { f32x4 v = acc[ai][bj][m][n]; v[0] = __expf(v[0] - mx); v[1] = __expf(v[1] - mx); v[2] = __expf(v[2] - mx); v[3] = __expf(v[3] - mx); acc[ai][bj][m][n] = v; sum += (v[0] + v[1]) + (v[2] + v[3]); }
                sum = xadd32(xadd16(sum));
                if (fq == 0) *(LAS f32x2*)(sm + ((rl0 + ai * HALF + m * 16) * 4 + wc) * 2) = (f32x2){mx, sum}; }
        asm volatile("s_waitcnt lgkmcnt(0)" ::: "memory"); __builtin_amdgcn_s_barrier(); asm volatile("" ::: "memory");
        const int row0 = u.pm * BM + rl0, col0 = u.pn * BM + wc * 32 + 8 * fq;
        f32x4 q0[2][4], q1[2][4];
#pragma unroll
        for (int ai = 0; ai < 2; ++ai)
#pragma unroll
            for (int m = 0; m < 4; ++m) { const int rl = rl0 + ai * HALF + m * 16; q0[ai][m] = *(const LAS f32x4*)(sm + rl * 8); q1[ai][m] = *(const LAS f32x4*)(sm + rl * 8 + 4); }
#pragma unroll
        for (int ai = 0; ai < 2; ++ai)
#pragma unroll
            for (int m = 0; m < 4; ++m) { const f32x4 a = q0[ai][m], b = q1[ai][m];
                const float M = fmaxf(fmaxf(a[0], a[2]), fmaxf(b[0], b[2]));
                const float tot = (a[1] * __expf(a[0] - M) + a[3] * __expf(a[2] - M)) + (b[1] * __expf(b[0] - M) + b[3] * __expf(b[2] - M));
                const float inv = __expf(mw[ai][m] - M) * __builtin_amdgcn_rcpf(tot);
                bf16_t* rowp = O + (size_t)(row0 + ai * HALF + m * 16) * ldc + col0;
#pragma unroll
                for (int bj = 0; bj < 2; ++bj) { const f32x4 v0 = acc[ai][bj][m][0] * inv, v1 = acc[ai][bj][m][1] * inv;
                    u32x4 w; w.x = cvt_pk_bf16(v0[0], v0[1]); w.y = cvt_pk_bf16(v0[2], v0[3]); w.z = cvt_pk_bf16(v1[0], v1[1]); w.w = cvt_pk_bf16(v1[2], v1[3]);
                    *(u32x4*)(rowp + bj * HALF) = w; } }
    }
};
struct EpiLora {
    static constexpr bool PERM = true;
    static constexpr bool HAS_PRE = false;
    bf16_t* O; size_t stride; const float* w0; const float* a0;
    __device__ __forceinline__ void operator()(const f32x4 (&acc)[2][2][4][2], const Unit& u, int wr, int wc, int fr, int fq) const {
        const int row0 = u.pm * BM + wr * 64 + fr; int colt = u.pn * BM; const int t = colt / 1024; colt -= t * 1024; bf16_t* base = O + (size_t)t * stride;
        const int col0 = colt + wc * 32 + 8 * fq; const float* bias = (t == 0) ? w0 : a0;
        f32x4 bv[2][2];
#pragma unroll
        for (int bj = 0; bj < 2; ++bj)
#pragma unroll
            for (int n = 0; n < 2; ++n) bv[bj][n] = (t < 2) ? *(const f32x4*)(bias + col0 + bj * HALF + 4 * n) : (f32x4){0.f, 0.f, 0.f, 0.f};
#pragma unroll
        for (int ai = 0; ai < 2; ++ai)
#pragma unroll
            for (int m = 0; m < 4; ++m) { bf16_t* rowp = base + (size_t)(row0 + ai * HALF + m * 16) * 1024 + col0;
#pragma unroll
                for (int bj = 0; bj < 2; ++bj) { f32x4 v0 = acc[ai][bj][m][0] + bv[bj][0], v1 = acc[ai][bj][m][1] + bv[bj][1];
                    if (t < 2) { const float s = (t == 0) ? -0.6065306597f : 1.f;
#pragma unroll
                        for (int e = 0; e < 4; ++e) { v0[e] = s * sigmoidf_(v0[e]); v1[e] = s * sigmoidf_(v1[e]); } }
                    u32x4 w; w.x = cvt_pk_bf16(v0[0], v0[1]); w.y = cvt_pk_bf16(v0[2], v0[3]); w.z = cvt_pk_bf16(v1[0], v1[1]); w.w = cvt_pk_bf16(v1[2], v1[3]);
                    *(u32x4*)(rowp + bj * HALF) = w; } }
    }
};
struct EpiResB {
    static constexpr bool PERM = true;
    static constexpr bool HAS_PRE = false;
    const float* basef; bf16_t* hb; int ldc; float* ssq;
    __device__ __forceinline__ void operator()(const f32x4 (&acc)[2][2][4][2], const Unit& u, int wr, int wc, int fr, int fq) const {
        const int row0 = u.pm * BM + wr * 64 + fr, col0 = u.pn * BM + wc * 32 + 8 * fq;
        if (basef) {
#pragma unroll
            for (int aim = 0; aim < 4; ++aim) { const int ai = aim >> 1, mb = (aim & 1) * 2; f32x4 bq[4][2][2];
#pragma unroll
                for (int m = mb; m < mb + 2; ++m) { const size_t off = (size_t)(row0 + ai * HALF + m * 16) * ldc + col0;
#pragma unroll
                    for (int bj = 0; bj < 2; ++bj) { bq[m][bj][0] = *(const f32x4*)(basef + off + bj * HALF); bq[m][bj][1] = *(const f32x4*)(basef + off + bj * HALF + 4); } }
                asm volatile("" ::: "memory");
#pragma unroll
                for (int m = mb; m < mb + 2; ++m) { const int row = row0 + ai * HALF + m * 16; const size_t off = (size_t)row * ldc + col0; float sq = 0.f;
#pragma unroll
                    for (int bj = 0; bj < 2; ++bj) { const f32x4 o0 = bq[m][bj][0] + acc[ai][bj][m][0], o1 = bq[m][bj][1] + acc[ai][bj][m][1];
                        u32x4 w; w.x = cvt_pk_bf16(o0[0], o0[1]); w.y = cvt_pk_bf16(o0[2], o0[3]); w.z = cvt_pk_bf16(o1[0], o1[1]); w.w = cvt_pk_bf16(o1[2], o1[3]);
                        *(u32x4*)(hb + off + bj * HALF) = w;
                        sq += ((o0[0] * o0[0] + o0[1] * o0[1]) + (o0[2] * o0[2] + o0[3] * o0[3])) + ((o1[0] * o1[0] + o1[1] * o1[1]) + (o1[2] * o1[2] + o1[3] * o1[3])); }
                    sq = xadd32(xadd16(sq)); if (fq == 0) ssq[(size_t)row * 16 + u.pn * 4 + wc] = sq; } }
        } else {
#pragma unroll
            for (int ai = 0; ai < 2; ++ai) { u32x4 bw[4][2];
#pragma unroll
                for (int m = 0; m < 4; ++m) { const size_t off = (size_t)(row0 + ai * HALF + m * 16) * ldc + col0;
#pragma unroll
                    for (int bj = 0; bj < 2; ++bj) bw[m][bj] = *(const u32x4*)(hb + off + bj * HALF); }
                asm volatile("" ::: "memory");
#pragma unroll
                for (int m = 0; m < 4; ++m) { const int row = row0 + ai * HALF + m * 16; const size_t off = (size_t)row * ldc + col0; float sq = 0.f;
#pragma unroll
                    for (int bj = 0; bj < 2; ++bj) { const u32x4 w = bw[m][bj];
                        const f32x4 b0 = (f32x4){__uint_as_float(w.x << 16), __uint_as_float(w.x & 0xffff0000u), __uint_as_float(w.y << 16), __uint_as_float(w.y & 0xffff0000u)};
                        const f32x4 b1 = (f32x4){__uint_as_float(w.z << 16), __uint_as_float(w.z & 0xffff0000u), __uint_as_float(w.w << 16), __uint_as_float(w.w & 0xffff0000u)};
                        const f32x4 o0 = b0 + acc[ai][bj][m][0], o1 = b1 + acc[ai][bj][m][1];
                        u32x4 wo; wo.x = cvt_pk_bf16(o0[0], o0[1]); wo.y = cvt_pk_bf16(o0[2], o0[3]); wo.z = cvt_pk_bf16(o1[0], o1[1]); wo.w = cvt_pk_bf16(o1[2], o1[3]);
                        *(u32x4*)(hb + off + bj * HALF) = wo;
                        sq += ((o0[0] * o0[0] + o0[1] * o0[1]) + (o0[2] * o0[2] + o0[3] * o0[3])) + ((o1[0] * o1[0] + o1[1] * o1[1]) + (o1[2] * o1[2] + o1[3] * o1[3])); }
                    sq = xadd32(xadd16(sq)); if (fq == 0) ssq[(size_t)row * 16 + u.pn * 4 + wc] = sq; } }
        }
    }
};
struct EpiScatter {
    static constexpr bool PERM = true;
    static constexpr bool HAS_PRE = true;
    bf16_t* hb; const int* stab; float* ssq; LAS int* tab;
    __device__ __forceinline__ void prefetch(const Unit& u, int wid) const {
        if (wid < 4) { int l; asm volatile("v_mbcnt_lo_u32_b32 %0, -1, 0\n\tv_mbcnt_hi_u32_b32 %0, -1, %0" : "=v"(l));
            __builtin_amdgcn_global_load_lds((const unsigned*)(stab + u.pm * BM + wid * 64 + l), (LAS unsigned*)(tab + wid * 64), 4, 0, 0); }
    }
    __device__ __forceinline__ void operator()(const f32x4 (&acc)[2][2][4][2], const Unit& u, int wr, int wc, int fr, int fq) const {
        const int col0 = u.pn * BM + wc * 32 + 8 * fq;
        int tk[2][4];
        asm volatile("ds_read_b32 %0, %8\n\tds_read_b32 %1, %8 offset:64\n\tds_read_b32 %2, %8 offset:128\n\tds_read_b32 %3, %8 offset:192\n\tds_read_b32 %4, %8 offset:512\n\tds_read_b32 %5, %8 offset:576\n\t"
                     "ds_read_b32 %6, %8 offset:640\n\tds_read_b32 %7, %8 offset:704\n\ts_waitcnt lgkmcnt(0)"
                     : "=&v"(tk[0][0]), "=&v"(tk[0][1]), "=&v"(tk[0][2]), "=&v"(tk[0][3]), "=&v"(tk[1][0]), "=&v"(tk[1][1]), "=&v"(tk[1][2]), "=&v"(tk[1][3]) : "v"((unsigned)(size_t)tab + (unsigned)(wr * 64 + fr) * 4u) : "memory");
#pragma unroll
        for (int ai = 0; ai < 2; ++ai)
#pragma unroll
            for (int m = 0; m < 4; ++m) { const int tok = tk[ai][m]; float sq = 0.f;
                if (tok >= 0) { const size_t off = (size_t)tok * DM + col0;
#pragma unroll
                    for (int bj = 0; bj < 2; ++bj) { const u32x4 w0 = *(const u32x4*)(hb + off + bj * HALF);
                        const f32x4 b0 = (f32x4){__uint_as_float(w0.x << 16), __uint_as_float(w0.x & 0xffff0000u), __uint_as_float(w0.y << 16), __uint_as_float(w0.y & 0xffff0000u)};
                        const f32x4 b1 = (f32x4){__uint_as_float(w0.z << 16), __uint_as_float(w0.z & 0xffff0000u), __uint_as_float(w0.w << 16), __uint_as_float(w0.w & 0xffff0000u)};
                        const f32x4 o0 = b0 + acc[ai][bj][m][0], o1 = b1 + acc[ai][bj][m][1];
                        u32x4 w; w.x = cvt_pk_bf16(o0[0], o0[1]); w.y = cvt_pk_bf16(o0[2], o0[3]); w.z = cvt_pk_bf16(o1[0], o1[1]); w.w = cvt_pk_bf16(o1[2], o1[3]);
                        *(u32x4*)(hb + off + bj * HALF) = w;
                        sq += ((o0[0] * o0[0] + o0[1] * o0[1]) + (o0[2] * o0[2] + o0[3] * o0[3])) + ((o1[0] * o1[0] + o1[1] * o1[1]) + (o1[2] * o1[2] + o1[3] * o1[3])); } }
                if (ssq) { sq = xadd32(xadd16(sq)); if (fq == 0 && tok >= 0) ssq[(size_t)tok * 16 + u.pn * 4 + wc] = sq; } }
    }
};
struct EpiRoute {
    static constexpr bool PERM = false;
    static constexpr bool HAS_PRE = false;
    float* out; const float* ssq;
    __device__ __forceinline__ void operator()(const f32x4 (&acc)[2][2][4][2], const Unit& u, int wr, int wc, int fr, int fq) const {
        if (wc >= 2) return;
        const int row0 = u.pm * BM + wr * 64 + fr, col0 = wc * 32 + 4 * fq;
        f32x4 qa[2][4];
#pragma unroll
        for (int ai = 0; ai < 2; ++ai)
#pragma unroll
            for (int m = 0; m < 4; ++m) qa[ai][m] = rstd16q_ld(ssq, row0 + ai * HALF + m * 16, fq);
        asm volatile("" ::: "memory");
#pragma unroll
        for (int ai = 0; ai < 2; ++ai)
#pragma unroll
            for (int m = 0; m < 4; ++m) { const int row = row0 + ai * HALF + m * 16; float* rowp = out + (size_t)row * 64 + col0; const float rs = rstd16q_fin(qa[ai][m]);
#pragma unroll
                for (int n = 0; n < 2; ++n) *(f32x4*)(rowp + n * 16) = acc[ai][0][m][n] * rs; }
    }
};
struct EpiSwiGLU {
    static constexpr bool PERM = true;
    static constexpr bool HAS_PRE = false;
    bf16_t* hid; const float* gate;
    __device__ __forceinline__ void operator()(const f32x4 (&acc)[2][2][4][2], const Unit& u, int wr, int wc, int fr, int fq) const {
        const int row0 = u.pm * BM + wr * 64 + fr, col0 = u.pn * 128 + wc * 32 + 8 * fq;
        f32x2 gq[2][4];
#pragma unroll
        for (int ai = 0; ai < 2; ++ai)
#pragma unroll
            for (int m = 0; m < 4; ++m) gq[ai][m] = *(const f32x2*)(gate + 2 * (size_t)(row0 + ai * HALF + m * 16));
        asm volatile("" ::: "memory");
#pragma unroll
        for (int ai = 0; ai < 2; ++ai)
#pragma unroll
            for (int m = 0; m < 4; ++m) { const int row = row0 + ai * HALF + m * 16; const f32x2 gr = gq[ai][m]; const float rs = gr.x, g = gr.y;
                f32x4 h0, h1;
#pragma unroll
                for (int e = 0; e < 4; ++e) { const float a0 = acc[ai][0][m][0][e] * rs, a1 = acc[ai][0][m][1][e] * rs;
                    h0[e] = a0 * sigmoidf_(a0) * acc[ai][1][m][0][e] * g; h1[e] = a1 * sigmoidf_(a1) * acc[ai][1][m][1][e] * g; }
                u32x4 w; w.x = cvt_pk_bf16(h0[0], h0[1]); w.y = cvt_pk_bf16(h0[2], h0[3]); w.z = cvt_pk_bf16(h1[0], h1[1]); w.w = cvt_pk_bf16(h1[2], h1[3]);
                *(u32x4*)(hid + (size_t)row * 256 + col0) = w; }
    }
};

template <class Epi, class Sched, bool ALIGN_EPI>
__device__ __forceinline__ void gemm_phase(LAS unsigned char* lds, const int wid, const Gemm g, const Sched& S, const Epi& E) {
    int lane; asm volatile("v_mbcnt_lo_u32_b32 %0, -1, 0\n\tv_mbcnt_hi_u32_b32 %0, -1, %0" : "=v"(lane));
    const int tid = wid * 64 + lane, wr = wid >> 2, wc = wid & 3, fr = lane & 15, fq = lane >> 4;
    const int K = g.K, nt = K / BK;
    unsigned voffA[2], voffB[2];
#pragma unroll
    for (int i = 0; i < 2; ++i) { int R, C; stage_rc(tid * 16 + i * 8192, R, C); const int Rb = Epi::PERM ? ((R & ~31) + perm32(R & 31)) : R;
        voffA[i] = (unsigned)(R * g.lda + C) * 2u; voffB[i] = (unsigned)(Rb * g.ldb + C) * 2u; }
    const size_t kstep = (size_t)(BK * 2);
    const size_t hstepA = (size_t)HALF * g.lda * 2, hstepB = (size_t)HALF * g.ldb * 2;
    const unsigned ldsw = (unsigned)wid * 1024u;
    const int aoff = lds_byte(wr * 64 + fr, fq * 8), boff = lds_byte(wc * 32 + fr, fq * 8);
#define PG8_SA(b, h) (((b) * 2 + (h)) * HTB)
#define PG8_SB(b, h) ((4 + (b) * 2 + (h)) * HTB)
#define PG8_STAGE(bufoff, gbase, voff) do { _Pragma("unroll") for (int _i = 0; _i < 2; ++_i) \
        __builtin_amdgcn_global_load_lds((const unsigned*)((const char*)(gbase) + (voff)[_i]), (LAS unsigned*)(lds + (bufoff) + ldsw + _i * 8192), 16, 0, 0); } while (0)
#define PG8_LDA(dst, b, h) do { _Pragma("unroll") for (int m = 0; m < 4; ++m) _Pragma("unroll") for (int k = 0; k < 2; ++k) dst[m][k] = *(const LAS bf16x8*)(lds + PG8_SA(b, h) + aoff + m * 2048 + k * 1024); } while (0)
#define PG8_LDB(dst, b, h) do { _Pragma("unroll") for (int n = 0; n < 2; ++n) _Pragma("unroll") for (int k = 0; k < 2; ++k) dst[n][k] = *(const LAS bf16x8*)(lds + PG8_SB(b, h) + boff + n * 2048 + k * 1024); } while (0)
#define PG8_MMA(ai, bj, At, Bt) do { __builtin_amdgcn_s_setprio(1); _Pragma("unroll") for (int m = 0; m < 4; ++m) _Pragma("unroll") for (int n = 0; n < 2; ++n) _Pragma("unroll") for (int k = 0; k < 2; ++k) \
        acc[ai][bj][m][n] = __builtin_amdgcn_mfma_f32_16x16x32_bf16(Bt[n][k], At[m][k], acc[ai][bj][m][n], 0, 0, 0); __builtin_amdgcn_s_setprio(0); } while (0)
#define PG8_WAIT_V(n) asm volatile("s_waitcnt vmcnt(" #n ")" ::: "memory")
#define PG8_WAIT_L(n) asm volatile("s_waitcnt lgkmcnt(" #n ")" ::: "memory")
#define PG8_BAR __builtin_amdgcn_s_barrier()
#define PG8_SCHED __builtin_amdgcn_sched_barrier(0)
    Unit cur, nxt; int ui = 0;
    if (!S.next(0, cur)) return;
    f32x4 acc[2][2][4][2];
#pragma unroll
    for (int a = 0; a < 2; ++a)
#pragma unroll
        for (int b = 0; b < 2; ++b)
#pragma unroll
            for (int m = 0; m < 4; ++m)
#pragma unroll
                for (int n = 0; n < 2; ++n) acc[a][b][m][n] = (f32x4){0.f, 0.f, 0.f, 0.f};
    bf16x8 At[4][2], B0[2][2], B1[2][2];
    const char* cA = (const char*)g.A + cur.offA; const char* cB = (const char*)g.Bt + cur.offB;
    PG8_STAGE(PG8_SB(0, 0), cB, voffB); PG8_STAGE(PG8_SB(0, 1), cB + hstepB, voffB); PG8_STAGE(PG8_SA(0, 0), cA, voffA); PG8_STAGE(PG8_SA(0, 1), cA + hstepA, voffA);
    if (wr == 1) PG8_BAR;
    PG8_WAIT_V(2); PG8_BAR;
    PG8_STAGE(PG8_SB(1, 0), cB + kstep, voffB); PG8_STAGE(PG8_SA(1, 0), cA + kstep, voffA); PG8_STAGE(PG8_SB(1, 1), cB + hstepB + kstep, voffB);
    PG8_WAIT_V(6); PG8_BAR;
    for (;;) {
        const bool has_next = S.next(ui + 1, nxt);
        const char* nA = has_next ? (const char*)g.A + nxt.offA : cA; const char* nB = has_next ? (const char*)g.Bt + nxt.offB : cB;
        if constexpr (Epi::HAS_PRE) E.prefetch(cur, wid);
        for (int t = 0; t < nt; t += 2) {
            const bool last = (t == nt - 2);
            const char* a1 = cA + (size_t)(t + 1) * kstep;
            const char* a2 = last ? nA : cA + (size_t)(t + 2) * kstep; const char* b2 = last ? nB : cB + (size_t)(t + 2) * kstep;
            const char* a3 = a2 + kstep; const char* b3 = b2 + kstep;
            PG8_LDB(B0, 0, 0); PG8_LDB(B1, 0, 1); PG8_SCHED; PG8_LDA(At, 0, 0); PG8_STAGE(PG8_SA(1, 1), a1 + hstepA, voffA);
            PG8_WAIT_V(8); PG8_WAIT_L(0); PG8_BAR; PG8_MMA(0, 0, At, B0); PG8_MMA(0, 1, At, B1); PG8_BAR; PG8_SCHED;
            PG8_LDA(At, 0, 1); PG8_STAGE(PG8_SB(0, 0), b2, voffB); PG8_STAGE(PG8_SB(0, 1), b2 + hstepB, voffB); PG8_STAGE(PG8_SA(0, 0), a2, voffA);
            PG8_WAIT_V(8); PG8_WAIT_L(0); PG8_BAR; PG8_MMA(1, 0, At, B0); PG8_MMA(1, 1, At, B1); PG8_BAR; PG8_SCHED;
            PG8_LDB(B0, 1, 0); PG8_LDB(B1, 1, 1); PG8_SCHED; PG8_LDA(At, 1, 0); PG8_STAGE(PG8_SA(0, 1), a2 + hstepA, voffA);
            PG8_WAIT_V(8); PG8_WAIT_L(0); PG8_BAR; PG8_MMA(0, 0, At, B0); PG8_MMA(0, 1, At, B1); PG8_BAR; PG8_SCHED;
            PG8_LDA(At, 1, 1); PG8_STAGE(PG8_SB(1, 0), b3, voffB); PG8_STAGE(PG8_SB(1, 1), b3 + hstepB, voffB); PG8_STAGE(PG8_SA(1, 0), a3, voffA);
            PG8_WAIT_V(8); PG8_WAIT_L(0); PG8_BAR; PG8_MMA(1, 0, At, B0); PG8_MMA(1, 1, At, B1); PG8_BAR; PG8_SCHED;
        }
        if constexpr (ALIGN_EPI) { if (wr == 0) PG8_BAR; }
        { int l2; asm volatile("v_mbcnt_lo_u32_b32 %0, -1, 0\n\tv_mbcnt_hi_u32_b32 %0, -1, %0" : "=v"(l2)); E(acc, cur, wr, wc, l2 & 15, l2 >> 4); }
        if (!has_next) break;
#pragma unroll
        for (int a = 0; a < 2; ++a)
#pragma unroll
            for (int b = 0; b < 2; ++b)
#pragma unroll
                for (int m = 0; m < 4; ++m)
#pragma unroll
                    for (int n = 0; n < 2; ++n) acc[a][b][m][n] = (f32x4){0.f, 0.f, 0.f, 0.f};
        cur = nxt; cA = nA; cB = nB; ++ui;
        if constexpr (ALIGN_EPI) { if (wr == 1) PG8_BAR; }
    }
    PG8_WAIT_V(0);
    if constexpr (!ALIGN_EPI) { if (wr == 0) PG8_BAR; }
    PG8_BAR;
#undef PG8_SA
#undef PG8_SB
#undef PG8_STAGE
#undef PG8_LDA
#undef PG8_LDB
#undef PG8_MMA
#undef PG8_WAIT_V
#undef PG8_WAIT_L
#undef PG8_BAR
#undef PG8_SCHED
}
template <class Epi, class Sched, bool ALIGN_EPI>
__device__ __forceinline__ void gemm_phase_g(LAS unsigned char* lds, const int wid, const Gemm g, const Sched& S, const Epi& E, const int* rowtab, LAS unsigned* gtab) {
    int lane; asm volatile("v_mbcnt_lo_u32_b32 %0, -1, 0\n\tv_mbcnt_hi_u32_b32 %0, -1, %0" : "=v"(lane));
    const int tid = wid * 64 + lane, wr = wid >> 2, wc = wid & 3, fr = lane & 15, fq = lane >> 4;
    const int K = g.K, nt = K / BK;
    unsigned voffA[2], voffB[2];
#pragma unroll
    for (int i = 0; i < 2; ++i) { int R, C; stage_rc(tid * 16 + i * 8192, R, C); const int Rb = Epi::PERM ? ((R & ~31) + perm32(R & 31)) : R;
        voffA[i] = (unsigned)R | ((unsigned)(C * 2) << 16); voffB[i] = (unsigned)(Rb * g.ldb + C) * 2u; }
    const size_t kstep = (size_t)(BK * 2);
    const size_t hstepA = (size_t)HALF * g.lda * 2, hstepB = (size_t)HALF * g.ldb * 2;
    const unsigned ldsw = (unsigned)wid * 1024u;
    const int aoff = lds_byte(wr * 64 + fr, fq * 8), boff = lds_byte(wc * 32 + fr, fq * 8);
#define PG8_SA(b, h) (((b) * 2 + (h)) * HTB)
#define PG8_SB(b, h) ((4 + (b) * 2 + (h)) * HTB)
#define PG8_STAGE(bufoff, gbase, voff) do { _Pragma("unroll") for (int _i = 0; _i < 2; ++_i) \
        __builtin_amdgcn_global_load_lds((const unsigned*)((const char*)(gbase) + (voff)[_i]), (LAS unsigned*)(lds + (bufoff) + ldsw + _i * 8192), 16, 0, 0); } while (0)
#define PG8_LDA(dst, b, h) do { _Pragma("unroll") for (int m = 0; m < 4; ++m) _Pragma("unroll") for (int k = 0; k < 2; ++k) dst[m][k] = *(const LAS bf16x8*)(lds + PG8_SA(b, h) + aoff + m * 2048 + k * 1024); } while (0)
#define PG8_LDB(dst, b, h) do { _Pragma("unroll") for (int n = 0; n < 2; ++n) _Pragma("unroll") for (int k = 0; k < 2; ++k) dst[n][k] = *(const LAS bf16x8*)(lds + PG8_SB(b, h) + boff + n * 2048 + k * 1024); } while (0)
#define PG8_MMA(ai, bj, At, Bt) do { __builtin_amdgcn_s_setprio(1); _Pragma("unroll") for (int m = 0; m < 4; ++m) _Pragma("unroll") for (int n = 0; n < 2; ++n) _Pragma("unroll") for (int k = 0; k < 2; ++k) \
        acc[ai][bj][m][n] = __builtin_amdgcn_mfma_f32_16x16x32_bf16(Bt[n][k], At[m][k], acc[ai][bj][m][n], 0, 0, 0); __builtin_amdgcn_s_setprio(0); } while (0)
#define PG8_STAGE_A(bufoff, gbase, half, tb) do { _Pragma("unroll") for (int _i = 0; _i < 2; ++_i) { const unsigned _o = gtab[(tb) * 256 + (half) * 128 + (voffA[_i] & 0xffffu)] + (voffA[_i] >> 16); \
        __builtin_amdgcn_global_load_lds((const unsigned*)((const char*)(gbase) + _o), (LAS unsigned*)(lds + (bufoff) + ldsw + _i * 8192), 16, 0, 0); } } while (0)
#define PG8_WAIT_V(n) asm volatile("s_waitcnt vmcnt(" #n ")" ::: "memory")
#define PG8_WAIT_L(n) asm volatile("s_waitcnt lgkmcnt(" #n ")" ::: "memory")
#define PG8_BAR __builtin_amdgcn_s_barrier()
#define PG8_SCHED __builtin_amdgcn_sched_barrier(0)
    Unit cur, nxt; int ui = 0;
    if (!S.next(0, cur)) return;
    f32x4 acc[2][2][4][2];
#pragma unroll
    for (int a = 0; a < 2; ++a)
#pragma unroll
        for (int b = 0; b < 2; ++b)
#pragma unroll
            for (int m = 0; m < 4; ++m)
#pragma unroll
                for (int n = 0; n < 2; ++n) acc[a][b][m][n] = (f32x4){0.f, 0.f, 0.f, 0.f};
    bf16x8 At[4][2], B0[2][2], B1[2][2];
    const char* cA = (const char*)g.A; const char* cB = (const char*)g.Bt + cur.offB;
    if (tid < 256) gtab[tid] = (unsigned)rowtab[cur.pm * 256 + tid] * (unsigned)(g.lda * 2);
    asm volatile("s_waitcnt vmcnt(0) lgkmcnt(0)" ::: "memory"); __builtin_amdgcn_s_barrier(); asm volatile("" ::: "memory");
    int cb = 0;
    PG8_STAGE(PG8_SB(0, 0), cB, voffB); PG8_STAGE(PG8_SB(0, 1), cB + hstepB, voffB); PG8_STAGE_A(PG8_SA(0, 0), cA, 0, cb); PG8_STAGE_A(PG8_SA(0, 1), cA, 1, cb);
    if (wr == 1) PG8_BAR;
    PG8_WAIT_V(2); PG8_BAR;
    PG8_STAGE(PG8_SB(1, 0), cB + kstep, voffB); PG8_STAGE_A(PG8_SA(1, 0), cA + kstep, 0, cb); PG8_STAGE(PG8_SB(1, 1), cB + hstepB + kstep, voffB);
    PG8_WAIT_V(6); PG8_BAR;
    for (;;) {
        const bool has_next = S.next(ui + 1, nxt);
        const char* nA = cA; const char* nB = has_next ? (const char*)g.Bt + nxt.offB : cB;
        if (has_next && tid < 256) gtab[(cb ^ 1) * 256 + tid] = (unsigned)rowtab[nxt.pm * 256 + tid] * (unsigned)(g.lda * 2);
        const int nbq = has_next ? (cb ^ 1) : cb;
        for (int t = 0; t < nt; t += 2) {
            const bool last = (t == nt - 2);
            const char* a1 = cA + (size_t)(t + 1) * kstep; const int tb2 = last ? nbq : cb;
            const char* a2 = last ? nA : cA + (size_t)(t + 2) * kstep; const char* b2 = last ? nB : cB + (size_t)(t + 2) * kstep;
            const char* a3 = a2 + kstep; const char* b3 = b2 + kstep;
            PG8_LDB(B0, 0, 0); PG8_LDB(B1, 0, 1); PG8_SCHED; PG8_LDA(At, 0, 0); PG8_STAGE_A(PG8_SA(1, 1), a1, 1, cb);
            PG8_WAIT_V(8); PG8_WAIT_L(0); PG8_BAR; PG8_MMA(0, 0, At, B0); PG8_MMA(0, 1, At, B1); PG8_BAR; PG8_SCHED;
            PG8_LDA(At, 0, 1); PG8_STAGE(PG8_SB(0, 0), b2, voffB); PG8_STAGE(PG8_SB(0, 1), b2 + hstepB, voffB); PG8_STAGE_A(PG8_SA(0, 0), a2, 0, tb2);
            PG8_WAIT_V(8); PG8_WAIT_L(0); PG8_BAR; PG8_MMA(1, 0, At, B0); PG8_MMA(1, 1, At, B1); PG8_BAR; PG8_SCHED;
            PG8_LDB(B0, 1, 0); PG8_LDB(B1, 1, 1); PG8_SCHED; PG8_LDA(At, 1, 0); PG8_STAGE_A(PG8_SA(0, 1), a2, 1, tb2);
            PG8_WAIT_V(8); PG8_WAIT_L(0); PG8_BAR; PG8_MMA(0, 0, At, B0); PG8_MMA(0, 1, At, B1); PG8_BAR; PG8_SCHED;
            PG8_LDA(At, 1, 1); PG8_STAGE(PG8_SB(1, 0), b3, voffB); PG8_STAGE(PG8_SB(1, 1), b3 + hstepB, voffB); PG8_STAGE_A(PG8_SA(1, 0), a3, 0, tb2);
            PG8_WAIT_V(8); PG8_WAIT_L(0); PG8_BAR; PG8_MMA(1, 0, At, B0); PG8_MMA(1, 1, At, B1); PG8_BAR; PG8_SCHED;
        }
        if constexpr (ALIGN_EPI) { if (wr == 0) PG8_BAR; }
        { int l2; asm volatile("v_mbcnt_lo_u32_b32 %0, -1, 0\n\tv_mbcnt_hi_u32_b32 %0, -1, %0" : "=v"(l2)); E(acc, cur, wr, wc, l2 & 15, l2 >> 4); }
        if (!has_next) break;
#pragma unroll
        for (int a = 0; a < 2; ++a)
#pragma unroll
            for (int b = 0; b < 2; ++b)
#pragma unroll
                for (int m = 0; m < 4; ++m)
#pragma unroll
                    for (int n = 0; n < 2; ++n) acc[a][b][m][n] = (f32x4){0.f, 0.f, 0.f, 0.f};
        cur = nxt; cA = nA; cB = nB; ++ui; cb ^= 1;
        if constexpr (ALIGN_EPI) { if (wr == 1) PG8_BAR; }
    }
    PG8_WAIT_V(0);
    if constexpr (!ALIGN_EPI) { if (wr == 0) PG8_BAR; }
    PG8_BAR;
#undef PG8_SA
#undef PG8_SB
#undef PG8_STAGE
#undef PG8_LDA
#undef PG8_LDB
#undef PG8_MMA
#undef PG8_STAGE_A
#undef PG8_WAIT_V
#undef PG8_WAIT_L
#undef PG8_BAR
#undef PG8_SCHED
}
}

constexpr size_t MiB = 1u << 20;
constexpr size_t WS_CTL = 0, CTL_ZERO_BYTES = 1 * MiB;
constexpr size_t WS_SSQ = 1 * MiB;
constexpr size_t WS_WR = 9 * MiB, WS_WK = 11 * MiB, WS_WV = 13 * MiB, WS_WO0 = 15 * MiB;
constexpr size_t WS_WPQ = 17 * MiB;
constexpr size_t WS_WL2 = 18 * MiB;
constexpr size_t WS_SBQKV = 20 * MiB, WS_SBWO = 26 * MiB;
constexpr size_t WS_XAWQ = 28 * MiB, WS_XAWO = 32 * MiB, WS_XAWKV = 36 * MiB;
constexpr size_t WS_ROUTE = 40 * MiB;
constexpr size_t WS_W13 = 41 * MiB;
constexpr size_t WS_W2 = 105 * MiB;
constexpr size_t WS_MEMN = 137 * MiB, WS_MEMK = 153 * MiB, WS_MEMVT = 169 * MiB;
constexpr size_t WS_HB = 185 * MiB;
constexpr size_t WS_ARENA = 313 * MiB;
constexpr size_t WS_LOGIT = WS_ARENA + 512 * MiB;
constexpr size_t WS_TOKE = WS_LOGIT + 16 * MiB, WS_TOKP = WS_TOKE + 512 * 1024, WS_TOKW = WS_TOKE + 1 * MiB, WS_TOKS = WS_TOKW + 512 * 1024;
constexpr size_t WS_ROWTAB = WS_TOKE + 4 * MiB;
constexpr size_t WS_GATE = WS_TOKE + 2 * MiB;
constexpr size_t BUF = (size_t)T * DM * 2;
constexpr size_t HBUF = BUF / NGRP;
constexpr size_t WS_BONUS = WS_ARENA + 11 * HBUF;
constexpr size_t WS_END = WS_BONUS + 2 * MiB;   static_assert(WS_ROWTAB + 1 * MiB <= WS_BONUS && WS_END <= 1024 * MiB && (size_t)TG * 16 * 4 <= 2 * MiB, "workspace");
static_assert((size_t)MAXSLOT * 8 <= 2 * MiB, "gate table");
constexpr int CW_BAR = 4096;
constexpr int CW_CNT = 16384;
constexpr int CW_STQ = 32768;

constexpr int RING_BYTES = 131072;
constexpr int LDSCTL_OFF = RING_BYTES;
constexpr int LDS_XB = LDSCTL_OFF;
constexpr int LDS_TOFF = LDSCTL_OFF + 3072;
constexpr int LDS_FLAGS = LDSCTL_OFF + 256;
constexpr int LDS_HIST = LDSCTL_OFF + 512;
constexpr int LDS_INP = LDSCTL_OFF + 1024;
constexpr int LDS_TEXP = LDSCTL_OFF + 2048;
constexpr int LDS_GTAB = LDSCTL_OFF + 12288;
constexpr int LDS_SM = LDSCTL_OFF + 4096;
constexpr int LDS_YB = LDSCTL_OFF + 4096;
constexpr int LDS_BYTES = 153600;

#define RLX_AGENT __ATOMIC_RELAXED, __HIP_MEMORY_SCOPE_AGENT

#define XB_TMO      128
#define XB_XCNT(j)  (256  + 64 * (j))
#define XB_XSUB(j)  (1280 + 64 * (j))
#define XB_XGEN(j)  (2304 + 64 * (j))
#define XB_TOP      3328
#define XB_TOPGEN   3392
#define XCD_BAR_WORDS 3456
#define XB_SPIN_CAP (1u << 18)
__device__ __forceinline__ unsigned xb_ld(unsigned* p)              { return __hip_atomic_load(p, __ATOMIC_RELAXED, __HIP_MEMORY_SCOPE_AGENT); }
__device__ __forceinline__ unsigned xb_add(unsigned* p, unsigned v) { return __hip_atomic_fetch_add(p, v, __ATOMIC_RELAXED, __HIP_MEMORY_SCOPE_AGENT); }
__device__ __forceinline__ unsigned xb_xcc_id() { return (unsigned)__builtin_amdgcn_s_getreg((3 << 11) | 20) & 0xFu; }
#define XB_SPIN(cond, bar) do { unsigned _sp = 0; while (cond) { __builtin_amdgcn_s_sleep(1); \
    if ((++_sp & 255u) == 0u) { if (xb_ld(&(bar)[XB_TMO])) break; if (_sp > XB_SPIN_CAP) { atomicAdd(&(bar)[XB_TMO], 1u); break; } } } } while (0)
struct XcdBarrier { unsigned* bar; unsigned x; volatile LAS unsigned* st; };
__device__ __forceinline__ XcdBarrier xcd_barrier_post(unsigned* bar, volatile LAS unsigned* st) {
    XcdBarrier b; b.bar = bar; b.x = xb_xcc_id(); b.st = st;
    if (threadIdx.x == 0) (void)xb_add(&bar[XB_XCNT(b.x)], 1u);
    return b;
}
__device__ __forceinline__ void xcd_barrier_complete(unsigned* bar, unsigned x, unsigned& nloc, unsigned& nx) {
    const unsigned G = gridDim.x * gridDim.y * gridDim.z;
    unsigned sum, cnt, mine, sp = 0u;
    for (;;) {
        sum = 0u; cnt = 0u; mine = 0u;
#pragma unroll
        for (unsigned j = 0; j < 16; ++j) { const unsigned c = xb_ld(&bar[XB_XCNT(j)]); sum += c; cnt += (c > 0u) ? 1u : 0u; mine = (j == x) ? c : mine; }
        if (sum == G) break;
        __builtin_amdgcn_s_sleep(1);
        if ((++sp & 255u) == 0u) { if (xb_ld(&bar[XB_TMO])) break; if (sp > XB_SPIN_CAP) { atomicAdd(&bar[XB_TMO], 1u); break; } }
    }
    nloc = mine > 0u ? mine : 1u; nx = cnt > 0u ? cnt : 1u;
}
__device__ __forceinline__ void xcd_barrier(const XcdBarrier& b) {
    asm volatile("s_waitcnt vmcnt(0)" ::: "memory");
    __syncthreads();
    if (threadIdx.x == 0) {
        unsigned* bar = b.bar;
        __builtin_amdgcn_s_waitcnt(0);
        unsigned nloc = b.st[0], nx = b.st[1];
        if (nloc == 0u) { xcd_barrier_complete(bar, b.x, nloc, nx); b.st[0] = nloc; b.st[1] = nx; }
        const unsigned old = xb_add(&bar[XB_XSUB(b.x)], 1u);
        const unsigned gen = old / nloc;
        if (old + 1u == (gen + 1u) * nloc) {
            __builtin_amdgcn_fence(__ATOMIC_RELEASE, "agent");
            asm volatile("s_waitcnt vmcnt(0)" ::: "memory");
            const unsigned og = xb_add(&bar[XB_TOP], 1u);
            const unsigned tg = og / nx;
            if (og + 1u == (tg + 1u) * nx) xb_add(&bar[XB_TOPGEN], 1u);
            else XB_SPIN(xb_ld(&bar[XB_TOPGEN]) == tg, bar);
            __builtin_amdgcn_fence(__ATOMIC_ACQUIRE, "agent");
            xb_add(&bar[XB_XGEN(b.x)], 1u);
            asm volatile("s_waitcnt vmcnt(0)" ::: "memory");
        } else {
            XB_SPIN(xb_ld(&bar[XB_XGEN(b.x)]) == gen, bar);
            __builtin_amdgcn_fence(__ATOMIC_ACQUIRE, "agent");
            asm volatile("s_waitcnt vmcnt(0)" ::: "memory");
        }
    }
    __syncthreads();
}

__device__ __forceinline__ unsigned f2bf(float f) { unsigned u = __builtin_bit_cast(unsigned, f); return (u + 0x7fffu + ((u >> 16) & 1u)) >> 16; }
__device__ __forceinline__ unsigned pk2(float lo, float hi) { return f2bf(lo) | (f2bf(hi) << 16); }
__device__ __forceinline__ float bflo(unsigned w) { return __uint_as_float(w << 16); }
__device__ __forceinline__ float bfhi(unsigned w) { return __uint_as_float(w & 0xffff0000u); }
__device__ __forceinline__ f32x4 unpack4(u32x2 w) { return (f32x4){bflo(w.x), bfhi(w.x), bflo(w.y), bfhi(w.y)}; }
__device__ __forceinline__ u32x2 pack4(f32x4 v) { u32x2 w; w.x = pk2(v[0], v[1]); w.y = pk2(v[2], v[3]); return w; }
template <int CTRL> __device__ __forceinline__ float dppf(float v) { return __uint_as_float((unsigned)__builtin_amdgcn_update_dpp(0, (int)__float_as_uint(v), CTRL, 0xF, 0xF, true)); }
__device__ __forceinline__ float sum4(float v) { v += dppf<0xB1>(v); v += dppf<0x4E>(v); return v; }
__device__ __forceinline__ float sum8(float v) { v = sum4(v); v += dppf<0x141>(v); return v; }
__device__ __forceinline__ float sum16(float v) { v = sum8(v); v += dppf<0x140>(v); return v; }
__device__ __forceinline__ float rdlane(float v, int l) { return __int_as_float(__builtin_amdgcn_readlane(__float_as_int(v), l)); }
__device__ __forceinline__ float wave_sum(float v) { v = sum16(v); return (rdlane(v, 0) + rdlane(v, 16)) + (rdlane(v, 32) + rdlane(v, 48)); }
__device__ __forceinline__ float wave_max(float v) { v = fmaxf(v, dppf<0xB1>(v)); v = fmaxf(v, dppf<0x4E>(v)); v = fmaxf(v, dppf<0x141>(v)); v = fmaxf(v, dppf<0x140>(v));
    return fmaxf(fmaxf(rdlane(v, 0), rdlane(v, 16)), fmaxf(rdlane(v, 32), rdlane(v, 48))); }
__device__ __forceinline__ float sigm(float x) { return __builtin_amdgcn_rcpf(1.f + __expf(-x)); }

struct Ctx { int wave, bid, G, gw, NGW; };
__device__ __forceinline__ int lane_id() { int l; asm volatile("v_mbcnt_lo_u32_b32 %0, -1, 0\n\tv_mbcnt_hi_u32_b32 %0, -1, %0" : "=v"(l)); return l; }
#define PHASE_IDS const int lane = lane_id(); const int tid = c.wave * 64 + lane; (void)tid; (void)lane

__device__ __forceinline__ void store_pair16(bf16_t* p, int hh, u32x2 a, u32x2 b) {
    const auto x = __builtin_amdgcn_permlane32_swap(a.x, b.x, false, false), y = __builtin_amdgcn_permlane32_swap(a.y, b.y, false, false);
    u32x4 w; w.x = x[0]; w.y = y[0]; w.z = x[1]; w.w = y[1];
    *(u32x4*)(p + 4 * hh) = w;
}
__device__ __forceinline__ void tr_block(const float* W, int ldw, int k0, int n0, bf16_t* WT, int ldt, int drow0, LAS float* scr, int lane, const float* s, int mode) {
    LAS unsigned* Tw = (LAS unsigned*)scr; const int kq = lane >> 4, n4 = (lane & 15) * 4;
    f32x4 v0[8], v1[8];
#pragma unroll
    for (int i = 0; i < 8; ++i) { const float* p = W + (size_t)(k0 + 8 * i + 2 * kq) * ldw + n0 + n4; v0[i] = *(const f32x4*)p; v1[i] = *(const f32x4*)(p + ldw); }
    if (mode) {
#pragma unroll
        for (int i = 0; i < 8; ++i) { float m0 = s[k0 + 8 * i + 2 * kq], m1 = s[k0 + 8 * i + 2 * kq + 1]; if (mode == 1) { m0 = 1.f - m0; m1 = 1.f - m1; } v0[i] *= m0; v1[i] *= m1; }
    }
#pragma unroll
    for (int i = 0; i < 8; ++i)
#pragma unroll
        for (int e = 0; e < 4; ++e) Tw[(n4 + e) * 33 + 4 * i + kq] = pk2(v0[i][e], v1[i][e]);
    asm volatile("s_waitcnt lgkmcnt(0)" ::: "memory");
    const int nr = lane >> 3, kc = lane & 7;
#pragma unroll
    for (int j = 0; j < 8; ++j) { const int n = nr + 8 * j; const LAS unsigned* p = Tw + n * 33 + 4 * kc;
        u32x4 o; o.x = p[0]; o.y = p[1]; o.z = p[2]; o.w = p[3];
        *(u32x4*)(WT + (size_t)(drow0 + n) * ldt + k0 + 8 * kc) = o; }
    asm volatile("s_waitcnt lgkmcnt(0)" ::: "memory");
}
__device__ __forceinline__ void cp_item(const float* W, int N, bf16_t* WN, int item, int lane, const float* s) {
    const int nblk = N / 64, k0 = 64 * (item / nblk), n0 = 64 * (item % nblk), kq = lane >> 4, n4 = (lane & 15) * 4;
    f32x4 v[16];
#pragma unroll
    for (int i = 0; i < 16; ++i) v[i] = __builtin_nontemporal_load((const f32x4*)(W + (size_t)(k0 + 4 * i + kq) * N + n0 + n4));
#pragma unroll
    for (int i = 0; i < 16; ++i) *(u32x2*)(WN + (size_t)(k0 + 4 * i + kq) * N + n0 + n4) = pack4(v[i] * s[k0 + 4 * i + kq]);
}
__device__ __forceinline__ void tr_item(const float* W, int K, int N, bf16_t* WT, int drow, LAS float* scr, int item, int lane, const float* s = nullptr, int mode = 0) {
    const int nblk = N / 64, kb = item / nblk, nb = item % nblk;
    tr_block(W, N, 64 * kb, 64 * nb, WT, K, drow + 64 * nb, scr, lane, s, mode);
}

struct In {
    const float *x, *mem, *norm_mix, *norm_cross, *norm_ffn, *norm_mem, *norm_final;
    const float *rw_mix, *rw_wr, *rw_wk, *rw_wv, *rw_w0, *rw_w1, *rw_w2, *rw_a0, *rw_a1, *rw_a2, *rw_g1, *rw_g2, *rw_kk, *rw_ka, *rw_rk, *rw_lnx_w, *rw_lnx_b, *rw_wo;
    const float *sb_wqkv, *sb_wo, *xa_wq, *xa_wkv, *xa_wo, *moe_wg, *moe_bg, *moe_we, *moe_be, *moe_w1, *moe_w3, *moe_w2;
};
struct Args { In in; float* out; unsigned char* ws; int ph_lo, ph_hi; };
struct InL { const LAS unsigned long long* p;
    __device__ __forceinline__ const float* get(int i) const { const unsigned long long v = p[i]; const unsigned lo = __builtin_amdgcn_readfirstlane((unsigned)v), hi = __builtin_amdgcn_readfirstlane((unsigned)(v >> 32)); return (const float*)(((unsigned long long)hi << 32) | lo); } };
#define IN(name) (in.get((int)(offsetof(In, name) / 8)))

__device__ __forceinline__ void rms_row_to_bf16(const float* xrow, const float* gain, bf16_t* orow, int lane) {
    const f32x4* xr = (const f32x4*)xrow + lane; f32x4 v[4]; float s = 0.f;
#pragma unroll
    for (int j = 0; j < 4; ++j) { v[j] = xr[64 * j]; s += (v[j].x * v[j].x + v[j].y * v[j].y) + (v[j].z * v[j].z + v[j].w * v[j].w); }
    const float rs = rsqrtf(wave_sum(s) * (1.f / DM) + NORM_EPS);
#pragma unroll
    for (int j = 0; j < 4; ++j) { const f32x4 g = gain ? ((const f32x4*)gain)[lane + 64 * j] : (f32x4){1.f, 1.f, 1.f, 1.f}; ((u32x2*)orow)[lane + 64 * j] = pack4(v[j] * rs * g); }
}

__device__ __forceinline__ void p_prologue(const Ctx& c, const InL& in, unsigned char* ws, LAS unsigned char* lds) {
    PHASE_IDS;
    LAS float* scr = (LAS float*)(lds + c.wave * 16384);
    constexpr int I_SQ = 16 * 16;
    constexpr int I_QKV = 16 * 48, I_KV = 16 * 32;
    constexpr int I_L64 = 16 * 1, I_L128 = 16 * 2;
    constexpr int I_M13 = 16 * 4;
    constexpr int I_M2 = 4 * 16;
    constexpr int NITEMS = 4 * I_SQ + 2 * (2 * I_L64 + I_L128) + I_QKV + I_SQ + 4 * I_SQ + I_KV + 2 * 64 * I_M13 + 64 * I_M2;
    for (int it = c.gw; it < NITEMS; it += c.NGW) {
        int r = it;
        if (r < I_SQ) { tr_item(IN(rw_wr), DM, DM, (bf16_t*)(ws + WS_WR), 0, scr, r, lane); continue; } r -= I_SQ;
        if (r < I_SQ) { tr_item(IN(rw_wk), DM, DM, (bf16_t*)(ws + WS_WK), 0, scr, r, lane); continue; } r -= I_SQ;
        if (r < I_SQ) { tr_item(IN(rw_wv), DM, DM, (bf16_t*)(ws + WS_WV), 0, scr, r, lane); continue; } r -= I_SQ;
        if (r < I_SQ) { tr_item(IN(rw_wo), DM, DM, (bf16_t*)(ws + WS_WO0), 0, scr, r, lane); continue; } r -= I_SQ;
        if (r < 2 * (2 * I_L64 + I_L128)) {
            const int q = r / (2 * I_L64 + I_L128), rr = r % (2 * I_L64 + I_L128); const int mode = 1 + q; bf16_t* WT = (bf16_t*)(ws + WS_WPQ);
            if (rr < I_L64) tr_item(IN(rw_w1), DM, 64, WT, 256 * q + 0, scr, rr, lane, IN(rw_mix) + 1 * DM, mode);
            else if (rr < 2 * I_L64) tr_item(IN(rw_a1), DM, 64, WT, 256 * q + 64, scr, rr - I_L64, lane, IN(rw_mix) + 4 * DM, mode);
            else tr_item(IN(rw_g1), DM, 128, WT, 256 * q + 128, scr, rr - 2 * I_L64, lane, IN(rw_mix) + 5 * DM, mode);
            continue; } r -= 2 * (2 * I_L64 + I_L128);
        if (r < I_QKV) { tr_item(IN(sb_wqkv), DM, 3 * DM, (bf16_t*)(ws + WS_SBQKV), 0, scr, r, lane, IN(norm_mix) + DM, 2); continue; } r -= I_QKV;
        if (r < I_SQ) { tr_item(IN(sb_wo), DM, DM, (bf16_t*)(ws + WS_SBWO), 0, scr, r, lane); continue; } r -= I_SQ;
        if (r < 2 * I_SQ) { const int l = r / I_SQ; cp_item(IN(xa_wq) + (size_t)l * DM * DM, DM, (bf16_t*)(ws + WS_XAWQ) + (size_t)l * DM * DM, r % I_SQ, lane, IN(norm_cross) + l * DM); continue; } r -= 2 * I_SQ;
        if (r < 2 * I_SQ) { const int l = r / I_SQ; tr_item(IN(xa_wo) + (size_t)l * DM * DM, DM, DM, (bf16_t*)(ws + WS_XAWO) + (size_t)l * DM * DM, 0, scr, r % I_SQ, lane); continue; } r -= 2 * I_SQ;
        if (r < I_KV) { tr_item(IN(xa_wkv), DM, 2 * DM, (bf16_t*)(ws + WS_XAWKV), 0, scr, r, lane); continue; } r -= I_KV;
        if (r < 2 * 64 * I_M13) {
            const int which = r / (64 * I_M13), rr = r % (64 * I_M13), le = rr / I_M13, item = rr % I_M13;
            const float* W = (which ? IN(moe_w3) : IN(moe_w1)) + (size_t)le * DM * DF; bf16_t* WT = (bf16_t*)(ws + WS_W13) + (size_t)le * 512 * DM;
            const int nblk = DF / 64, kb = item / nblk, nb = item % nblk, n0 = 64 * nb;
            tr_block(W, DF, 64 * kb, n0, WT, DM, (n0 / 128) * 256 + (n0 % 128) + which * 128, scr, lane, IN(norm_ffn) + (le / NE) * DM, 2);
            continue; } r -= 2 * 64 * I_M13;
        { const int le = r / I_M2, item = r % I_M2; tr_item(IN(moe_w2) + (size_t)le * DF * DM, DF, DM, (bf16_t*)(ws + WS_W2) + (size_t)le * DM * DF, 0, scr, item, lane); }
    }
    const int gt = c.bid * 512 + tid, NT = c.G * 512;
    for (int i = gt; i < 2 * 256 * DM; i += NT) { const int l = i / (256 * DM), n = (i / DM) % 256, k = i % DM; float v = 0.f;
        if (n < NG) v = IN(moe_wg)[((size_t)l * DM + k) * NG + n]; else if (n < NG + NE) v = IN(moe_we)[((size_t)l * DM + k) * NE + (n - NG)];
        ((bf16_t*)(ws + WS_ROUTE))[i] = (bf16_t)f2bf(v * IN(norm_ffn)[l * DM + k]); }
    for (int i = gt; i < 3072 * 256; i += NT) { const int n = i / 256, k = i % 256, t = n / 1024, nn = n % 1024; float v = 0.f;
        if (t == 0) { if (k < 64) v = IN(rw_w2)[(size_t)k * DM + nn]; } else if (t == 1) { if (k >= 64 && k < 128) v = IN(rw_a2)[(size_t)(k - 64) * DM + nn]; } else { if (k >= 128) v = IN(rw_g2)[(size_t)(k - 128) * DM + nn]; }
        ((bf16_t*)(ws + WS_WL2))[i] = (bf16_t)f2bf(v); }
    for (int m = c.gw; m < BATCH * NMEM; m += c.NGW) rms_row_to_bf16(IN(mem) + (size_t)m * DM, IN(norm_mem), (bf16_t*)(ws + WS_MEMN) + (size_t)m * DM, lane);
}

__device__ __forceinline__ void p_norm_shift(const Ctx& c, const InL& in, int g, bf16_t* hn, bf16_t* xr, bf16_t* xk, bf16_t* xv) {
    PHASE_IDS;
    const int NGW = c.G * 8; const float* xin = IN(x); const float* gnp = IN(norm_mix); const float* mixp = IN(rw_mix);
    for (int row0 = c.bid * 8 + c.wave; row0 < TG; row0 += 2 * NGW) {
        f32x4 v[2][4], p[2][4]; bool first[2];
#pragma unroll
        for (int q = 0; q < 2; ++q) { const int t = g * TG + row0 + q * NGW; first[q] = (t % SEQ) == 0;
            const f32x4* xc = (const f32x4*)(xin + (size_t)t * DM) + lane; const f32x4* xp = (const f32x4*)(xin + (size_t)(first[q] ? t : t - 1) * DM) + lane;
#pragma unroll
            for (int j = 0; j < 4; ++j) { v[q][j] = xc[64 * j]; p[q][j] = xp[64 * j]; } }
#pragma unroll
        for (int q = 0; q < 2; ++q) { const int row = row0 + q * NGW; float s = 0.f, sp = 0.f;
#pragma unroll
            for (int j = 0; j < 4; ++j) { s += (v[q][j].x * v[q][j].x + v[q][j].y * v[q][j].y) + (v[q][j].z * v[q][j].z + v[q][j].w * v[q][j].w); sp += (p[q][j].x * p[q][j].x + p[q][j].y * p[q][j].y) + (p[q][j].z * p[q][j].z + p[q][j].w * p[q][j].w); }
            const float rs = rsqrtf(wave_sum(s) * (1.f / DM) + NORM_EPS); const float rpv = rsqrtf(wave_sum(sp) * (1.f / DM) + NORM_EPS); const float rp = first[q] ? 0.f : rpv;
#pragma unroll
            for (int j = 0; j < 4; ++j) { const int ci = lane + 64 * j; const f32x4 gn = ((const f32x4*)gnp)[ci];
                const f32x4 h = v[q][j] * rs * gn, hp = p[q][j] * rp * gn, dx = hp - h;
                const f32x4 mr = ((const f32x4*)(mixp + 0 * DM))[ci], mk = ((const f32x4*)(mixp + 2 * DM))[ci], mv = ((const f32x4*)(mixp + 3 * DM))[ci];
                const size_t o = (size_t)row * (DM / 4) + ci;
                ((u32x2*)hn)[o] = pack4(h); ((u32x2*)xr)[o] = pack4(h + dx * mr); ((u32x2*)xk)[o] = pack4(h + dx * mk); ((u32x2*)xv)[o] = pack4(h + dx * mv); } }
    }
}
__device__ __forceinline__ void p_lora_act(const Ctx& c, const bf16_t* pq, bf16_t* act) {
    PHASE_IDS;
    for (int row = c.gw; row < TG; row += c.NGW) {
        const bool first = (row % SEQ) == 0;
        f32x4 u = unpack4(((const u32x2*)(pq + (size_t)row * 512))[lane]);
        if (!first) u += unpack4(((const u32x2*)(pq + (size_t)(row - 1) * 512 + 256))[lane]);
        f32x4 o;
#pragma unroll
        for (int e = 0; e < 4; ++e) { const float x = u[e]; o[e] = (lane < 16) ? (1.f - 2.f * __builtin_amdgcn_rcpf(1.f + __expf(2.f * x))) : (lane < 32 ? x : sigm(x)); }
        ((u32x2*)(act + (size_t)row * 256))[lane] = pack4(o);
    }
}
typedef _Float16 f16x8 __attribute__((ext_vector_type(8)));
typedef float f32x16 __attribute__((ext_vector_type(16)));
typedef __bf16 bf16x2_t __attribute__((ext_vector_type(2)));
__device__ __forceinline__ unsigned cvt2bf(float lo, float hi) { f32x2 v = {lo, hi}; bf16x2_t b = __builtin_convertvector(v, bf16x2_t); return __builtin_bit_cast(unsigned, b); }
__device__ __forceinline__ unsigned cvt2h(float lo, float hi) { return __builtin_bit_cast(unsigned, __builtin_amdgcn_cvt_pkrtz(lo, hi)); }
__device__ __forceinline__ bf16x8 frag144(const LAS unsigned char* img, int row, int s, int hh) { return *(const LAS bf16x8*)(img + row * 144 + s * 32 + hh * 16); }
__device__ __forceinline__ bf16x8 frag144s(const LAS unsigned char* img, int row, int s, int hh) { return *(const LAS bf16x8*)(img + row * 144 + (((2 * s + hh) ^ ((row >> 3) & 7)) << 4)); }
__device__ __forceinline__ void s1_solve(const Ctx& c, const LAS unsigned char* I_A, const LAS unsigned char* I_AB, const LAS unsigned char* TB, const LAS float* RZ, LAS unsigned char* AT, LAS unsigned char* I_XT) {
    constexpr int P = 144;
    const int ct = c.wave; LAS unsigned char* at = AT + ct * 512;
#pragma unroll
    for (int bb = 0; bb < 4; ++bb) {
        const int lane = lane_id(), c16 = lane & 15, g4 = lane >> 4, col = 16 * ct + c16;
        f32x4 d = (f32x4){0.f, 0.f, 0.f, 0.f};
        if (bb > 0) {
#pragma unroll
            for (int s = 0; s < (16 * bb + 31) / 32; ++s) {
                const bf16x8 a = *(const LAS bf16x8*)(I_AB + (16 * bb + c16) * P + s * 64 + g4 * 16), b = *(const LAS bf16x8*)(I_XT + col * P + s * 64 + g4 * 16);
                d = __builtin_amdgcn_mfma_f32_16x16x32_bf16(a, b, d, 0, 0, 0); }
        }
        if (ct < 4) {
#pragma unroll
            for (int e = 0; e < 4; ++e) d[e] += __uint_as_float(((unsigned)*(const LAS unsigned short*)(I_A + (16 * bb + 4 * g4 + e) * P + col * 2)) << 16);
        } else {
#pragma unroll
            for (int e = 0; e < 4; ++e) d[e] += RZ[(16 * bb + 4 * g4 + e) * 68 + (col - 64)];
        }
        { u32x2 w; w.x = cvt2bf(d[0], d[1]); w.y = cvt2bf(d[2], d[3]); *(LAS u32x2*)(at + c16 * 32 + 8 * g4) = w; }
        asm volatile("s_waitcnt lgkmcnt(0)" ::: "memory");
        u32x4 bw = *(const LAS u32x4*)(at + c16 * 32 + 16 * (g4 & 1)); if (g4 >= 2) bw = (u32x4){0u, 0u, 0u, 0u};
        const bf16x8 a2 = *(const LAS bf16x8*)(TB + bb * 1024 + c16 * 64 + g4 * 16);
        const f32x4 x = __builtin_amdgcn_mfma_f32_16x16x32_bf16(a2, __builtin_bit_cast(bf16x8, bw), (f32x4){0.f, 0.f, 0.f, 0.f}, 0, 0, 0);
        { u32x2 w; w.x = cvt2bf(x[0], x[1]); w.y = cvt2bf(x[2], x[3]); *(LAS u32x2*)(I_XT + col * P + (16 * bb + 4 * g4) * 2) = w; }
        asm volatile("s_waitcnt lgkmcnt(0)" ::: "memory");
    }
}
__device__ __forceinline__ void s1_tinv(const LAS float* ADG, LAS unsigned char* TB) {
    const int lane = lane_id(), bq = lane >> 4, jc = lane & 15;
    float x[16];
#pragma unroll
    for (int ii = 0; ii < 16; ++ii) {
        const LAS f32x4* ar = (const LAS f32x4*)(ADG + bq * 256 + ii * 16); const f32x4 a0 = ar[0], a1 = ar[1], a2 = ar[2], a3 = ar[3];
        const float av[16] = {a0[0], a0[1], a0[2], a0[3], a1[0], a1[1], a1[2], a1[3], a2[0], a2[1], a2[2], a2[3], a3[0], a3[1], a3[2], a3[3]};
        float v = (ii == jc) ? 1.f : 0.f;
#pragma unroll
        for (int jj = 0; jj < ii; ++jj) v += av[jj] * x[jj];
        x[ii] = v;
        *(LAS unsigned short*)(TB + bq * 1024 + ii * 64 + jc * 2) = (unsigned short)f2bf(v);
    }
    *(LAS u32x4*)(TB + bq * 1024 + jc * 64 + 32) = (u32x4){0u, 0u, 0u, 0u}; *(LAS u32x4*)(TB + bq * 1024 + jc * 64 + 48) = (u32x4){0u, 0u, 0u, 0u};
}
__device__ __forceinline__ void p_scan_s1(const Ctx& c, const InL& in, const bf16_t* R, const bf16_t* Kb, const bf16_t* Vb, const bf16_t* WL, const bf16_t* Ab,
                                          bf16_t* RH, bf16_t* YL, bf16_t* MM, bf16_t* NT, float* bonus, LAS unsigned char* lds) {
    PHASE_IDS;
    constexpr int P = 144, IMG = 64 * P;
    LAS unsigned char* I_R = lds; LAS unsigned char* I_BT = lds + IMG; LAS unsigned char* I_KT = lds + 2 * IMG; LAS unsigned char* I_VT = lds + 3 * IMG;
    LAS unsigned char* I_AK = lds + 4 * IMG; LAS unsigned char* I_RB = lds + 5 * IMG; LAS unsigned char* I_RK = lds + 6 * IMG;
    LAS unsigned char* I_A = lds + 7 * IMG; LAS unsigned char* I_B = lds + 8 * IMG; LAS unsigned char* I_K = lds + 9 * IMG; LAS unsigned char* I_XT = I_B;
    LAS float* A4 = (LAS float*)(lds + 10 * IMG);
    LAS unsigned char* I_AB = lds + 10 * IMG; LAS float* ADG = (LAS float*)(lds + 10 * IMG + IMG); LAS unsigned char* TB = lds + 10 * IMG + IMG + 4096;
    LAS unsigned char* AT = I_AK;
    LAS float* RZ = (LAS float*)(lds + 10 * IMG + 17408);
    LAS float* PL = (LAS float*)(lds + 10 * IMG + 2 * 17408);
    LAS float* TOT = PL + 64;
    u32x4 nrw, nkw, nvw, nww, naw;
#define S1_LOAD(uu) do { const int ch_ = (uu) % (SEQ / 64), h_ = ((uu) / (SEQ / 64)) % NH, bl_ = (uu) / ((SEQ / 64) * NH); \
        const size_t off_ = ((size_t)(bl_ * SEQ + ch_ * 64 + (tid >> 3))) * DM + h_ * HD + (tid & 7) * 8; \
        nrw = *(const u32x4*)(R + off_); nkw = *(const u32x4*)(Kb + off_); nvw = *(const u32x4*)(Vb + off_); nww = *(const u32x4*)(WL + off_); naw = *(const u32x4*)(Ab + off_); } while (0)
    if (c.bid < BG * NH * (SEQ / 64)) S1_LOAD(c.bid);
    for (int u = c.bid; u < BG * NH * (SEQ / 64); u += c.G) {
        const int ch = u % (SEQ / 64), h = (u / (SEQ / 64)) % NH, bl = u / ((SEQ / 64) * NH);
        __syncthreads();
        {
            const int lane = lane_id(), tid = c.wave * 64 + lane;
            const int i = tid >> 3, n8 = (tid & 7) * 8;
            const u32x4 rw = nrw, kw = nkw, vw = nvw, ww = nww, aw = naw;
            float rr[8] = {bflo(rw.x), bfhi(rw.x), bflo(rw.y), bfhi(rw.y), bflo(rw.z), bfhi(rw.z), bflo(rw.w), bfhi(rw.w)};
            float kx[8] = {bflo(kw.x), bfhi(kw.x), bflo(kw.y), bfhi(kw.y), bflo(kw.z), bfhi(kw.z), bflo(kw.w), bfhi(kw.w)};
            float wx[8] = {bflo(ww.x), bfhi(ww.x), bflo(ww.y), bfhi(ww.y), bflo(ww.z), bfhi(ww.z), bflo(ww.w), bfhi(ww.w)};
            float ax[8] = {bflo(aw.x), bfhi(aw.x), bflo(aw.y), bfhi(aw.y), bflo(aw.z), bfhi(aw.z), bflo(aw.w), bfhi(aw.w)};
            const float* pkk = IN(rw_kk) + h * HD + n8; const float* pka = IN(rw_ka) + h * HD + n8;
            float kk[8], kp[8], bb[8]; float ssq = 0.f;
#pragma unroll
            for (int e = 0; e < 8; ++e) { kk[e] = kx[e] * pkk[e]; ssq += kk[e] * kk[e]; kp[e] = kx[e] * (1.f + (ax[e] - 1.f) * pka[e]); }
            ssq = sum8(ssq); const float inv = 1.f / fmaxf(sqrtf(ssq), 1e-12f);
            { const float* prk = IN(rw_rk) + h * HD + n8; float bo = 0.f;
#pragma unroll
              for (int e = 0; e < 8; ++e) bo += rr[e] * kp[e] * prk[e];
              bo = sum8(bo); if ((tid & 7) == 0) bonus[(size_t)(bl * SEQ + ch * 64 + i) * NH + h] = bo; }
#pragma unroll
            for (int e = 0; e < 8; ++e) { kk[e] *= inv; bb[e] = kk[e] * ax[e]; }
            LAS float* CW = A4;
            *(LAS f32x4*)(CW + i * 64 + n8) = (f32x4){wx[0], wx[1], wx[2], wx[3]}; *(LAS f32x4*)(CW + i * 64 + n8 + 4) = (f32x4){wx[4], wx[5], wx[6], wx[7]};
            __syncthreads();
            { const int n = tid & 63, seg = tid >> 6; float acc = 0.f;
#pragma unroll
              for (int e = 0; e < 8; ++e) { acc += CW[(8 * seg + e) * 64 + n]; CW[(8 * seg + e) * 64 + n] = acc; }
              TOT[seg * 64 + n] = acc; }
            __syncthreads();
            float cw[8];
            { const f32x4 c0 = *(const LAS f32x4*)(CW + i * 64 + n8), c1 = *(const LAS f32x4*)(CW + i * 64 + n8 + 4);
              cw[0] = c0.x; cw[1] = c0.y; cw[2] = c0.z; cw[3] = c0.w; cw[4] = c1.x; cw[5] = c1.y; cw[6] = c1.z; cw[7] = c1.w;
              const int seg = i >> 3;
              for (int sp = 0; sp < seg; ++sp) { const f32x4 t0 = *(const LAS f32x4*)(TOT + sp * 64 + n8), t1 = *(const LAS f32x4*)(TOT + sp * 64 + n8 + 4);
                  cw[0] += t0.x; cw[1] += t0.y; cw[2] += t0.z; cw[3] += t0.w; cw[4] += t1.x; cw[5] += t1.y; cw[6] += t1.z; cw[7] += t1.w; } }
            float at[8], bt[8], kt[8], rt[8];
#pragma unroll
            for (int e = 0; e < 8; ++e) { const float ein = __expf(cw[e]), eex = __expf(cw[e] - wx[e]), eng = __expf(-cw[e]);
                at[e] = -kk[e] * eex; bt[e] = bb[e] * eng; kt[e] = kp[e] * eng; rt[e] = rr[e] * ein; if (i == 63) PL[n8 + e] = ein; }
            u32x4 w;
            w.x = cvt2bf(at[0], at[1]); w.y = cvt2bf(at[2], at[3]); w.z = cvt2bf(at[4], at[5]); w.w = cvt2bf(at[6], at[7]); *(LAS u32x4*)(I_A + i * P + n8 * 2) = w;
            w.x = cvt2bf(rt[0], rt[1]); w.y = cvt2bf(rt[2], rt[3]); w.z = cvt2bf(rt[4], rt[5]); w.w = cvt2bf(rt[6], rt[7]); *(LAS u32x4*)(I_R + i * P + n8 * 2) = w;
            u32x4 wb, wk;
            wb.x = cvt2bf(bt[0], bt[1]); wb.y = cvt2bf(bt[2], bt[3]); wb.z = cvt2bf(bt[4], bt[5]); wb.w = cvt2bf(bt[6], bt[7]); *(LAS u32x4*)(I_B + i * P + n8 * 2) = wb;
            wk.x = cvt2bf(kt[0], kt[1]); wk.y = cvt2bf(kt[2], kt[3]); wk.z = cvt2bf(kt[4], kt[5]); wk.w = cvt2bf(kt[6], kt[7]); *(LAS u32x4*)(I_K + i * P + n8 * 2) = wk;
            const unsigned tb[4] = {wb.x, wb.y, wb.z, wb.w}, tk[4] = {wk.x, wk.y, wk.z, wk.w}, tv[4] = {vw.x, vw.y, vw.z, vw.w};
#pragma unroll
            for (int e = 0; e < 8; ++e) { const int sh = (e & 1) * 16; const int ro = (n8 + e) * P + ((((i >> 3) ^ ((n8 >> 3) & 7)) << 4) | ((i & 7) * 2));
                *(LAS unsigned short*)(I_BT + ro) = (unsigned short)(tb[e >> 1] >> sh); *(LAS unsigned short*)(I_KT + ro) = (unsigned short)(tk[e >> 1] >> sh); *(LAS unsigned short*)(I_VT + ro) = (unsigned short)(tv[e >> 1] >> sh); }
        }
        __syncthreads();
        {
            const int lane = lane_id(), r = lane & 31, hh = lane >> 5;
            const int combo = c.wave >> 1, jt = c.wave & 1;
            const LAS unsigned char* Ximg = (combo & 1) ? I_K : I_B; const LAS unsigned char* Yimg = (combo >> 1) ? I_R : I_A;
            LAS unsigned char* Oimg = (combo == 1) ? I_AK : (combo == 2 ? I_RB : I_RK);
            const bool incl = combo >= 2;
#pragma unroll
            for (int tt = 0; tt < 2; ++tt) {
                f32x16 d;
#pragma unroll
                for (int e = 0; e < 16; ++e) d[e] = 0.f;
                if (tt >= jt) {
#pragma unroll
                    for (int s = 0; s < 4; ++s) d = __builtin_amdgcn_mfma_f32_32x32x16_bf16(frag144(Ximg, 32 * jt + r, s, hh), frag144(Yimg, 32 * tt + r, s, hh), d, 0, 0, 0);
                }
                const int t = 32 * tt + r;
#pragma unroll
                for (int e = 0; e < 16; ++e) { const int j = 32 * jt + (e & 3) + 8 * (e >> 2) + 4 * hh; const bool keep = incl ? (j <= t) : (j < t); d[e] = keep ? d[e] : 0.f; }
                if (combo == 0) {
#pragma unroll
                    for (int g = 0; g < 4; ++g) { u32x2 w; w.x = cvt2bf(d[4 * g], d[4 * g + 1]); w.y = cvt2bf(d[4 * g + 2], d[4 * g + 3]); *(LAS u32x2*)(I_AB + t * P + (32 * jt + 8 * g + 4 * hh) * 2) = w;
                        if ((2 * jt + (g >> 1)) == (t >> 4)) *(LAS f32x4*)(ADG + (t >> 4) * 256 + (t & 15) * 16 + ((8 * g + 4 * hh) & 15)) = (f32x4){d[4 * g], d[4 * g + 1], d[4 * g + 2], d[4 * g + 3]}; }
                } else {
#pragma unroll
                    for (int g = 0; g < 4; ++g) { u32x2 w; w.x = cvt2bf(d[4 * g], d[4 * g + 1]); w.y = cvt2bf(d[4 * g + 2], d[4 * g + 3]); *(LAS u32x2*)(Oimg + t * P + (32 * jt + 8 * g + 4 * hh) * 2) = w; }
                }
            }
        }
        __syncthreads();
        { const int tz = c.wave * 64 + lane_id(); for (int o = tz * 16; o < 128 * P; o += 512 * 16) *(LAS u32x4*)(I_XT + o) = (u32x4){0u, 0u, 0u, 0u}; }
        if (c.wave == 4) s1_tinv(ADG, TB);
        if (c.wave < 4) {
            const int lane = lane_id(), r = lane & 31, hh = lane >> 5;
            const int vt = c.wave >> 1, tt = c.wave & 1;
            f32x16 d;
#pragma unroll
            for (int e = 0; e < 16; ++e) d[e] = 0.f;
#pragma unroll
            for (int s = 0; s < 4; ++s) d = __builtin_amdgcn_mfma_f32_32x32x16_bf16(frag144s(I_VT, 32 * vt + r, s, hh), frag144(I_AK, 32 * tt + r, s, hh), d, 0, 0, 0);
            const int t = 32 * tt + r;
#pragma unroll
            for (int g = 0; g < 4; ++g) *(LAS f32x4*)(RZ + t * 68 + 32 * vt + 8 * g + 4 * hh) = (f32x4){d[4 * g], d[4 * g + 1], d[4 * g + 2], d[4 * g + 3]};
        }
        __syncthreads();
        if (u + c.G < BG * NH * (SEQ / 64)) { const int tid = c.wave * 64 + lane_id(); S1_LOAD(u + c.G); }
        s1_solve(c, I_A, I_AB, TB, RZ, AT, I_XT);
        __syncthreads();
        {
            const int lane = lane_id(), r = lane & 31, hh = lane >> 5;
            const int rt = (c.wave >> 1) & 1, ct = c.wave & 1; const bool mhi = c.wave >= 4;
            int u2 = u; asm volatile("" : "+s"(u2));
            const size_t ub = (size_t)u2 * 4096;
#pragma unroll
            for (int it = 0; it < 2; ++it) {
                const int mat = it == 0 ? (mhi ? 3 : 1) : (mhi ? 2 : 0);
                f32x16 d;
                const int cl = 32 * ct + r;
                if (mat == 0) {
#pragma unroll
                    for (int g = 0; g < 4; ++g) { const f32x4 v = unpack4(*(const LAS u32x2*)(I_R + cl * P + (32 * rt + 8 * g + 4 * hh) * 2)); d[4 * g] = v.x; d[4 * g + 1] = v.y; d[4 * g + 2] = v.z; d[4 * g + 3] = v.w; }
#pragma unroll
                    for (int s = 0; s < 4; ++s) d = __builtin_amdgcn_mfma_f32_32x32x16_bf16(frag144(I_XT, 32 * rt + r, s, hh), frag144(I_RB, cl, s, hh), d, 0, 0, 0);
                } else {
#pragma unroll
                    for (int e = 0; e < 16; ++e) d[e] = 0.f;
                    if (mat == 1) {
#pragma unroll
                        for (int s = 0; s < 4; ++s) d = __builtin_amdgcn_mfma_f32_32x32x16_bf16(frag144(I_XT, 64 + 32 * rt + r, s, hh), frag144(I_RB, cl, s, hh), d, 0, 0, 0);
#pragma unroll
                        for (int s = 0; s < 4; ++s) d = __builtin_amdgcn_mfma_f32_32x32x16_bf16(frag144s(I_VT, 32 * rt + r, s, hh), frag144(I_RK, cl, s, hh), d, 0, 0, 0);
                    } else if (mat == 2) {
#pragma unroll
                        for (int s = 0; s < 4; ++s) d = __builtin_amdgcn_mfma_f32_32x32x16_bf16(frag144(I_XT, 32 * rt + r, s, hh), frag144s(I_BT, cl, s, hh), d, 0, 0, 0);
                        const float pl = PL[cl];
#pragma unroll
                        for (int e = 0; e < 16; ++e) { const int k = 32 * rt + (e & 3) + 8 * (e >> 2) + 4 * hh; d[e] = (d[e] + (k == cl ? 1.f : 0.f)) * pl; }
                    } else {
#pragma unroll
                        for (int s = 0; s < 4; ++s) d = __builtin_amdgcn_mfma_f32_32x32x16_bf16(frag144s(I_BT, 32 * rt + r, s, hh), frag144(I_XT, 64 + cl, s, hh), d, 0, 0, 0);
#pragma unroll
                        for (int s = 0; s < 4; ++s) d = __builtin_amdgcn_mfma_f32_32x32x16_bf16(frag144s(I_KT, 32 * rt + r, s, hh), frag144s(I_VT, cl, s, hh), d, 0, 0, 0);
#pragma unroll
                        for (int g = 0; g < 4; ++g) { const f32x4 pl = *(const LAS f32x4*)(PL + 32 * rt + 8 * g + 4 * hh); d[4 * g] *= pl.x; d[4 * g + 1] *= pl.y; d[4 * g + 2] *= pl.z; d[4 * g + 3] *= pl.w; }
                    }
                }
                bf16_t* ob = (mat == 0 ? RH : mat == 1 ? YL : mat == 2 ? MM : NT) + ub + (size_t)cl * 64 + 32 * rt + 4 * hh;
#pragma unroll
                for (int g = 0; g < 4; g += 2) { u32x2 w0, w1; w0.x = cvt2bf(d[4 * g], d[4 * g + 1]); w0.y = cvt2bf(d[4 * g + 2], d[4 * g + 3]); w1.x = cvt2bf(d[4 * g + 4], d[4 * g + 5]); w1.y = cvt2bf(d[4 * g + 6], d[4 * g + 7]);
                    store_pair16(ob + 8 * g, hh, w0, w1); }
            }
        }
    }
}
__device__ __forceinline__ bf16x8 ldfrag8(const bf16_t* p) { const u32x2 lo = *(const u32x2*)p, hi = *(const u32x2*)(p + 8); u32x4 v; v.x = lo.x; v.y = lo.y; v.z = hi.x; v.w = hi.y; return __builtin_bit_cast(bf16x8, v); }
__device__ __forceinline__ bf16x8 packacc(const f32x16& x, int s) { u32x4 w; w.x = cvt2bf(x[8 * s], x[8 * s + 1]); w.y = cvt2bf(x[8 * s + 2], x[8 * s + 3]); w.z = cvt2bf(x[8 * s + 4], x[8 * s + 5]); w.w = cvt2bf(x[8 * s + 6], x[8 * s + 7]); return __builtin_bit_cast(bf16x8, w); }
__device__ __forceinline__ int s2_off(int row, int chunk, int sub) { return row * 128 + ((chunk ^ ((row ^ (row >> 3)) & 7)) << 4) + sub; }
__device__ __forceinline__ bf16x8 s2_frag(const LAS unsigned char* mat, int row, int ch, int hh) {
    const u32x2 lo = *(const LAS u32x2*)(mat + s2_off(row, ch, 8 * hh)), hi = *(const LAS u32x2*)(mat + s2_off(row, ch + 1, 8 * hh)); u32x4 v; v.x = lo.x; v.y = lo.y; v.z = hi.x; v.w = hi.y; return __builtin_bit_cast(bf16x8, v); }
__device__ __forceinline__ void p_scan_s2(const Ctx& c, const InL& in, const bf16_t* RH, const bf16_t* YL, const bf16_t* MM, const bf16_t* NT, const float* bonus, const bf16_t* Vb, const bf16_t* Gt, bf16_t* Z, LAS unsigned char* lds) {
    PHASE_IDS;
    constexpr int NCH = SEQ / 64, SLOT = 32768;
    for (int bh = c.bid; bh < BG * NH; bh += c.G) {
        const int bl = bh / NH, h = bh % NH;
        __syncthreads();
#define S2_ISSUE(ch) do { int ln_ = lane; asm volatile("" : "+v"(ln_)); const size_t ub_ = ((size_t)bh * NCH + (ch)) * 4096; LAS unsigned char* sl_ = lds + ((ch) & 3) * SLOT; \
        _Pragma("unroll") for (int j_ = 0; j_ < 8; ++j_) { const int d_ = ((c.wave - 4) * 8 + j_) * 64 + ln_, q_ = d_ >> 9, row_ = (d_ >> 3) & 63, cp_ = d_ & 7; \
            const bf16_t* src_ = (q_ == 0 ? RH : q_ == 1 ? YL : q_ == 2 ? MM : NT) + ub_ + row_ * 64 + ((cp_ ^ ((row_ ^ (row_ >> 3)) & 7)) << 3); \
            __builtin_amdgcn_global_load_lds((const unsigned*)src_, (LAS unsigned*)(sl_ + ((c.wave - 4) * 8 + j_) * 1024), 16, 0, 0); } } while (0)
        if (c.wave >= 4) { S2_ISSUE(0); S2_ISSUE(1); S2_ISSUE(2); asm volatile("s_waitcnt vmcnt(16)" ::: "memory"); }
        __syncthreads();
        f32x4 plw = {0.f, 0.f, 0.f, 0.f}, plb = {0.f, 0.f, 0.f, 0.f};
        if (c.wave == 2 || c.wave == 3) { int lp = lane; asm volatile("" : "+v"(lp)); plw = *(const f32x4*)(IN(rw_lnx_w) + h * HD + (lp & 15) * 4); plb = *(const f32x4*)(IN(rw_lnx_b) + h * HD + (lp & 15) * 4);
            asm volatile("" : "+v"(plw), "+v"(plb)); }
        f32x16 H0, H1;
#pragma unroll
        for (int e = 0; e < 16; ++e) { H0[e] = 0.f; H1[e] = 0.f; }
#pragma unroll 1
        for (int ch = 0; ch <= NCH; ++ch) {
            if (c.wave >= 4) {
                if (ch < NCH) {
                if (ch + 3 < NCH) S2_ISSUE(ch + 3);
                const int pend = (ch + 3 < NCH ? ch + 3 : NCH - 1) - (ch + 1);
                if (pend >= 2) asm volatile("s_waitcnt vmcnt(16)" ::: "memory"); else if (pend == 1) asm volatile("s_waitcnt vmcnt(8)" ::: "memory"); else asm volatile("s_waitcnt vmcnt(0)" ::: "memory");
                }
            } else if (c.wave >= 2) {
                if (ch >= 1) {
                    int lp = lane; asm volatile("" : "+v"(lp));
                    const LAS unsigned char* yb = lds + LDS_YB + ((ch + 1) & 1) * (64 * 136) + (32 * (c.wave - 2) + (lp >> 4)) * 136 + (lp & 15) * 8;
                    const size_t rowp = (size_t)bl * SEQ + (ch - 1) * 64 + 32 * (c.wave - 2) + (lp >> 4), offp = rowp * DM + h * HD + (lp & 15) * 4;
                    u32x2 pv[8], pg[8], yw[8]; float pb[8]; f32x4 tn[8];
#pragma unroll
                    for (int q = 0; q < 8; ++q) { pv[q] = *(const u32x2*)(Vb + offp + (size_t)4 * q * DM); pg[q] = *(const u32x2*)(Gt + offp + (size_t)4 * q * DM); pb[q] = bonus[(rowp + 4 * q) * NH + h]; }
                    asm volatile("ds_read_b64 %0, %8\n\tds_read_b64 %1, %8 offset:544\n\tds_read_b64 %2, %8 offset:1088\n\tds_read_b64 %3, %8 offset:1632\n\tds_read_b64 %4, %8 offset:2176\n\tds_read_b64 %5, %8 offset:2720\n\t"
                                 "ds_read_b64 %6, %8 offset:3264\n\tds_read_b64 %7, %8 offset:3808\n\ts_waitcnt lgkmcnt(0)"
                                 : "=&v"(yw[0]), "=&v"(yw[1]), "=&v"(yw[2]), "=&v"(yw[3]), "=&v"(yw[4]), "=&v"(yw[5]), "=&v"(yw[6]), "=&v"(yw[7]) : "v"((unsigned)(size_t)yb) : "memory");
#pragma unroll
                    for (int q = 0; q < 8; ++q) {
                        const f32x4 y4 = unpack4(yw[q]);
                        const float mu = sum16((y4.x + y4.y) + (y4.z + y4.w)) * (1.f / 64.f);
                        const f32x4 dy = y4 - mu; const float var = sum16((dy.x * dy.x + dy.y * dy.y) + (dy.z * dy.z + dy.w * dy.w)) * (1.f / 64.f);
                        tn[q] = dy * rsqrtf(var + GN_EPS) * plw + plb;
                    }
                    asm volatile("" : "+v"(tn[0]), "+v"(tn[1]), "+v"(tn[2]), "+v"(tn[3]), "+v"(tn[4]), "+v"(tn[5]), "+v"(tn[6]), "+v"(tn[7]) :: "memory");
                    asm volatile("" : "+v"(pv[0]), "+v"(pv[1]), "+v"(pv[2]), "+v"(pv[3]), "+v"(pv[4]), "+v"(pv[5]), "+v"(pv[6]), "+v"(pv[7]), "+v"(pg[0]), "+v"(pg[1]), "+v"(pg[2]), "+v"(pg[3]), "+v"(pg[4]), "+v"(pg[5]), "+v"(pg[6]), "+v"(pg[7]),
                                 "+v"(pb[0]), "+v"(pb[1]), "+v"(pb[2]), "+v"(pb[3]), "+v"(pb[4]), "+v"(pb[5]), "+v"(pb[6]), "+v"(pb[7]) :: "memory");
                    bf16_t* zo = Z + offp;
#pragma unroll
                    for (int q = 0; q < 8; ++q) { const f32x4 z = (tn[q] + pb[q] * unpack4(pv[q])) * unpack4(pg[q]); *(u32x2*)(zo + (size_t)4 * q * DM) = pack4(z); }
                }
            } else if (ch < NCH) {
                int lo_ = lane; asm volatile("" : "+v"(lo_)); const int r = lo_ & 31, hh = lo_ >> 5, vt = c.wave;
                const LAS unsigned char* sl = lds + (ch & 3) * SLOT; const LAS unsigned char* rh = sl; const LAS unsigned char* yl = sl + 8192; const LAS unsigned char* mm = sl + 16384; const LAS unsigned char* nt = sl + 24576;
                bf16x8 hp[2][2];
#pragma unroll
                for (int s = 0; s < 2; ++s) { hp[0][s] = packacc(H0, s); hp[1][s] = packacc(H1, s); }
#pragma unroll
                for (int tt = 0; tt < 2; ++tt) {
                    f32x16 a; const int t = 32 * tt + r;
#pragma unroll
                    for (int g = 0; g < 4; ++g) { const f32x4 v = unpack4(*(const LAS u32x2*)(yl + s2_off(t, 4 * vt + g, 8 * hh))); a[4 * g] = v.x; a[4 * g + 1] = v.y; a[4 * g + 2] = v.z; a[4 * g + 3] = v.w; }
#pragma unroll
                    for (int kt = 0; kt < 2; ++kt)
#pragma unroll
                        for (int s = 0; s < 2; ++s) a = __builtin_amdgcn_mfma_f32_32x32x16_bf16(hp[kt][s], s2_frag(rh, t, 4 * kt + 2 * s, hh), a, 0, 0, 0);
                    LAS unsigned char* yo = lds + LDS_YB + (ch & 1) * (64 * 136) + t * 136 + (32 * vt + 4 * hh) * 2;
#pragma unroll
                    for (int g = 0; g < 4; ++g) { u32x2 w; w.x = cvt2bf(a[4 * g], a[4 * g + 1]); w.y = cvt2bf(a[4 * g + 2], a[4 * g + 3]); *(LAS u32x2*)(yo + 16 * g) = w; }
                }
                f32x16 n0, n1;
#pragma unroll
                for (int kq = 0; kq < 2; ++kq) {
                    f32x16 a; const int v = 32 * vt + r;
#pragma unroll
                    for (int g = 0; g < 4; ++g) { const f32x4 x = unpack4(*(const LAS u32x2*)(nt + s2_off(v, 4 * kq + g, 8 * hh))); a[4 * g] = x.x; a[4 * g + 1] = x.y; a[4 * g + 2] = x.z; a[4 * g + 3] = x.w; }
#pragma unroll
                    for (int kt = 0; kt < 2; ++kt)
#pragma unroll
                        for (int s = 0; s < 2; ++s) a = __builtin_amdgcn_mfma_f32_32x32x16_bf16(s2_frag(mm, 32 * kq + r, 4 * kt + 2 * s, hh), hp[kt][s], a, 0, 0, 0);
                    if (kq == 0) n0 = a; else n1 = a;
                }
                H0 = n0; H1 = n1;
            }
            asm volatile("s_waitcnt lgkmcnt(0)" ::: "memory"); __builtin_amdgcn_s_barrier(); asm volatile("" ::: "memory");
        }
#undef S2_ISSUE
    }
}
__device__ __forceinline__ void p_scan_post(const Ctx& c, const InL& in, const bf16_t* Yb, const float* bonus, const bf16_t* Vb, const bf16_t* Gt, bf16_t* Z) {
    PHASE_IDS;
    const int gt = c.bid * 512 + tid, NT_ = c.G * 512;
    const int col = (gt & 255) * 4;
    const f32x4 lw = *(const f32x4*)(IN(rw_lnx_w) + col), lb = *(const f32x4*)(IN(rw_lnx_b) + col);
    for (int it = gt; it < TG * 256; it += 4 * NT_) {
        u32x2 yw[4], vw[4], gw[4]; float bo[4];
#pragma unroll
        for (int q = 0; q < 4; ++q) { const int row = (it + q * NT_) >> 8; const size_t off = (size_t)row * DM + col;
            yw[q] = *(const u32x2*)(Yb + off); vw[q] = *(const u32x2*)(Vb + off); gw[q] = *(const u32x2*)(Gt + off); bo[q] = bonus[(size_t)row * NH + (col >> 6)]; }
#pragma unroll
        for (int q = 0; q < 4; ++q) { const int row = (it + q * NT_) >> 8; const size_t off = (size_t)row * DM + col;
            const f32x4 y4 = unpack4(yw[q]), v4 = unpack4(vw[q]), g4 = unpack4(gw[q]);
            const float mu = sum16((y4.x + y4.y) + (y4.z + y4.w)) * (1.f / 64.f);
            const f32x4 dy = y4 - mu; const float var = sum16((dy.x * dy.x + dy.y * dy.y) + (dy.z * dy.z + dy.w * dy.w)) * (1.f / 64.f);
            const f32x4 z = (dy * rsqrtf(var + GN_EPS) * lw + lb + bo[q] * v4) * g4;
            *(u32x2*)(Z + off) = pack4(z); }
    }
}

template <class Sched> __device__ __forceinline__ void p_select(const Ctx& c, const Sched& S, const float* logit, const float* bg, const float* be, unsigned* gcnt, int* tok_e, int* tok_p, float* tok_w, int* rowtab, LAS unsigned char* lds) {
    PHASE_IDS;
    for (int i = c.bid * 512 + tid; i < MAXSLOT; i += c.G * 512) { rowtab[i] = 0; rowtab[STAB_OFF + i] = -1; }
    LAS int* lcnt = (LAS int*)(lds + LDS_HIST); LAS int* lbase = lcnt + NB;
    for (int it = 0; ; ++it) {
        pg8::Unit su; if (!S.next(it, su)) break; const int tb = su.pm * 256;
        if (tid < NB) lcnt[tid] = 0;
        __syncthreads();
        const bool act_ = tid < 256; const int t = tb + (act_ ? tid : 0); const f32x4* lr = (const f32x4*)(logit + (size_t)t * 64);
        const f32x4 gl = lr[0] + *(const f32x4*)bg;
        int grp = 0; float gm = gl.x; if (gl.y > gm) { gm = gl.y; grp = 1; } if (gl.z > gm) { gm = gl.z; grp = 2; } if (gl.w > gm) { gm = gl.w; grp = 3; }
        const float pg = 1.f / ((__expf(gl.x - gm) + __expf(gl.y - gm)) + (__expf(gl.z - gm) + __expf(gl.w - gm)));
        const float* er = logit + (size_t)t * 64 + 4 + 8 * grp; const float* eb = be + 8 * grp;
        float ev[8];
#pragma unroll
        for (int e = 0; e < 8; ++e) ev[e] = er[e] + eb[e];
        int i0 = 0; float m0 = ev[0];
#pragma unroll
        for (int e = 1; e < 8; ++e) if (ev[e] > m0) { m0 = ev[e]; i0 = e; }
        int i1 = -1; float m1 = -3.0e38f;
#pragma unroll
        for (int e = 0; e < 8; ++e) if (e != i0 && ev[e] > m1) { m1 = ev[e]; i1 = e; }
        const float e1 = __expf(m1 - m0), w0 = pg / (1.f + e1), w1 = pg * e1 / (1.f + e1);
        const int ea = grp * 8 + i0, eb2 = NE + grp * 8 + i1;
        int la = 0, lb = 0; if (act_) { la = atomicAdd((int*)&lcnt[ea], 1); lb = atomicAdd((int*)&lcnt[eb2], 1); }
        __syncthreads();
        if (tid < NB) lbase[tid] = (int)atomicAdd(&gcnt[tid], (unsigned)lcnt[tid]);
        __syncthreads();
        if (act_) { tok_e[2 * t] = ea; tok_e[2 * t + 1] = eb2; tok_p[2 * t] = lbase[ea] + la; tok_p[2 * t + 1] = lbase[eb2] + lb; tok_w[2 * t] = w0; tok_w[2 * t + 1] = w1; }
        __syncthreads();
    }
}
__device__ __forceinline__ void moe_table(const Ctx& c, unsigned* gcnt, LAS unsigned char* lds) {
    PHASE_IDS;
    LAS int* toff = (LAS int*)(lds + LDS_TOFF);
    LAS int* tmp = (LAS int*)(lds + LDS_HIST);
    __syncthreads();
    if (tid < NB) tmp[tid] = ((int)__hip_atomic_load(gcnt + tid, RLX_AGENT) + 255) >> 8;
    __syncthreads();
    if (tid == 0) { int o = 0; for (int e = 0; e < NB; ++e) { toff[e] = o; o += tmp[e]; } toff[NB] = o; }
    __syncthreads();
    { LAS unsigned char* texp = (LAS unsigned char*)(lds + LDS_TEXP); const int ntile = toff[NB];
      for (int m = tid; m < ntile; m += 512) { int e = 0; for (int k = 1; k < NB; ++k) if (toff[k] <= m) e = k; texp[m] = (unsigned char)(e & (NE - 1)); } }
    __syncthreads();
}
__device__ __forceinline__ void p_gather(const Ctx& c, const float* ssq, const int* tok_e, const int* tok_p, const float* tok_w, int* tok_s, float* gate, int* rowtab, LAS unsigned char* lds) {
    PHASE_IDS;
    const LAS int* toff = (const LAS int*)(lds + LDS_TOFF);
    for (int i = c.bid * 512 + tid; i < 2 * T; i += c.G * 512) {
        const int slot = toff[tok_e[i]] * 256 + tok_p[i];
        tok_s[i] = slot; rowtab[slot] = i >> 1; rowtab[STAB_OFF + slot] = i >> 1; { const float rs_ = pg8::rstd16(ssq, i >> 1); gate[2 * slot] = rs_; gate[2 * slot + 1] = tok_w[i] * rs_; }
    }
}
struct OrderMoE {
    const LAS int* toff; int G, c, npn; long sA, sBe, sBn; int mlo, mhi;
    __device__ __forceinline__ bool next(int i, pg8::Unit& u) const {
        const int cv = (G % 8 == 0) ? (c % 8) * (G / 8) + c / 8 : c;
        const int L = i * G + cv, m = mlo + L / npn; if (m >= mhi) return false;
        const int e = __builtin_amdgcn_readfirstlane((int)((const LAS unsigned char*)toff)[(LDS_TEXP - LDS_TOFF) + m]);
        u.pm = m; u.pn = L % npn; u.offA = m * sA; u.offB = e * sBe + u.pn * sBn; return true;
    }
};
template <bool FINAL> __device__ __forceinline__ void p_combine(const Ctx& c, bf16_t* h, float* outf, const bf16_t* Y, const int* tok_s, const float* gain, bf16_t* o) {
    PHASE_IDS;
    const int NGW = c.G * 8;
    for (int m0 = c.bid * 8 + c.wave; m0 < T; m0 += 4 * NGW) {
        int s0[4], s1[4];
#pragma unroll
        for (int q = 0; q < 4; ++q) { const int m = m0 + q * NGW; s0[q] = tok_s[2 * m]; s1[q] = tok_s[2 * m + 1]; }
        u32x2 rh[4][4], ya[4][4], yb[4][4];
#pragma unroll
        for (int q = 0; q < 4; ++q) { const int m = m0 + q * NGW; const u32x2* hp = (const u32x2*)(h + (size_t)m * DM) + lane; const u32x2* y0 = (const u32x2*)(Y + (size_t)s0[q] * DM) + lane; const u32x2* y1 = (const u32x2*)(Y + (size_t)s1[q] * DM) + lane;
#pragma unroll
            for (int j = 0; j < 4; ++j) { rh[q][j] = hp[64 * j]; ya[q][j] = y0[64 * j]; yb[q][j] = y1[64 * j]; } }
#pragma unroll
        for (int q = 0; q < 4; ++q) { const int m = m0 + q * NGW; f32x4 v[4]; float ss = 0.f;
#pragma unroll
            for (int j = 0; j < 4; ++j) { v[j] = unpack4(rh[q][j]) + unpack4(ya[q][j]) + unpack4(yb[q][j]); ss += (v[j].x * v[j].x + v[j].y * v[j].y) + (v[j].z * v[j].z + v[j].w * v[j].w); }
            const float rs = rsqrtf(wave_sum(ss) * (1.f / DM) + NORM_EPS);
#pragma unroll
            for (int j = 0; j < 4; ++j) { const f32x4 g = ((const f32x4*)gain)[lane + 64 * j];
                if (FINAL) ((f32x4*)(outf + (size_t)m * DM))[lane + 64 * j] = v[j] * rs * g;
                else { ((u32x2*)(h + (size_t)m * DM))[lane + 64 * j] = pack4(v[j]); ((u32x2*)(o + (size_t)m * DM))[lane + 64 * j] = pack4(v[j] * rs * g); } } }
    }
}
__device__ __forceinline__ void p_final(const Ctx& c, const bf16_t* h, const float* ssq, const float* gain, float* outf) {
    PHASE_IDS;
    const int NGW = c.G * 8;
    f32x4 g[4];
#pragma unroll
    for (int j = 0; j < 4; ++j) g[j] = ((const f32x4*)gain)[lane + 64 * j];
    for (int m0 = c.bid * 8 + c.wave; m0 < T; m0 += 4 * NGW) {
        u32x2 rh[4][4]; float rs[4];
#pragma unroll
        for (int q = 0; q < 4; ++q) { const int m = m0 + q * NGW; const u32x2* hp = (const u32x2*)(h + (size_t)m * DM) + lane; rs[q] = pg8::rstd16(ssq, m);
#pragma unroll
            for (int j = 0; j < 4; ++j) rh[q][j] = hp[64 * j]; }
#pragma unroll
        for (int q = 0; q < 4; ++q) { const int m = m0 + q * NGW;
#pragma unroll
            for (int j = 0; j < 4; ++j) __builtin_nontemporal_store(unpack4(rh[q][j]) * rs[q] * g[j], (f32x4*)(outf + (size_t)m * DM) + lane + 64 * j); }
    }
}
constexpr float STICK_EXIT = 30.f * 1.4426950408889634f;
__device__ __forceinline__ void p_stick2(const Ctx& c, const bf16_t* Q, const bf16_t* Kb, const bf16_t* Vb, bf16_t* O, unsigned* queue, LAS unsigned char* lds) {
    PHASE_IDS;
    const int r = lane & 31, hh = lane >> 5;
    LAS unsigned char* Kw = lds + c.wave * 9216; LAS unsigned char* Vt = Kw + 4608;
    f16x8 Lf[2];
#pragma unroll
    for (int s = 0; s < 2; ++s)
#pragma unroll
        for (int j = 0; j < 8; ++j) Lf[s][j] = (16 * s + 8 * (j >> 2) + 4 * hh + (j & 3) >= r) ? (_Float16)1.0f : (_Float16)0.0f;
    constexpr int NUNIT = BATCH * NH * (SEQ / 32), QLEN = NUNIT / 8, QBATCH = 4;
    int qi = c.bid & 7, qtries = 0, ubase = 0, uleft = 0;
    for (;;) {
        if (uleft == 0) {
            unsigned got = 0u; bool ok = false;
            while (qtries < 8) {
                if (lane == 0) got = __hip_atomic_fetch_add(queue + 64 * qi, (unsigned)QBATCH, RLX_AGENT);
                got = (unsigned)__builtin_amdgcn_readfirstlane((int)got);
                if (got < (unsigned)QLEN) { ok = true; break; }
                qi = (qi + 1) & 7; ++qtries;
            }
            if (!ok) break;
            ubase = qi * QLEN + (int)got; uleft = QBATCH;
        }
        const int u = ubase; ++ubase; --uleft;
        const int qb = u % (SEQ / 32), h = (u / (SEQ / 32)) % NH, b = u / ((SEQ / 32) * NH);
        const size_t rowbase = (size_t)b * SEQ; const int q0 = qb * 32;
        bf16x8 qf[4];
#pragma unroll
        for (int s = 0; s < 4; ++s) qf[s] = *(const bf16x8*)(Q + (rowbase + q0 + r) * DM + h * HD + 16 * s + 8 * hh);
        float carry = 0.f; f32x16 o0, o1;
#pragma unroll
        for (int i = 0; i < 16; ++i) { o0[i] = 0.f; o1[i] = 0.f; }
        u32x4 nk[4], nv[4];
#define STICK_LOAD(jt_) do { _Pragma("unroll") for (int i_ = 0; i_ < 4; ++i_) { const int chunk_ = lane + 64 * i_; const size_t g_ = (rowbase + (jt_) * 32 + (chunk_ >> 3)) * DM + h * HD + (chunk_ & 7) * 8; \
            nk[i_] = *(const u32x4*)(Kb + g_); nv[i_] = *(const u32x4*)(Vb + g_); } } while (0)
        STICK_LOAD(qb);
        for (int jt = qb; jt >= 0; --jt) {
#pragma unroll
            for (int i = 0; i < 4; ++i) { const int chunk = lane + 64 * i, row = chunk >> 3, cc = chunk & 7;
                const u32x4 kv = nk[i], vv = nv[i];
                *(LAS u32x4*)(Kw + row * 144 + cc * 16) = kv;
                const unsigned px = (unsigned)__builtin_amdgcn_update_dpp(0, (int)vv.x, 0x128, 0xF, 0xF, true), py = (unsigned)__builtin_amdgcn_update_dpp(0, (int)vv.y, 0x128, 0xF, 0xF, true);
                const unsigned pz = (unsigned)__builtin_amdgcn_update_dpp(0, (int)vv.z, 0x128, 0xF, 0xF, true), pw = (unsigned)__builtin_amdgcn_update_dpp(0, (int)vv.w, 0x128, 0xF, 0xF, true);
                const bool odd = (row & 1) != 0; const unsigned a0 = odd ? pz : vv.x, a1 = odd ? pw : vv.y, b0 = odd ? vv.z : px, b1 = odd ? vv.w : py;
                LAS unsigned* vt = (LAS unsigned*)(Vt + (cc * 8 + (odd ? 4 : 0)) * 72 + (row & ~1) * 2);
                vt[0 * 18] = (a0 & 0xffffu) | (b0 << 16); vt[1 * 18] = (a0 >> 16) | (b0 & 0xffff0000u); vt[2 * 18] = (a1 & 0xffffu) | (b1 << 16); vt[3 * 18] = (a1 >> 16) | (b1 & 0xffff0000u); }
            if (jt > 0) STICK_LOAD(jt - 1);
            f32x16 p;
#pragma unroll
            for (int i = 0; i < 16; ++i) p[i] = 0.f;
#pragma unroll
            for (int s = 0; s < 4; ++s) { const bf16x8 kf = *(const LAS bf16x8*)(Kw + r * 144 + s * 32 + hh * 16); p = __builtin_amdgcn_mfma_f32_32x32x16_bf16(kf, qf[s], p, 0, 0, 0); }
            const bool diag = (jt == qb);
            float sp[16]; f32x16 cum;
#pragma unroll
            for (int i = 0; i < 16; ++i) { const int kr = (i & 3) + 8 * (i >> 2) + 4 * hh; const bool valid = !diag || (kr < r); const float z = p[i];
                sp[i] = valid ? (fmaxf(z, 0.f) + __builtin_amdgcn_logf(1.f + __builtin_amdgcn_exp2f(-fabsf(z)))) : 0.f; cum[i] = carry; }
#pragma unroll
            for (int s = 0; s < 2; ++s) { u32x4 w; w.x = cvt2h(sp[8 * s], sp[8 * s + 1]); w.y = cvt2h(sp[8 * s + 2], sp[8 * s + 3]); w.z = cvt2h(sp[8 * s + 4], sp[8 * s + 5]); w.w = cvt2h(sp[8 * s + 6], sp[8 * s + 7]);
                cum = __builtin_amdgcn_mfma_f32_32x32x16_f16(Lf[s], __builtin_bit_cast(f16x8, w), cum, 0, 0, 0); }
            float att[16];
#pragma unroll
            for (int i = 0; i < 16; ++i) { const int kr = (i & 3) + 8 * (i >> 2) + 4 * hh; const bool valid = !diag || (kr < r); att[i] = valid ? __builtin_amdgcn_exp2f(p[i] - cum[i]) : 0.f; }
            { const unsigned cu_ = __float_as_uint(cum[0]); carry = __uint_as_float(__builtin_amdgcn_permlane32_swap(cu_, cu_, false, false)[0]); }
#pragma unroll
            for (int s = 0; s < 2; ++s) { u32x4 w; w.x = cvt2bf(att[8 * s], att[8 * s + 1]); w.y = cvt2bf(att[8 * s + 2], att[8 * s + 3]); w.z = cvt2bf(att[8 * s + 4], att[8 * s + 5]); w.w = cvt2bf(att[8 * s + 6], att[8 * s + 7]);
                const bf16x8 af = __builtin_bit_cast(bf16x8, w);
                { const u32x2 lo = *(const LAS u32x2*)(Vt + r * 72 + (16 * s + 4 * hh) * 2), hi = *(const LAS u32x2*)(Vt + r * 72 + (16 * s + 8 + 4 * hh) * 2);
                  u32x4 v; v.x = lo.x; v.y = lo.y; v.z = hi.x; v.w = hi.y; o0 = __builtin_amdgcn_mfma_f32_32x32x16_bf16(__builtin_bit_cast(bf16x8, v), af, o0, 0, 0, 0); }
                { const u32x2 lo = *(const LAS u32x2*)(Vt + (32 + r) * 72 + (16 * s + 4 * hh) * 2), hi = *(const LAS u32x2*)(Vt + (32 + r) * 72 + (16 * s + 8 + 4 * hh) * 2);
                  u32x4 v; v.x = lo.x; v.y = lo.y; v.z = hi.x; v.w = hi.y; o1 = __builtin_amdgcn_mfma_f32_32x32x16_bf16(__builtin_bit_cast(bf16x8, v), af, o1, 0, 0, 0); } }
            if (__all(carry > STICK_EXIT)) break;
        }
#undef STICK_LOAD
        bf16_t* orow = O + (rowbase + q0 + r) * DM + h * HD + 4 * hh;
#pragma unroll
        for (int g = 0; g < 4; g += 2) { u32x2 w0, w1, x0, x1;
            w0.x = cvt2bf(o0[4 * g], o0[4 * g + 1]); w0.y = cvt2bf(o0[4 * g + 2], o0[4 * g + 3]); w1.x = cvt2bf(o0[4 * g + 4], o0[4 * g + 5]); w1.y = cvt2bf(o0[4 * g + 6], o0[4 * g + 7]);
            x0.x = cvt2bf(o1[4 * g], o1[4 * g + 1]); x0.y = cvt2bf(o1[4 * g + 2], o1[4 * g + 3]); x1.x = cvt2bf(o1[4 * g + 4], o1[4 * g + 5]); x1.y = cvt2bf(o1[4 * g + 6], o1[4 * g + 7]);
            store_pair16(orow + 8 * g, hh, w0, w1); store_pair16(orow + 32 + 8 * g, hh, x0, x1); }
    }
}

struct OrderPre {
    int G, c; bool vo;
    __device__ __forceinline__ bool next(int i, pg8::Unit& u) const {
        const int cv = (G % 8 == 0) ? (c % 8) * (G / 8) + c / 8 : c;
        const int L = i * G + cv; if (L >= BATCH * 16) return false;
        const int b = L / 16, s1 = (L / 4) % 4, s0 = L % 4;
        const long om = ((long)b * NMEM * DM + (vo ? s0 : s1) * XD) * 2, ow = ((long)(vo ? s1 : s0) * 256 * DM + (vo ? s0 : s1) * XD) * 2;
        u.pm = b * 4 + s1; u.pn = s0; u.offA = vo ? ow : om; u.offB = vo ? om : ow; return true;
    }
};
struct OrderXS {
    int G, c;
    __device__ __forceinline__ bool next(int i, pg8::Unit& u) const {
        const int cv = (G % 8 == 0) ? (c % 8) * (G / 8) + c / 8 : c;
        const int L = i * G + cv; if (L >= BATCH * 4 * (SEQ / 256)) return false;
        const int b = L / 32, hh = (L / 8) % 4, it = L % 8;
        u.pm = b * 8 + it; u.pn = hh; u.offA = (long)u.pm * 256 * DM * 2; u.offB = ((long)b * DM + hh * 256) * DM * 2; return true;
    }
};

constexpr int NPHASE = 2 + 7 * NGRP + 7 + 3 + 8;
#define AR(i) ((bf16_t*)(ws + WS_ARENA + (size_t)(i) * BUF))
#define HB(i) ((bf16_t*)(ws + WS_ARENA + (size_t)(i) * HBUF))
#define SSQ(i) ((float*)(ws + WS_SSQ) + (size_t)(i) * T * 16)
#define HBR ((bf16_t*)(ws + WS_HB))
#define PH_BEGIN if (lo <= ph && ph < hi) {
#define PH_END   if (!MK_MULTI && ph + 1 < hi) xcd_barrier(bar); } ++ph;

template <int L> __device__ __forceinline__ void xa_fold(const Ctx& c, unsigned char* ws, LAS unsigned char* lds) {
    using namespace pg8;
    bf16_t* KQ = AR(2); bf16_t* VO = AR(2) + (size_t)BATCH * DM * DM;
    { Gemm gm{(const bf16_t*)(ws + WS_MEMK), (const bf16_t*)(ws + WS_XAWQ) + (size_t)L * DM * DM, DM, DM, XD}; OrderPre S{c.G, c.bid, false}; EpiBf16 E{KQ, DM, 0, 0, 1.f, nullptr}; gemm_phase<EpiBf16, OrderPre, true>(lds, c.wave, gm, S, E); }
    { Gemm gm{(const bf16_t*)(ws + WS_XAWO) + (size_t)L * DM * DM, (const bf16_t*)(ws + WS_MEMVT), DM, DM, XD}; OrderPre S{c.G, c.bid, true}; EpiBf16 E{VO, DM, 0, 0, 1.f, nullptr}; gemm_phase<EpiBf16, OrderPre, true>(lds, c.wave, gm, S, E); }
}
template <int GI> __device__ __forceinline__ void rwkv_group(const Ctx& c, const InL& in, unsigned char* ws, float* hres, LAS unsigned char* lds, const XcdBarrier& bar, int lo, int hi, int& ph) {
    using namespace pg8;
    bf16_t* pq = HB(7); bf16_t* act = HB(7) + (size_t)TG * 512;
    PH_BEGIN p_norm_shift(c, in, GI, HB(0), HB(1), HB(2), HB(3)); PH_END
    PH_BEGIN
    { Gemm gm{HB(1), (const bf16_t*)(ws + WS_WR), DM, DM, DM}; OrderRKV S; S.init(TG, 3 * DM, DM, DM, c.G, c.bid); S.aStep = (long)HBUF;
      EpiBf16 E{HB(4), DM, DM, HBUF / 2, 1.f, nullptr}; gemm_phase<EpiBf16, OrderRKV, true>(lds, c.wave, gm, S, E); }
    { Gemm gm{HB(0), (const bf16_t*)(ws + WS_WPQ), DM, DM, DM}; OrderMN S; S.init(TG, 512, DM, DM, c.G, c.bid); EpiBf16 E{pq, 512, 0, 0, 1.f, nullptr}; gemm_phase<EpiBf16, OrderMN, true>(lds, c.wave, gm, S, E); }
    PH_END
    PH_BEGIN p_lora_act(c, pq, act); PH_END
    PH_BEGIN
    { Gemm gm{act, (const bf16_t*)(ws + WS_WL2), 256, 256, 128}; OrderLora2 S; S.init(TG, 3072, 256, 256, c.G, c.bid); EpiLora E{HB(0), (size_t)TG * DM, IN(rw_w0), IN(rw_a0)}; gemm_phase<EpiLora, OrderLora2, true>(lds, c.wave, gm, S, E); }
    PH_END
    PH_BEGIN p_scan_s1(c, in, HB(4), HB(5), HB(6), HB(0), HB(1), HB(7), HB(8), HB(9), HB(10), (float*)(ws + WS_BONUS), lds);
    PH_END
    PH_BEGIN p_scan_s2(c, in, HB(7), HB(8), HB(9), HB(10), (const float*)(ws + WS_BONUS), HB(6), HB(2), HB(3), lds); PH_END
    PH_BEGIN
    { Gemm gm{HB(3), (const bf16_t*)(ws + WS_WO0), DM, DM, DM}; OrderMN S; S.init(TG, DM, DM, DM, c.G, c.bid);
      EpiResB E{IN(x) + (size_t)GI * TG * DM, HBR + (size_t)GI * TG * DM, DM, SSQ(0) + (size_t)GI * TG * 16}; gemm_phase<EpiResB, OrderMN, true>(lds, c.wave, gm, S, E); }
    if (GI == NGRP - 1) xa_fold<0>(c, ws, lds);
    PH_END
}
template <int L> __device__ __forceinline__ void layer_tail(const Ctx& c, const InL& in, unsigned char* ws, float* outp, LAS unsigned char* lds, const XcdBarrier& bar, int lo, int hi, int& ph) {
    using namespace pg8;
    unsigned* ctl = (unsigned*)(ws + WS_CTL);
    bf16_t* KQ = AR(2); bf16_t* VO = AR(2) + (size_t)BATCH * DM * DM;
    PH_BEGIN
    { Gemm gm{HBR, KQ, DM, DM, DM}; OrderXS S{c.G, c.bid}; EpiSoftmax E{AR(0), DM, 0.0625f, (LAS float*)(lds + LDS_SM), SSQ(0)}; gemm_phase<EpiSoftmax, OrderXS, true>(lds, c.wave, gm, S, E); }
    PH_END
    PH_BEGIN
    { Gemm gm{AR(0), VO, DM, DM, DM}; OrderXS S{c.G, c.bid}; EpiResB E{nullptr, HBR, DM, SSQ(1)}; gemm_phase<EpiResB, OrderXS, true>(lds, c.wave, gm, S, E); }
    PH_END
    bf16_t* xs = AR(1); bf16_t* hid = (bf16_t*)(ws + WS_ARENA + BUF + (size_t)MAXSLOT * DM * 2);
    unsigned* gcnt = ctl + CW_CNT + 128 * L;
    float* logit = (float*)(ws + WS_LOGIT); int* tok_e = (int*)(ws + WS_TOKE); int* tok_p = (int*)(ws + WS_TOKP); float* tok_w = (float*)(ws + WS_TOKW); int* tok_s = (int*)(ws + WS_TOKS); float* gate = (float*)(ws + WS_GATE);
    PH_BEGIN
    { Gemm gm{HBR, (const bf16_t*)(ws + WS_ROUTE) + (size_t)L * 256 * DM, DM, DM, DM}; OrderMN S; S.init(T, 256, DM, DM, c.G, c.bid); EpiRoute E{logit, SSQ(1)}; gemm_phase<EpiRoute, OrderMN, true>(lds, c.wave, gm, S, E);
      __builtin_amdgcn_fence(__ATOMIC_ACQUIRE, "agent");
      p_select(c, S, logit, IN(moe_bg) + L * NG, IN(moe_be) + L * NE, gcnt, tok_e, tok_p, tok_w, (int*)(ws + WS_ROWTAB), lds); }
    PH_END
    PH_BEGIN moe_table(c, gcnt, lds); p_gather(c, SSQ(1), tok_e, tok_p, tok_w, tok_s, gate, (int*)(ws + WS_ROWTAB), lds); PH_END
    PH_BEGIN
    { moe_table(c, gcnt, lds); const LAS int* toff = (const LAS int*)(lds + LDS_TOFF);
      Gemm gm{HBR, (const bf16_t*)(ws + WS_W13) + (size_t)L * NE * 512 * DM, DM, DM, DM}; OrderMoE S{toff, c.G, c.bid, 2, (long)256 * DM * 2, (long)512 * DM * 2, (long)256 * DM * 2, 0, __builtin_amdgcn_readfirstlane(toff[NB])};
      EpiSwiGLU E{hid, gate}; gemm_phase_g<EpiSwiGLU, OrderMoE, true>(lds, c.wave, gm, S, E, (const int*)(ws + WS_ROWTAB), (LAS unsigned*)(lds + LDS_GTAB)); }
    PH_END
    PH_BEGIN
    { moe_table(c, gcnt, lds); const LAS int* toff = (const LAS int*)(lds + LDS_TOFF);
      Gemm gm{hid, (const bf16_t*)(ws + WS_W2) + (size_t)L * NE * DM * DF, DF, DF, DF}; OrderMoE S{toff, c.G, c.bid, 4, (long)256 * DF * 2, (long)DM * DF * 2, (long)256 * DF * 2, 0, __builtin_amdgcn_readfirstlane(toff[NE])};
      EpiScatter E{HBR, (const int*)(ws + WS_ROWTAB) + STAB_OFF, nullptr, (LAS int*)(lds + LDS_GTAB)}; gemm_phase<EpiScatter, OrderMoE, true>(lds, c.wave, gm, S, E); }
    PH_END
    PH_BEGIN
    { moe_table(c, gcnt, lds); const LAS int* toff = (const LAS int*)(lds + LDS_TOFF);
      Gemm gm{hid, (const bf16_t*)(ws + WS_W2) + (size_t)L * NE * DM * DF, DF, DF, DF}; OrderMoE S{toff, c.G, c.bid, 4, (long)256 * DF * 2, (long)DM * DF * 2, (long)256 * DF * 2, __builtin_amdgcn_readfirstlane(toff[NE]), __builtin_amdgcn_readfirstlane(toff[NB])};
      EpiScatter E{HBR, (const int*)(ws + WS_ROWTAB) + STAB_OFF, SSQ(0), (LAS int*)(lds + LDS_GTAB)}; gemm_phase<EpiScatter, OrderMoE, true>(lds, c.wave, gm, S, E); }
    PH_END
    if (L == 1) { PH_BEGIN p_final(c, HBR, SSQ(0), IN(norm_final), outp); PH_END }
}

__global__ void __launch_bounds__(512, 2) fwd_kernel(Args args) {
    extern __shared__ __attribute__((aligned(16))) unsigned char lds_raw[];
    LAS unsigned char* lds = (LAS unsigned char*)lds_raw;
    Ctx c; c.wave = __builtin_amdgcn_readfirstlane((int)(threadIdx.x >> 6)); c.bid = blockIdx.x; c.G = gridDim.x; c.gw = c.bid * 8 + c.wave; c.NGW = c.G * 8;
    unsigned char* ws = args.ws; float* hres = args.out;
    unsigned* ctl = (unsigned*)(ws + WS_CTL);
    { const int t0 = c.wave * 64 + lane_id();
      for (int u = t0; u < (LDS_BYTES - LDSCTL_OFF) / 4; u += 512) ((LAS unsigned*)(lds + LDSCTL_OFF))[u] = 0u;
      __syncthreads();
      if (t0 < 37) ((LAS unsigned long long*)(lds + LDS_INP))[t0] = ((const unsigned long long*)__builtin_amdgcn_kernarg_segment_ptr())[t0];
      __syncthreads(); }
    InL in; in.p = (const LAS unsigned long long*)(lds + LDS_INP);
    XcdBarrier bar; bar.bar = ctl + CW_BAR; bar.x = 0; bar.st = nullptr;
    if (!MK_MULTI) bar = xcd_barrier_post(ctl + CW_BAR, (volatile LAS unsigned*)(lds + LDS_XB));
    const int lo = args.ph_lo, hi = args.ph_hi; int ph = 0;
    using namespace pg8;
    PH_BEGIN
    p_prologue(c, in, ws, lds);
    PH_END
    PH_BEGIN
    { Gemm g{(const bf16_t*)(ws + WS_MEMN), (const bf16_t*)(ws + WS_XAWKV), DM, DM, DM}; OrderMN S; S.init(BATCH * NMEM, 2 * DM, DM, DM, c.G, c.bid);
      EpiBf16 E{(bf16_t*)(ws + WS_MEMK), DM, DM, (WS_MEMVT - WS_MEMK) / 2, 1.f, nullptr}; gemm_phase<EpiBf16, OrderMN, true>(lds, c.wave, g, S, E); }
    PH_END
    rwkv_group<0>(c, in, ws, hres, lds, bar, lo, hi, ph);
    rwkv_group<1>(c, in, ws, hres, lds, bar, lo, hi, ph);
    layer_tail<0>(c, in, ws, hres, lds, bar, lo, hi, ph);
    PH_BEGIN
    { Gemm gm{HBR, (const bf16_t*)(ws + WS_SBQKV), DM, DM, DM}; OrderMN S; S.init(T, 3 * DM, DM, DM, c.G, c.bid); EpiBf16 E{AR(1), DM, DM, (size_t)T * DM, 0.125f * 1.4426950408889634f, SSQ(0)}; gemm_phase<EpiBf16, OrderMN, true>(lds, c.wave, gm, S, E); }
    PH_END
    PH_BEGIN
    p_stick2(c, AR(1), AR(2), AR(3), AR(0), (unsigned*)(ws + WS_CTL) + CW_STQ, lds);
    PH_END
    PH_BEGIN
    { Gemm gm{AR(0), (const bf16_t*)(ws + WS_SBWO), DM, DM, DM}; OrderMN S; S.init(T, DM, DM, DM, c.G, c.bid); EpiResB E{nullptr, HBR, DM, SSQ(0)}; gemm_phase<EpiResB, OrderMN, true>(lds, c.wave, gm, S, E); }
    xa_fold<1>(c, ws, lds);
    PH_END
    layer_tail<1>(c, in, ws, hres, lds, bar, lo, hi, ph);
}
#undef PH_BEGIN
#undef PH_END

extern "C" void kernel_launch(void* const* d_in, const int* in_sizes, int n_in, void* d_out, int out_size, void* d_ws, size_t ws_size, hipStream_t stream) {
    static int grid = 0;
    if (grid == 0) {
        if (n_in != 37 || out_size != T * DM || ws_size < WS_END) { fprintf(stderr, "kernel_launch: unexpected shapes (n_in %d, out %d, ws %zu < %zu)\n", n_in, out_size, ws_size, (size_t)WS_END); grid = -1; return; }
        int dev = 0, cus = 0, per_cu = 0;
        if (hipGetDevice(&dev) != hipSuccess || hipDeviceGetAttribute(&cus, hipDeviceAttributeMultiprocessorCount, dev) != hipSuccess) { grid = -1; return; }
        if (hipFuncSetAttribute((const void*)fwd_kernel, hipFuncAttributeMaxDynamicSharedMemorySize, LDS_BYTES) != hipSuccess) { fprintf(stderr, "kernel_launch: hipFuncSetAttribute failed\n"); grid = -1; return; }
        if (hipOccupancyMaxActiveBlocksPerMultiprocessor(&per_cu, (const void*)fwd_kernel, 512, LDS_BYTES) != hipSuccess || per_cu < 1) fprintf(stderr, "kernel_launch: occupancy query reports %d\n", per_cu);
        (void)hipGetLastError();
        grid = 1; while (grid * 2 <= cus && grid * 2 <= 256) grid *= 2;
    }
    if (grid < 0) return;
    if (hipMemsetAsync((char*)d_ws + WS_CTL, 0, CTL_ZERO_BYTES, stream) != hipSuccess) return;
    Args a{};
    const float** ip = (const float**)&a.in;
    for (int i = 0; i < 37; ++i) ip[i] = (const float*)d_in[i];
    a.out = (float*)d_out; a.ws = (unsigned char*)d_ws;
#if MK_MULTI
    for (int p = 0; p < NPHASE; ++p) { a.ph_lo = p; a.ph_hi = p + 1; hipLaunchKernelGGL(fwd_kernel, dim3(grid), dim3(512), LDS_BYTES, stream, a); }
#else
    a.ph_lo = 0; a.ph_hi = NPHASE; hipLaunchKernelGGL(fwd_kernel, dim3(grid), dim3(512), LDS_BYTES, stream, a);
#endif
}
```

```cpp
#include <hip/hip_runtime.h>
#include <cstdio>
#include <cstdint>
#include <cstddef>

#ifndef MK_MULTI
#define MK_MULTI 0
#endif

#define GAS __attribute__((address_space(1)))
#define LAS __attribute__((address_space(3)))
typedef unsigned short bf16_t;
typedef short bf16x8 __attribute__((ext_vector_type(8)));
typedef float f32x4 __attribute__((ext_vector_type(4)));
typedef float f32x2 __attribute__((ext_vector_type(2)));
typedef unsigned u32x4 __attribute__((ext_vector_type(4)));
typedef unsigned u32x2 __attribute__((ext_vector_type(2)));

constexpr int BATCH = 32, SEQ = 2048, DM = 1024, T = BATCH * SEQ;
constexpr int NH = 16, HD = 64;
constexpr int NMEM = 256, XH = 4, XD = 256;
constexpr int NG = 4, NEG = 8, NE = 32, DF = 256;
constexpr int NGRP = 2;
constexpr int TG = T / NGRP, BG = BATCH / NGRP;
constexpr float NORM_EPS = 1e-6f, GN_EPS = 64e-5f;
constexpr int STAB_OFF = 256 * 1024;
constexpr int NB = 2 * NE;
constexpr int MAXSLOT = 2 * T + NB * 256;

namespace pg8 {
constexpr int BM = 256, BK = 64, HALF = 128, HTB = HALF * BK * 2, STAGE_BYTES = 8 * HTB, NXCD = 8, WGM = 8;
__host__ __device__ __forceinline__ int lds_byte(int r, int c) { const int st = (r >> 4) * 2 + (c >> 5), rr = r & 15, cc = c & 31, ob = rr * 64 + cc * 2; return st * 1024 + (ob ^ (((ob >> 9) & 1) << 5)); }
__host__ __device__ __forceinline__ void stage_rc(int b, int& R, int& C) { const int st = b / 1024, sb = b % 1024, swz = sb ^ (((sb >> 9) & 1) << 5); R = (st >> 1) * 16 + swz / 64; C = (st & 1) * 32 + (swz % 64) / 2; }
__host__ __device__ __forceinline__ int perm32(int rho) { const int n = rho >> 4, i = rho & 15; return 8 * (i >> 2) + 4 * n + (i & 3); }

struct Unit { int pm, pn; long offA, offB; };
struct Gemm { const bf16_t* A; const bf16_t* Bt; int lda, ldb, K; };

__device__ __forceinline__ unsigned cvt_pk_bf16(float lo, float hi) { unsigned r; asm volatile("v_cvt_pk_bf16_f32 %0, %1, %2" : "=v"(r) : "v"(lo), "v"(hi)); return r; }

struct OrderMN {
    int nM, nN, nwg, G, c; long sA, sB;
    __device__ void init(int M, int N, int lda, int ldb, int G_, int c_) { nM = M / BM; nN = N / BM; nwg = nM * nN; G = G_; c = c_; sA = (long)BM * lda * 2; sB = (long)BM * ldb * 2; }
    __device__ __forceinline__ bool next(int i, Unit& u) const {
        const long L = (long)i * G + c; if (L >= nwg) return false;
        int wgid = (int)L; { const int q = nwg / NXCD, r = nwg % NXCD, xcd = wgid % NXCD, off = wgid / NXCD; wgid = (xcd < r ? xcd * (q + 1) : r * (q + 1) + (xcd - r) * q) + off; }
        const int nig = WGM * nN, gid = wgid / nig, fm = gid * WGM, gsz = (nM - fm) < WGM ? (nM - fm) : WGM;
        u.pm = fm + ((wgid % nig) % gsz); u.pn = (wgid % nig) / gsz; u.offA = u.pm * sA; u.offB = u.pn * sB; return true;
    }
};

struct OrderLora2 : OrderMN {
    __device__ __forceinline__ bool next(int i, Unit& u) const { if (!OrderMN::next(i, u)) return false; if (u.pn >= 8) { u.offA += 256; u.offB += 256; } return true; }
};
struct OrderRKV : OrderMN {
    long aStep;
    __device__ __forceinline__ bool next(int i, Unit& u) const { if (!OrderMN::next(i, u)) return false; u.offA += (long)(u.pn >> 2) * aStep; return true; }
};
__device__ __forceinline__ float xadd16(float x) { const unsigned u = __float_as_uint(x); const auto r = __builtin_amdgcn_permlane16_swap(u, u, false, false); return __uint_as_float(r[0]) + __uint_as_float(r[1]); }
__device__ __forceinline__ float xadd32(float x) { const unsigned u = __float_as_uint(x); const auto r = __builtin_amdgcn_permlane32_swap(u, u, false, false); return __uint_as_float(r[0]) + __uint_as_float(r[1]); }
__device__ __forceinline__ float xmax16(float x) { const unsigned u = __float_as_uint(x); const auto r = __builtin_amdgcn_permlane16_swap(u, u, false, false); return fmaxf(__uint_as_float(r[0]), __uint_as_float(r[1])); }
__device__ __forceinline__ float xmax32(float x) { const unsigned u = __float_as_uint(x); const auto r = __builtin_amdgcn_permlane32_swap(u, u, false, false); return fmaxf(__uint_as_float(r[0]), __uint_as_float(r[1])); }
__device__ __forceinline__ float rstd16(const float* ssq, int row) { const f32x4* p = (const f32x4*)(ssq + (size_t)row * 16); const f32x4 a = p[0], b = p[1], c = p[2], d = p[3];
    const f32x4 s = (a + b) + (c + d); return rsqrtf(((s[0] + s[1]) + (s[2] + s[3])) * (1.f / 1024.f) + 1e-6f); }
__device__ __forceinline__ f32x4 rstd16q_ld(const float* ssq, int row, int fq) { return *(const f32x4*)(ssq + (size_t)row * 16 + 4 * fq); }
__device__ __forceinline__ void ssq_prefetch(const float* ssq, const Unit& u, int wid, LAS float* sp) {
    int l; asm volatile("v_mbcnt_lo_u32_b32 %0, -1, 0\n\tv_mbcnt_hi_u32_b32 %0, -1, %0" : "=v"(l));
#pragma unroll
    for (int j = 0; j < 2; ++j) { const int blk = wid * 2 + j;
        __builtin_amdgcn_global_load_lds((const unsigned*)(ssq + ((size_t)u.pm * BM + blk * 16) * 16 + l * 4), (LAS unsigned*)(sp + blk * 256), 16, 0, 0); }
}
__device__ __forceinline__ void ssq_read8(f32x4 (&qa)[2][4], const LAS float* sp, int wr, int fr, int fq) {
    asm volatile("ds_read_b128 %0, %8\n\tds_read_b128 %1, %8 offset:1024\n\tds_read_b128 %2, %8 offset:2048\n\tds_read_b128 %3, %8 offset:3072\n\tds_read_b128 %4, %8 offset:8192\n\tds_read_b128 %5, %8 offset:9216\n\t"
                 "ds_read_b128 %6, %8 offset:10240\n\tds_read_b128 %7, %8 offset:11264\n\ts_waitcnt lgkmcnt(0)"
                 : "=&v"(qa[0][0]), "=&v"(qa[0][1]), "=&v"(qa[0][2]), "=&v"(qa[0][3]), "=&v"(qa[1][0]), "=&v"(qa[1][1]), "=&v"(qa[1][2]), "=&v"(qa[1][3]) : "v"((unsigned)(size_t)sp + (unsigned)((wr * 64 + fr) * 64 + fq * 16)) : "memory");
}
__device__ __forceinline__ float rstd16q_fin(f32x4 a) { return rsqrtf(xadd32(xadd16((a[0] + a[1]) + (a[2] + a[3]))) * (1.f / 1024.f) + 1e-6f); }
struct EpiBf16 {
    static constexpr bool PERM = true;
    static constexpr bool HAS_PRE = true;
    bf16_t* O; int ldc; int split_cols; size_t split_stride; float scale0; const float* ssq; LAS float* sp;
    __device__ __forceinline__ void prefetch(const Unit& u, int wid) const { if (ssq) ssq_prefetch(ssq, u, wid, sp); }
    __device__ __forceinline__ void operator()(const f32x4 (&acc)[2][2][4][2], const Unit& u, int wr, int wc, int fr, int fq) const {
        const int row0 = u.pm * BM + wr * 64 + fr; int colt = u.pn * BM; bf16_t* base = O;
        float sc0 = scale0; if (split_cols) { const int t = colt / split_cols; base += (size_t)t * split_stride; colt -= t * split_cols; if (t != 0) sc0 = 1.f; }
        const int col0 = colt + wc * 32 + 8 * fq;
        f32x4 qa[2][4];
        if (ssq) ssq_read8(qa, sp, wr, fr, fq);
#pragma unroll
        for (int ai = 0; ai < 2; ++ai)
#pragma unroll
            for (int m = 0; m < 4; ++m) { const int row = row0 + ai * HALF + m * 16; bf16_t* rowp = base + (size_t)row * ldc + col0;
                const float sc = ssq ? sc0 * rstd16q_fin(qa[ai][m]) : sc0;
#pragma unroll
                for (int bj = 0; bj < 2; ++bj) { const f32x4 v0 = acc[ai][bj][m][0] * sc, v1 = acc[ai][bj][m][1] * sc;
                    u32x4 w; w.x = cvt_pk_bf16(v0[0], v0[1]); w.y = cvt_pk_bf16(v0[2], v0[3]); w.z = cvt_pk_bf16(v1[0], v1[1]); w.w = cvt_pk_bf16(v1[2], v1[3]);
                    *(u32x4*)(rowp + bj * HALF) = w; } }
    }
};
__device__ __forceinline__ float sigmoidf_(float x) { return __builtin_amdgcn_rcpf(1.f + __expf(-x)); }
struct EpiSoftmax {
    static constexpr bool PERM = true;
    static constexpr bool HAS_PRE = true;
    bf16_t* O; int ldc; float scale; LAS float* sm; const float* ssq;
    LAS float* sp;
    __device__ __forceinline__ void prefetch(const Unit& u, int wid) const { if (ssq) ssq_prefetch(ssq, u, wid, sp); }
    __device__ __forceinline__ void operator()(f32x4 (&acc)[2][2][4][2], const Unit& u, int wr, int wc, int fr, int fq) const {
        const int rl0 = wr * 64 + fr;
        f32x4 qa[2][4];
        if (ssq) ssq_read8(qa, sp, wr, fr, fq);
        float mw[2][4];
#pragma unroll
        for (int ai = 0; ai < 2; ++ai)
#pragma unroll
            for (int m = 0; m < 4; ++m) { float mx = -3.0e38f; const float sc = ssq ? scale * rstd16q_fin(qa[ai][m]) : scale;
#pragma unroll
                for (int bj = 0; bj < 2; ++bj)
#pragma unroll
                    for (int n = 0; n < 2; ++n) { acc[ai][bj][m][n] = acc[ai][bj][m][n] * sc; const f32x4 v = acc[ai][bj][m][n]; mx = fmaxf(mx, fmaxf(fmaxf(v[0], v[1]), fmaxf(v[2], v[3]))); }
                mx = xmax32(xmax16(mx)); mw[ai][m] = mx; float sum = 0.f;
#pragma unroll
                for (int bj = 0; bj < 2; ++bj)
#pragma unroll
                    for (int n = 0; n < 2; ++n) { f32x4 v = acc[ai][bj][m][n]; v[0] = __expf(v[0] - mx); v[1] = __expf(v[1] - mx); v[2] = __expf(v[2] - mx); v[3] = __expf(v[3] - mx); acc[ai][bj][m][n] = v; sum += (v[0] + v[1]) + (v[2] + v[3]); }
                sum = xadd32(xadd16(sum));
                if (fq == 0) *(LAS f32x2*)(sm + ((rl0 + ai * HALF + m * 16) * 4 + wc) * 2) = (f32x2){mx, sum}; }
        asm volatile("s_waitcnt lgkmcnt(0)" ::: "memory"); __builtin_amdgcn_s_barrier(); asm volatile("" ::: "memory");
        const int row0 = u.pm * BM + rl0, col0 = u.pn * BM + wc * 32 + 8 * fq;
        f32x4 q0[2][4], q1[2][4];
#pragma unroll
        for (int ai = 0; ai < 2; ++ai)
#pragma unroll
            for (int m = 0; m < 4; ++m) { const int rl = rl0 + ai * HALF + m * 16; q0[ai][m] = *(const LAS f32x4*)(sm + rl * 8); q1[ai][m] = *(const LAS f32x4*)(sm + rl * 8 + 4); }
#pragma unroll
        for (int ai = 0; ai < 2; ++ai)
#pragma unroll
            for (int m = 0; m < 4; ++m) { const f32x4 a = q0[ai][m], b = q1[ai][m];
                const float M = fmaxf(fmaxf(a[0], a[2]), fmaxf(b[0], b[2]));
                const float tot = (a[1] * __expf(a[0] - M) + a[3] * __expf(a[2] - M)) + (b[1] * __expf(b[0] - M) + b[3] * __expf(b[2] - M));
                const float inv = __expf(mw[ai][m] - M) * __builtin_amdgcn_rcpf(tot);
                bf16_t* rowp = O + (size_t)(row0 + ai * HALF + m * 16) * ldc + col0;
#pragma unroll
                for (int bj = 0; bj < 2; ++bj) { const f32x4 v0 = acc[ai][bj][m][0] * inv, v1 = acc[ai][bj][m][1] * inv;
                    u32x4 w; w.x = cvt_pk_bf16(v0[0], v0[1]); w.y = cvt_pk_bf16(v0[2], v0[3]); w.z = cvt_pk_bf16(v1[0], v1[1]); w.w = cvt_pk_bf16(v1[2], v1[3]);
                    *(u32x4*)(rowp + bj * HALF) = w; } }
    }
};
struct EpiLora {
    static constexpr bool PERM = true;
    static constexpr bool HAS_PRE = false;
    bf16_t* O; size_t stride; const float* w0; const float* a0;
    __device__ __forceinline__ void operator()(const f32x4 (&acc)[2][2][4][2], const Unit& u, int wr, int wc, int fr, int fq) const {
        const int row0 = u.pm * BM + wr * 64 + fr; int colt = u.pn * BM; const int t = colt / 1024; colt -= t * 1024; bf16_t* base = O + (size_t)t * stride;
        const int col0 = colt + wc * 32 + 8 * fq; const float* bias = (t == 0) ? w0 : a0;
        f32x4 bv[2][2];
#pragma unroll
        for (int bj = 0; bj < 2; ++bj)
#pragma unroll
            for (int n = 0; n < 2; ++n) bv[bj][n] = (t < 2) ? *(const f32x4*)(bias + col0 + bj * HALF + 4 * n) : (f32x4){0.f, 0.f, 0.f, 0.f};
#pragma unroll
        for (int ai = 0; ai < 2; ++ai)
#pragma unroll
            for (int m = 0; m < 4; ++m) { bf16_t* rowp = base + (size_t)(row0 + ai * HALF + m * 16) * 1024 + col0;
#pragma unroll
                for (int bj = 0; bj < 2; ++bj) { f32x4 v0 = acc[ai][bj][m][0] + bv[bj][0], v1 = acc[ai][bj][m][1] + bv[bj][1];
                    if (t < 2) { const float s = (t == 0) ? -0.6065306597f : 1.f;
#pragma unroll
                        for (int e = 0; e < 4; ++e) { v0[e] = s * sigmoidf_(v0[e]); v1[e] = s * sigmoidf_(v1[e]); } }
                    u32x4 w; w.x = cvt_pk_bf16(v0[0], v0[1]); w.y = cvt_pk_bf16(v0[2], v0[3]); w.z = cvt_pk_bf16(v1[0], v1[1]); w.w = cvt_pk_bf16(v1[2], v1[3]);
                    *(u32x4*)(rowp + bj * HALF) = w; } }
    }
};
struct EpiResB {
    static constexpr bool PERM = true;
    static constexpr bool HAS_PRE = false;
    const float* basef; bf16_t* hb; int ldc; float* ssq;
    __device__ __forceinline__ void operator()(const f32x4 (&acc)[2][2][4][2], const Unit& u, int wr, int wc, int fr, int fq) const {
        const int row0 = u.pm * BM + wr * 64 + fr, col0 = u.pn * BM + wc * 32 + 8 * fq;
        if (basef) {
#pragma unroll
            for (int aim = 0; aim < 4; ++aim) { const int ai = aim >> 1, mb = (aim & 1) * 2; f32x4 bq[4][2][2];
#pragma unroll
                for (int m = mb; m < mb + 2; ++m) { const size_t off = (size_t)(row0 + ai * HALF + m * 16) * ldc + col0;
#pragma unroll
                    for (int bj = 0; bj < 2; ++bj) { bq[m][bj][0] = *(const f32x4*)(basef + off + bj * HALF); bq[m][bj][1] = *(const f32x4*)(basef + off + bj * HALF + 4); } }
                asm volatile("" ::: "memory");
#pragma unroll
                for (int m = mb; m < mb + 2; ++m) { const int row = row0 + ai * HALF + m * 16; const size_t off = (size_t)row * ldc + col0; float sq = 0.f;
#pragma unroll
                    for (int bj = 0; bj < 2; ++bj) { const f32x4 o0 = bq[m][bj][0] + acc[ai][bj][m][0], o1 = bq[m][bj][1] + acc[ai][bj][m][1];
                        u32x4 w; w.x = cvt_pk_bf16(o0[0], o0[1]); w.y = cvt_pk_bf16(o0[2], o0[3]); w.z = cvt_pk_bf16(o1[0], o1[1]); w.w = cvt_pk_bf16(o1[2], o1[3]);
                        *(u32x4*)(hb + off + bj * HALF) = w;
                        sq += ((o0[0] * o0[0] + o0[1] * o0[1]) + (o0[2] * o0[2] + o0[3] * o0[3])) + ((o1[0] * o1[0] + o1[1] * o1[1]) + (o1[2] * o1[2] + o1[3] * o1[3])); }
                    sq = xadd32(xadd16(sq)); if (fq == 0) ssq[(size_t)row * 16 + u.pn * 4 + wc] = sq; } }
        } else {
#pragma unroll
            for (int ai = 0; ai < 2; ++ai) { u32x4 bw[4][2];
#pragma unroll
                for (int m = 0; m < 4; ++m) { const size_t off = (size_t)(row0 + ai * HALF + m * 16) * ldc + col0;
#pragma unroll
                    for (int bj = 0; bj < 2; ++bj) bw[m][bj] = *(const u32x4*)(hb + off + bj * HALF); }
                asm volatile("" ::: "memory");
#pragma unroll
                for (int m = 0; m < 4; ++m) { const int row = row0 + ai * HALF + m * 16; const size_t off = (size_t)row * ldc + col0; float sq = 0.f;
#pragma unroll
                    for (int bj = 0; bj < 2; ++bj) { const u32x4 w = bw[m][bj];
                        const f32x4 b0 = (f32x4){__uint_as_float(w.x << 16), __uint_as_float(w.x & 0xffff0000u), __uint_as_float(w.y << 16), __uint_as_float(w.y & 0xffff0000u)};
                        const f32x4 b1 = (f32x4){__uint_as_float(w.z << 16), __uint_as_float(w.z & 0xffff0000u), __uint_as_float(w.w << 16), __uint_as_float(w.w & 0xffff0000u)};
                        const f32x4 o0 = b0 + acc[ai][bj][m][0], o1 = b1 + acc[ai][bj][m][1];
                        u32x4 wo; wo.x = cvt_pk_bf16(o0[0], o0[1]); wo.y = cvt_pk_bf16(o0[2], o0[3]); wo.z = cvt_pk_bf16(o1[0], o1[1]); wo.w = cvt_pk_bf16(o1[2], o1[3]);
                        *(u32x4*)(hb + off + bj * HALF) = wo;
                        sq += ((o0[0] * o0[0] + o0[1] * o0[1]) + (o0[2] * o0[2] + o0[3] * o0[3])) + ((o1[0] * o1[0] + o1[1] * o1[1]) + (o1[2] * o1[2] + o1[3] * o1[3])); }
                    sq = xadd32(xadd16(sq)); if (fq == 0) ssq[(size_t)row * 16 + u.pn * 4 + wc] = sq; } }
        }
    }
};
struct EpiScatter {
    static constexpr bool PERM = true;
    static constexpr bool HAS_PRE = true;
    bf16_t* hb; const int* stab; float* ssq; LAS int* tab;
    __device__ __forceinline__ void prefetch(const Unit& u, int wid) const {
        if (wid < 4) { int l; asm volatile("v_mbcnt_lo_u32_b32 %0, -1, 0\n\tv_mbcnt_hi_u32_b32 %0, -1, %0" : "=v"(l));
            __builtin_amdgcn_global_load_lds((const unsigned*)(stab + u.pm * BM + wid * 64 + l), (LAS unsigned*)(tab + wid * 64), 4, 0, 0); }
    }
    __device__ __forceinline__ void operator()(const f32x4 (&acc)[2][2][4][2], const Unit& u, int wr, int wc, int fr, int fq) const {
        const int col0 = u.pn * BM + wc * 32 + 8 * fq;
        int tk[2][4];
        asm volatile("ds_read_b32 %0, %8\n\tds_read_b32 %1, %8 offset:64\n\tds_read_b32 %2, %8 offset:128\n\tds_read_b32 %3, %8 offset:192\n\tds_read_b32 %4, %8 offset:512\n\tds_read_b32 %5, %8 offset:576\n\t"
                     "ds_read_b32 %6, %8 offset:640\n\tds_read_b32 %7, %8 offset:704\n\ts_waitcnt lgkmcnt(0)"
                     : "=&v"(tk[0][0]), "=&v"(tk[0][1]), "=&v"(tk[0][2]), "=&v"(tk[0][3]), "=&v"(tk[1][0]), "=&v"(tk[1][1]), "=&v"(tk[1][2]), "=&v"(tk[1][3]) : "v"((unsigned)(size_t)tab + (unsigned)(wr * 64 + fr) * 4u) : "memory");
#pragma unroll
        for (int ai = 0; ai < 2; ++ai)
#pragma unroll
            for (int m = 0; m < 4; ++m) { const int tok = tk[ai][m]; float sq = 0.f;
                if (tok >= 0) { const size_t off = (size_t)tok * DM + col0;
#pragma unroll
                    for (int bj = 0; bj < 2; ++bj) { const u32x4 w0 = *(const u32x4*)(hb + off + bj * HALF);
                        const f32x4 b0 = (f32x4){__uint_as_float(w0.x << 16), __uint_as_float(w0.x & 0xffff0000u), __uint_as_float(w0.y << 16), __uint_as_float(w0.y & 0xffff0000u)};
                        const f32x4 b1 = (f32x4){__uint_as_float(w0.z << 16), __uint_as_float(w0.z & 0xffff0000u), __uint_as_float(w0.w << 16), __uint_as_float(w0.w & 0xffff0000u)};
                        const f32x4 o0 = b0 + acc[ai][bj][m][0], o1 = b1 + acc[ai][bj][m][1];
                        u32x4 w; w.x = cvt_pk_bf16(o0[0], o0[1]); w.y = cvt_pk_bf16(o0[2], o0[3]); w.z = cvt_pk_bf16(o1[0], o1[1]); w.w = cvt_pk_bf16(o1[2], o1[3]);
                        *(u32x4*)(hb + off + bj * HALF) = w;
                        sq += ((o0[0] * o0[0] + o0[1] * o0[1]) + (o0[2] * o0[2] + o0[3] * o0[3])) + ((o1[0] * o1[0] + o1[1] * o1[1]) + (o1[2] * o1[2] + o1[3] * o1[3])); } }
                if (ssq) { sq = xadd32(xadd16(sq)); if (fq == 0 && tok >= 0) ssq[(size_t)tok * 16 + u.pn * 4 + wc] = sq; } }
    }
};
struct EpiRoute {
    static constexpr bool PERM = false;
    static constexpr bool HAS_PRE = true;
    float* out; const float* ssq; LAS float* sp;
    __device__ __forceinline__ void prefetch(const Unit& u, int wid) const { ssq_prefetch(ssq, u, wid, sp); }
    __device__ __forceinline__ void operator()(const f32x4 (&acc)[2][2][4][2], const Unit& u, int wr, int wc, int fr, int fq) const {
        if (wc >= 2) return;
        const int row0 = u.pm * BM + wr * 64 + fr, col0 = wc * 32 + 4 * fq;
        f32x4 qa[2][4]; ssq_read8(qa, sp, wr, fr, fq);
#pragma unroll
        for (int ai = 0; ai < 2; ++ai)
#pragma unroll
            for (int m = 0; m < 4; ++m) { const int row = row0 + ai * HALF + m * 16; float* rowp = out + (size_t)row * 64 + col0; const float rs = rstd16q_fin(qa[ai][m]);
#pragma unroll
                for (int n = 0; n < 2; ++n) *(f32x4*)(rowp + n * 16) = acc[ai][0][m][n] * rs; }
    }
};
struct EpiSwiGLU {
    static constexpr bool PERM = true;
    static constexpr bool HAS_PRE = false;
    bf16_t* hid; const float* gate;
    __device__ __forceinline__ void operator()(const f32x4 (&acc)[2][2][4][2], const Unit& u, int wr, int wc, int fr, int fq) const {
        const int row0 = u.pm * BM + wr * 64 + fr, col0 = u.pn * 128 + wc * 32 + 8 * fq;
        f32x2 gq[2][4];
#pragma unroll
        for (int ai = 0; ai < 2; ++ai)
#pragma unroll
            for (int m = 0; m < 4; ++m) gq[ai][m] = *(const f32x2*)(gate + 2 * (size_t)(row0 + ai * HALF + m * 16));
        asm volatile("" ::: "memory");
#pragma unroll
        for (int ai = 0; ai < 2; ++ai)
#pragma unroll
            for (int m = 0; m < 4; ++m) { const int row = row0 + ai * HALF + m * 16; const f32x2 gr = gq[ai][m]; const float rs = gr.x, g = gr.y;
                f32x4 h0, h1;
#pragma unroll
                for (int e = 0; e < 4; ++e) { const float a0 = acc[ai][0][m][0][e] * rs, a1 = acc[ai][0][m][1][e] * rs;
                    h0[e] = a0 * sigmoidf_(a0) * acc[ai][1][m][0][e] * g; h1[e] = a1 * sigmoidf_(a1) * acc[ai][1][m][1][e] * g; }
                u32x4 w; w.x = cvt_pk_bf16(h0[0], h0[1]); w.y = cvt_pk_bf16(h0[2], h0[3]); w.z = cvt_pk_bf16(h1[0], h1[1]); w.w = cvt_pk_bf16(h1[2], h1[3]);
                *(u32x4*)(hid + (size_t)row * 256 + col0) = w; }
    }
};

template <class Epi, class Sched, bool ALIGN_EPI>
__device__ __forceinline__ void gemm_phase(LAS unsigned char* lds, const int wid, const Gemm g, const Sched& S, const Epi& E) {
    int lane; asm volatile("v_mbcnt_lo_u32_b32 %0, -1, 0\n\tv_mbcnt_hi_u32_b32 %0, -1, %0" : "=v"(lane));
    const int tid = wid * 64 + lane, wr = wid >> 2, wc = wid & 3, fr = lane & 15, fq = lane >> 4;
    const int K = g.K, nt = K / BK;
    unsigned voffA[2], voffB[2];
#pragma unroll
    for (int i = 0; i < 2; ++i) { int R, C; stage_rc(tid * 16 + i * 8192, R, C); const int Rb = Epi::PERM ? ((R & ~31) + perm32(R & 31)) : R;
        voffA[i] = (unsigned)(R * g.lda + C) * 2u; voffB[i] = (unsigned)(Rb * g.ldb + C) * 2u; }
    const size_t kstep = (size_t)(BK * 2);
    const size_t hstepA = (size_t)HALF * g.lda * 2, hstepB = (size_t)HALF * g.ldb * 2;
    const unsigned ldsw = (unsigned)wid * 1024u;
    const int aoff = lds_byte(wr * 64 + fr, fq * 8), boff = lds_byte(wc * 32 + fr, fq * 8);
#define PG8_SA(b, h) (((b) * 2 + (h)) * HTB)
#define PG8_SB(b, h) ((4 + (b) * 2 + (h)) * HTB)
#define PG8_STAGE(bufoff, gbase, voff) do { _Pragma("unroll") for (int _i = 0; _i < 2; ++_i) \
        __builtin_amdgcn_global_load_lds((const unsigned*)((const char*)(gbase) + (voff)[_i]), (LAS unsigned*)(lds + (bufoff) + ldsw + _i * 8192), 16, 0, 0); } while (0)
#define PG8_LDA(dst, b, h) do { _Pragma("unroll") for (int m = 0; m < 4; ++m) _Pragma("unroll") for (int k = 0; k < 2; ++k) dst[m][k] = *(const LAS bf16x8*)(lds + PG8_SA(b, h) + aoff + m * 2048 + k * 1024); } while (0)
#define PG8_LDB(dst, b, h) do { _Pragma("unroll") for (int n = 0; n < 2; ++n) _Pragma("unroll") for (int k = 0; k < 2; ++k) dst[n][k] = *(const LAS bf16x8*)(lds + PG8_SB(b, h) + boff + n * 2048 + k * 1024); } while (0)
#define PG8_MMA(ai, bj, At, Bt) do { __builtin_amdgcn_s_setprio(1); _Pragma("unroll") for (int m = 0; m < 4; ++m) _Pragma("unroll") for (int n = 0; n < 2; ++n) _Pragma("unroll") for (int k = 0; k < 2; ++k) \
        acc[ai][bj][m][n] = __builtin_amdgcn_mfma_f32_16x16x32_bf16(Bt[n][k], At[m][k], acc[ai][bj][m][n], 0, 0, 0); __builtin_amdgcn_s_setprio(0); } while (0)
#define PG8_WAIT_V(n) asm volatile("s_waitcnt vmcnt(" #n ")" ::: "memory")
#define PG8_WAIT_L(n) asm volatile("s_waitcnt lgkmcnt(" #n ")" ::: "memory")
#define PG8_BAR __builtin_amdgcn_s_barrier()
#define PG8_SCHED __builtin_amdgcn_sched_barrier(0)
    Unit cur, nxt; int ui = 0;
    if (!S.next(0, cur)) return;
    f32x4 acc[2][2][4][2];
#pragma unroll
    for (int a = 0; a < 2; ++a)
#pragma unroll
        for (int b = 0; b < 2; ++b)
#pragma unroll
            for (int m = 0; m < 4; ++m)
#pragma unroll
                for (int n = 0; n < 2; ++n) acc[a][b][m][n] = (f32x4){0.f, 0.f, 0.f, 0.f};
    bf16x8 At[4][2], B0[2][2], B1[2][2];
    const char* cA = (const char*)g.A + cur.offA; const char* cB = (const char*)g.Bt + cur.offB;
    PG8_STAGE(PG8_SB(0, 0), cB, voffB); PG8_STAGE(PG8_SB(0, 1), cB + hstepB, voffB); PG8_STAGE(PG8_SA(0, 0), cA, voffA); PG8_STAGE(PG8_SA(0, 1), cA + hstepA, voffA);
    if (wr == 1) PG8_BAR;
    PG8_WAIT_V(2); PG8_BAR;
    PG8_STAGE(PG8_SB(1, 0), cB + kstep, voffB); PG8_STAGE(PG8_SA(1, 0), cA + kstep, voffA); PG8_STAGE(PG8_SB(1, 1), cB + hstepB + kstep, voffB);
    PG8_WAIT_V(6); PG8_BAR;
    for (;;) {
        const bool has_next = S.next(ui + 1, nxt);
        const char* nA = has_next ? (const char*)g.A + nxt.offA : cA; const char* nB = has_next ? (const char*)g.Bt + nxt.offB : cB;
        if constexpr (Epi::HAS_PRE) E.prefetch(cur, wid);
        for (int t = 0; t < nt; t += 2) {
            const bool last = (t == nt - 2);
            const char* a1 = cA + (size_t)(t + 1) * kstep;
            const char* a2 = last ? nA : cA + (size_t)(t + 2) * kstep; const char* b2 = last ? nB : cB + (size_t)(t + 2) * kstep;
            const char* a3 = a2 + kstep; const char* b3 = b2 + kstep;
            PG8_LDB(B0, 0, 0); PG8_LDB(B1, 0, 1); PG8_SCHED; PG8_LDA(At, 0, 0); PG8_STAGE(PG8_SA(1, 1), a1 + hstepA, voffA);
            PG8_WAIT_V(8); PG8_WAIT_L(0); PG8_BAR; PG8_MMA(0, 0, At, B0); PG8_MMA(0, 1, At, B1); PG8_BAR; PG8_SCHED;
            PG8_LDA(At, 0, 1); PG8_STAGE(PG8_SB(0, 0), b2, voffB); PG8_STAGE(PG8_SB(0, 1), b2 + hstepB, voffB); PG8_STAGE(PG8_SA(0, 0), a2, voffA);
            PG8_WAIT_V(8); PG8_WAIT_L(0); PG8_BAR; PG8_MMA(1, 0, At, B0); PG8_MMA(1, 1, At, B1); PG8_BAR; PG8_SCHED;
            PG8_LDB(B0, 1, 0); PG8_LDB(B1, 1, 1); PG8_SCHED; PG8_LDA(At, 1, 0); PG8_STAGE(PG8_SA(0, 1), a2 + hstepA, voffA);
            PG8_WAIT_V(8); PG8_WAIT_L(0); PG8_BAR; PG8_MMA(0, 0, At, B0); PG8_MMA(0, 1, At, B1); PG8_BAR; PG8_SCHED;
            PG8_LDA(At, 1, 1); PG8_STAGE(PG8_SB(1, 0), b3, voffB); PG8_STAGE(PG8_SB(1, 1), b3 + hstepB, voffB); PG8_STAGE(PG8_SA(1, 0), a3, voffA);
            PG8_WAIT_V(8); PG8_WAIT_L(0); PG8_BAR; PG8_MMA(1, 0, At, B0); PG8_MMA(1, 1, At, B1); PG8_BAR; PG8_SCHED;
        }
        if constexpr (ALIGN_EPI) { if (wr == 0) PG8_BAR; }
        { int l2; asm volatile("v_mbcnt_lo_u32_b32 %0, -1, 0\n\tv_mbcnt_hi_u32_b32 %0, -1, %0" : "=v"(l2)); E(acc, cur, wr, wc, l2 & 15, l2 >> 4); }
        if (!has_next) break;
#pragma unroll
        for (int a = 0; a < 2; ++a)
#pragma unroll
            for (int b = 0; b < 2; ++b)
#pragma unroll
                for (int m = 0; m < 4; ++m)
#pragma unroll
                    for (int n = 0; n < 2; ++n) acc[a][b][m][n] = (f32x4){0.f, 0.f, 0.f, 0.f};
        cur = nxt; cA = nA; cB = nB; ++ui;
        if constexpr (ALIGN_EPI) { if (wr == 1) PG8_BAR; }
    }
    PG8_WAIT_V(0);
    if constexpr (!ALIGN_EPI) { if (wr == 0) PG8_BAR; }
    PG8_BAR;
#undef PG8_SA
#undef PG8_SB
#undef PG8_STAGE
#undef PG8_LDA
#undef PG8_LDB
#undef PG8_MMA
#undef PG8_WAIT_V
#undef PG8_WAIT_L
#undef PG8_BAR
#undef PG8_SCHED
}
template <class Epi, class Sched, bool ALIGN_EPI>
__device__ __forceinline__ void gemm_phase_g(LAS unsigned char* lds, const int wid, const Gemm g, const Sched& S, const Epi& E, const int* rowtab, LAS unsigned* gtab) {
    int lane; asm volatile("v_mbcnt_lo_u32_b32 %0, -1, 0\n\tv_mbcnt_hi_u32_b32 %0, -1, %0" : "=v"(lane));
    const int tid = wid * 64 + lane, wr = wid >> 2, wc = wid & 3, fr = lane & 15, fq = lane >> 4;
    const int K = g.K, nt = K / BK;
    unsigned voffA[2], voffB[2];
#pragma unroll
    for (int i = 0; i < 2; ++i) { int R, C; stage_rc(tid * 16 + i * 8192, R, C); const int Rb = Epi::PERM ? ((R & ~31) + perm32(R & 31)) : R;
        voffA[i] = (unsigned)R | ((unsigned)(C * 2) << 16); voffB[i] = (unsigned)(Rb * g.ldb + C) * 2u; }
    const size_t kstep = (size_t)(BK * 2);
    const size_t hstepA = (size_t)HALF * g.lda * 2, hstepB = (size_t)HALF * g.ldb * 2;
    const unsigned ldsw = (unsigned)wid * 1024u;
    const int aoff = lds_byte(wr * 64 + fr, fq * 8), boff = lds_byte(wc * 32 + fr, fq * 8);
#define PG8_SA(b, h) (((b) * 2 + (h)) * HTB)
#define PG8_SB(b, h) ((4 + (b) * 2 + (h)) * HTB)
#define PG8_STAGE(bufoff, gbase, voff) do { _Pragma("unroll") for (int _i = 0; _i < 2; ++_i) \
        __builtin_amdgcn_global_load_lds((const unsigned*)((const char*)(gbase) + (voff)[_i]), (LAS unsigned*)(lds + (bufoff) + ldsw + _i * 8192), 16, 0, 0); } while (0)
#define PG8_LDA(dst, b, h) do { _Pragma("unroll") for (int m = 0; m < 4; ++m) _Pragma("unroll") for (int k = 0; k < 2; ++k) dst[m][k] = *(const LAS bf16x8*)(lds + PG8_SA(b, h) + aoff + m * 2048 + k * 1024); } while (0)
#define PG8_LDB(dst, b, h) do { _Pragma("unroll") for (int n = 0; n < 2; ++n) _Pragma("unroll") for (int k = 0; k < 2; ++k) dst[n][k] = *(const LAS bf16x8*)(lds + PG8_SB(b, h) + boff + n * 2048 + k * 1024); } while (0)
#define PG8_MMA(ai, bj, At, Bt) do { __builtin_amdgcn_s_setprio(1); _Pragma("unroll") for (int m = 0; m < 4; ++m) _Pragma("unroll") for (int n = 0; n < 2; ++n) _Pragma("unroll") for (int k = 0; k < 2; ++k) \
        acc[ai][bj][m][n] = __builtin_amdgcn_mfma_f32_16x16x32_bf16(Bt[n][k], At[m][k], acc[ai][bj][m][n], 0, 0, 0); __builtin_amdgcn_s_setprio(0); } while (0)
#define PG8_STAGE_A(bufoff, gbase, half, tb) do { _Pragma("unroll") for (int _i = 0; _i < 2; ++_i) { const unsigned _o = gtab[(tb) * 256 + (half) * 128 + (voffA[_i] & 0xffffu)] + (voffA[_i] >> 16); \
        __builtin_amdgcn_global_load_lds((const unsigned*)((const char*)(gbase) + _o), (LAS unsigned*)(lds + (bufoff) + ldsw + _i * 8192), 16, 0, 0); } } while (0)
#define PG8_WAIT_V(n) asm volatile("s_waitcnt vmcnt(" #n ")" ::: "memory")
#define PG8_WAIT_L(n) asm volatile("s_waitcnt lgkmcnt(" #n ")" ::: "memory")
#define PG8_BAR __builtin_amdgcn_s_barrier()
#define PG8_SCHED __builtin_amdgcn_sched_barrier(0)
    Unit cur, nxt; int ui = 0;
    if (!S.next(0, cur)) return;
    f32x4 acc[2][2][4][2];
#pragma unroll
    for (int a = 0; a < 2; ++a)
#pragma unroll
        for (int b = 0; b < 2; ++b)
#pragma unroll
            for (int m = 0; m < 4; ++m)
#pragma unroll
                for (int n = 0; n < 2; ++n) acc[a][b][m][n] = (f32x4){0.f, 0.f, 0.f, 0.f};
    bf16x8 At[4][2], B0[2][2], B1[2][2];
    const char* cA = (const char*)g.A; const char* cB = (const char*)g.Bt + cur.offB;
    if (tid < 256) gtab[tid] = (unsigned)rowtab[cur.pm * 256 + tid] * (unsigned)(g.lda * 2);
    asm volatile("s_waitcnt vmcnt(0) lgkmcnt(0)" ::: "memory"); __builtin_amdgcn_s_barrier(); asm volatile("" ::: "memory");
    int cb = 0;
    PG8_STAGE(PG8_SB(0, 0), cB, voffB); PG8_STAGE(PG8_SB(0, 1), cB + hstepB, voffB); PG8_STAGE_A(PG8_SA(0, 0), cA, 0, cb); PG8_STAGE_A(PG8_SA(0, 1), cA, 1, cb);
    if (wr == 1) PG8_BAR;
    PG8_WAIT_V(2); PG8_BAR;
    PG8_STAGE(PG8_SB(1, 0), cB + kstep, voffB); PG8_STAGE_A(PG8_SA(1, 0), cA + kstep, 0, cb); PG8_STAGE(PG8_SB(1, 1), cB + hstepB + kstep, voffB);
    PG8_WAIT_V(6); PG8_BAR;
    for (;;) {
        const bool has_next = S.next(ui + 1, nxt);
        const char* nA = cA; const char* nB = has_next ? (const char*)g.Bt + nxt.offB : cB;
        if (has_next && tid < 256) gtab[(cb ^ 1) * 256 + tid] = (unsigned)rowtab[nxt.pm * 256 + tid] * (unsigned)(g.lda * 2);
        const int nbq = has_next ? (cb ^ 1) : cb;
        for (int t = 0; t < nt; t += 2) {
            const bool last = (t == nt - 2);
            const char* a1 = cA + (size_t)(t + 1) * kstep; const int tb2 = last ? nbq : cb;
            const char* a2 = last ? nA : cA + (size_t)(t + 2) * kstep; const char* b2 = last ? nB : cB + (size_t)(t + 2) * kstep;
            const char* a3 = a2 + kstep; const char* b3 = b2 + kstep;
            PG8_LDB(B0, 0, 0); PG8_LDB(B1, 0, 1); PG8_SCHED; PG8_LDA(At, 0, 0); PG8_STAGE_A(PG8_SA(1, 1), a1, 1, cb);
            PG8_WAIT_V(8); PG8_WAIT_L(0); PG8_BAR; PG8_MMA(0, 0, At, B0); PG8_MMA(0, 1, At, B1); PG8_BAR; PG8_SCHED;
            PG8_LDA(At, 0, 1); PG8_STAGE(PG8_SB(0, 0), b2, voffB); PG8_STAGE(PG8_SB(0, 1), b2 + hstepB, voffB); PG8_STAGE_A(PG8_SA(0, 0), a2, 0, tb2);
            PG8_WAIT_V(8); PG8_WAIT_L(0); PG8_BAR; PG8_MMA(1, 0, At, B0); PG8_MMA(1, 1, At, B1); PG8_BAR; PG8_SCHED;
            PG8_LDB(B0, 1, 0); PG8_LDB(B1, 1, 1); PG8_SCHED; PG8_LDA(At, 1, 0); PG8_STAGE_A(PG8_SA(0, 1), a2, 1, tb2);
            PG8_WAIT_V(8); PG8_WAIT_L(0); PG8_BAR; PG8_MMA(0, 0, At, B0); PG8_MMA(0, 1, At, B1); PG8_BAR; PG8_SCHED;
            PG8_LDA(At, 1, 1); PG8_STAGE(PG8_SB(1, 0), b3, voffB); PG8_STAGE(PG8_SB(1, 1), b3 + hstepB, voffB); PG8_STAGE_A(PG8_SA(1, 0), a3, 0, tb2);
            PG8_WAIT_V(8); PG8_WAIT_L(0); PG8_BAR; PG8_MMA(1, 0, At, B0); PG8_MMA(1, 1, At, B1); PG8_BAR; PG8_SCHED;
        }
        if constexpr (ALIGN_EPI) { if (wr == 0) PG8_BAR; }
        { int l2; asm volatile("v_mbcnt_lo_u32_b32 %0, -1, 0\n\tv_mbcnt_hi_u32_b32 %0, -1, %0" : "=v"(l2)); E(acc, cur, wr, wc, l2 & 15, l2 >> 4); }
        if (!has_next) break;
#pragma unroll
        for (int a = 0; a < 2; ++a)
#pragma unroll
            for (int b = 0; b < 2; ++b)
#pragma unroll
                for (int m = 0; m < 4; ++m)
#pragma unroll
                    for (int n = 0; n < 2; ++n) acc[a][b][m][n] = (f32x4){0.f, 0.f, 0.f, 0.f};
        cur = nxt; cA = nA; cB = nB; ++ui; cb ^= 1;
        if constexpr (ALIGN_EPI) { if (wr == 1) PG8_BAR; }
    }
    PG8_WAIT_V(0);
    if constexpr (!ALIGN_EPI) { if (wr == 0) PG8_BAR; }
    PG8_BAR;
#undef PG8_SA
#undef PG8_SB
#undef PG8_STAGE
#undef PG8_LDA
#undef PG8_LDB
#undef PG8_MMA
#undef PG8_STAGE_A
#undef PG8_WAIT_V
#undef PG8_WAIT_L
#undef PG8_BAR
#undef PG8_SCHED
}
}

constexpr size_t MiB = 1u << 20;
constexpr size_t WS_CTL = 0, CTL_ZERO_BYTES = 1 * MiB;
constexpr size_t WS_SSQ = 1 * MiB;
constexpr size_t WS_WR = 9 * MiB, WS_WK = 11 * MiB, WS_WV = 13 * MiB, WS_WO0 = 15 * MiB;
constexpr size_t WS_WPQ = 17 * MiB;
constexpr size_t WS_WL2 = 18 * MiB;
constexpr size_t WS_SBQKV = 20 * MiB, WS_SBWO = 26 * MiB;
constexpr size_t WS_XAWQ = 28 * MiB, WS_XAWO = 32 * MiB, WS_XAWKV = 36 * MiB;
constexpr size_t WS_ROUTE = 40 * MiB;
constexpr size_t WS_W13 = 41 * MiB;
constexpr size_t WS_W2 = 105 * MiB;
constexpr size_t WS_MEMN = 137 * MiB, WS_MEMK = 153 * MiB, WS_MEMVT = 169 * MiB;
constexpr size_t WS_HB = 185 * MiB;
constexpr size_t WS_ARENA = 313 * MiB;
constexpr size_t WS_LOGIT = WS_ARENA + 512 * MiB;
constexpr size_t WS_TOKE = WS_LOGIT + 16 * MiB, WS_TOKP = WS_TOKE + 512 * 1024, WS_TOKW = WS_TOKE + 1 * MiB, WS_TOKS = WS_TOKW + 512 * 1024;
constexpr size_t WS_ROWTAB = WS_TOKE + 4 * MiB;
constexpr size_t WS_GATE = WS_TOKE + 2 * MiB;
constexpr size_t BUF = (size_t)T * DM * 2;
constexpr size_t HBUF = BUF / NGRP;
constexpr size_t WS_BONUS = WS_ARENA + 11 * HBUF;
constexpr size_t WS_END = WS_BONUS + 2 * MiB;   static_assert(WS_ROWTAB + 1 * MiB <= WS_BONUS && WS_END <= 1024 * MiB && (size_t)TG * 16 * 4 <= 2 * MiB, "workspace");
static_assert((size_t)MAXSLOT * 8 <= 2 * MiB, "gate table");
constexpr int CW_BAR = 4096;
constexpr int CW_CNT = 16384;
constexpr int CW_STQ = 32768;

constexpr int RING_BYTES = 131072;
constexpr int LDSCTL_OFF = RING_BYTES;
constexpr int LDS_XB = LDSCTL_OFF;
constexpr int LDS_TOFF = LDSCTL_OFF + 3072;
constexpr int LDS_FLAGS = LDSCTL_OFF + 256;
constexpr int LDS_HIST = LDSCTL_OFF + 512;
constexpr int LDS_INP = LDSCTL_OFF + 1024;
constexpr int LDS_TEXP = LDSCTL_OFF + 2048;
constexpr int LDS_GTAB = LDSCTL_OFF + 12288;
constexpr int LDS_SM = LDSCTL_OFF + 4096;
constexpr int LDS_YB = LDSCTL_OFF + 4096;
constexpr int LDS_SSQP = LDSCTL_OFF + 16384;
constexpr int LDS_BYTES = 163840;

#define RLX_AGENT __ATOMIC_RELAXED, __HIP_MEMORY_SCOPE_AGENT

#define XB_TMO      128
#define XB_XCNT(j)  (256  + 64 * (j))
#define XB_XSUB(j)  (1280 + 64 * (j))
#define XB_XGEN(j)  (2304 + 64 * (j))
#define XB_TOP      3328
#define XB_TOPGEN   3392
#define XCD_BAR_WORDS 3456
#define XB_SPIN_CAP (1u << 18)
__device__ __forceinline__ unsigned xb_ld(unsigned* p)              { return __hip_atomic_load(p, __ATOMIC_RELAXED, __HIP_MEMORY_SCOPE_AGENT); }
__device__ __forceinline__ unsigned xb_add(unsigned* p, unsigned v) { return __hip_atomic_fetch_add(p, v, __ATOMIC_RELAXED, __HIP_MEMORY_SCOPE_AGENT); }
__device__ __forceinline__ unsigned xb_xcc_id() { return (unsigned)__builtin_amdgcn_s_getreg((3 << 11) | 20) & 0xFu; }
#define XB_SPIN(cond, bar) do { unsigned _sp = 0; while (cond) { __builtin_amdgcn_s_sleep(1); \
    if ((++_sp & 255u) == 0u) { if (xb_ld(&(bar)[XB_TMO])) break; if (_sp > XB_SPIN_CAP) { atomicAdd(&(bar)[XB_TMO], 1u); break; } } } } while (0)
struct XcdBarrier { unsigned* bar; unsigned x; volatile LAS unsigned* st; };
__device__ __forceinline__ XcdBarrier xcd_barrier_post(unsigned* bar, volatile LAS unsigned* st) {
    XcdBarrier b; b.bar = bar; b.x = xb_xcc_id(); b.st = st;
    if (threadIdx.x == 0) (void)xb_add(&bar[XB_XCNT(b.x)], 1u);
    return b;
}
__device__ __forceinline__ void xcd_barrier_complete(unsigned* bar, unsigned x, unsigned& nloc, unsigned& nx) {
    const unsigned G = gridDim.x * gridDim.y * gridDim.z;
    unsigned sum, cnt, mine, sp = 0u;
    for (;;) {
        sum = 0u; cnt = 0u; mine = 0u;
#pragma unroll
        for (unsigned j = 0; j < 16; ++j) { const unsigned c = xb_ld(&bar[XB_XCNT(j)]); sum += c; cnt += (c > 0u) ? 1u : 0u; mine = (j == x) ? c : mine; }
        if (sum == G) break;
        __builtin_amdgcn_s_sleep(1);
        if ((++sp & 255u) == 0u) { if (xb_ld(&bar[XB_TMO])) break; if (sp > XB_SPIN_CAP) { atomicAdd(&bar[XB_TMO], 1u); break; } }
    }
    nloc = mine > 0u ? mine : 1u; nx = cnt > 0u ? cnt : 1u;
}
__device__ __forceinline__ void xcd_barrier(const XcdBarrier& b) {
    asm volatile("s_waitcnt vmcnt(0)" ::: "memory");
    __syncthreads();
    if (threadIdx.x == 0) {
        unsigned* bar = b.bar;
        __builtin_amdgcn_s_waitcnt(0);
        unsigned nloc = b.st[0], nx = b.st[1];
        if (nloc == 0u) { xcd_barrier_complete(bar, b.x, nloc, nx); b.st[0] = nloc; b.st[1] = nx; }
        const unsigned old = xb_add(&bar[XB_XSUB(b.x)], 1u);
        const unsigned gen = old / nloc;
        if (old + 1u == (gen + 1u) * nloc) {
            __builtin_amdgcn_fence(__ATOMIC_RELEASE, "agent");
            asm volatile("s_waitcnt vmcnt(0)" ::: "memory");
            const unsigned og = xb_add(&bar[XB_TOP], 1u);
            const unsigned tg = og / nx;
            if (og + 1u == (tg + 1u) * nx) xb_add(&bar[XB_TOPGEN], 1u);
            else XB_SPIN(xb_ld(&bar[XB_TOPGEN]) == tg, bar);
            __builtin_amdgcn_fence(__ATOMIC_ACQUIRE, "agent");
            xb_add(&bar[XB_XGEN(b.x)], 1u);
            asm volatile("s_waitcnt vmcnt(0)" ::: "memory");
        } else {
            XB_SPIN(xb_ld(&bar[XB_XGEN(b.x)]) == gen, bar);
            __builtin_amdgcn_fence(__ATOMIC_ACQUIRE, "agent");
            asm volatile("s_waitcnt vmcnt(0)" ::: "memory");
        }
    }
    __syncthreads();
}

__device__ __forceinline__ unsigned f2bf(float f) { unsigned u = __builtin_bit_cast(unsigned, f); return (u + 0x7fffu + ((u >> 16) & 1u)) >> 16; }
__device__ __forceinline__ unsigned pk2(float lo, float hi) { return f2bf(lo) | (f2bf(hi) << 16); }
__device__ __forceinline__ float bflo(unsigned w) { return __uint_as_float(w << 16); }
__device__ __forceinline__ float bfhi(unsigned w) { return __uint_as_float(w & 0xffff0000u); }
__device__ __forceinline__ f32x4 unpack4(u32x2 w) { return (f32x4){bflo(w.x), bfhi(w.x), bflo(w.y), bfhi(w.y)}; }
__device__ __forceinline__ u32x2 pack4(f32x4 v) { u32x2 w; w.x = pk2(v[0], v[1]); w.y = pk2(v[2], v[3]); return w; }
template <int CTRL> __device__ __forceinline__ float dppf(float v) { return __uint_as_float((unsigned)__builtin_amdgcn_update_dpp(0, (int)__float_as_uint(v), CTRL, 0xF, 0xF, true)); }
__device__ __forceinline__ float sum4(float v) { v += dppf<0xB1>(v); v += dppf<0x4E>(v); return v; }
__device__ __forceinline__ float sum8(float v) { v = sum4(v); v += dppf<0x141>(v); return v; }
__device__ __forceinline__ float sum16(float v) { v = sum8(v); v += dppf<0x140>(v); return v; }
__device__ __forceinline__ float rdlane(float v, int l) { return __int_as_float(__builtin_amdgcn_readlane(__float_as_int(v), l)); }
__device__ __forceinline__ float wave_sum(float v) { v = sum16(v); return (rdlane(v, 0) + rdlane(v, 16)) + (rdlane(v, 32) + rdlane(v, 48)); }
__device__ __forceinline__ float wave_max(float v) { v = fmaxf(v, dppf<0xB1>(v)); v = fmaxf(v, dppf<0x4E>(v)); v = fmaxf(v, dppf<0x141>(v)); v = fmaxf(v, dppf<0x140>(v));
    return fmaxf(fmaxf(rdlane(v, 0), rdlane(v, 16)), fmaxf(rdlane(v, 32), rdlane(v, 48))); }
__device__ __forceinline__ float sigm(float x) { return __builtin_amdgcn_rcpf(1.f + __expf(-x)); }

struct Ctx { int wave, bid, G, gw, NGW; };
__device__ __forceinline__ int lane_id() { int l; asm volatile("v_mbcnt_lo_u32_b32 %0, -1, 0\n\tv_mbcnt_hi_u32_b32 %0, -1, %0" : "=v"(l)); return l; }
#define PHASE_IDS const int lane = lane_id(); const int tid = c.wave * 64 + lane; (void)tid; (void)lane

__device__ __forceinline__ void store_pair16(bf16_t* p, int hh, u32x2 a, u32x2 b) {
    const auto x = __builtin_amdgcn_permlane32_swap(a.x, b.x, false, false), y = __builtin_amdgcn_permlane32_swap(a.y, b.y, false, false);
    u32x4 w; w.x = x[0]; w.y = y[0]; w.z = x[1]; w.w = y[1];
    *(u32x4*)(p + 4 * hh) = w;
}
__device__ __forceinline__ void tr_block(const float* W, int ldw, int k0, int n0, bf16_t* WT, int ldt, int drow0, LAS float* scr, int lane, const float* s, int mode) {
    LAS unsigned* Tw = (LAS unsigned*)scr; const int kq = lane >> 4, n4 = (lane & 15) * 4;
    f32x4 v0[8], v1[8];
#pragma unroll
    for (int i = 0; i < 8; ++i) { const float* p = W + (size_t)(k0 + 8 * i + 2 * kq) * ldw + n0 + n4; v0[i] = *(const f32x4*)p; v1[i] = *(const f32x4*)(p + ldw); }
    if (mode) {
#pragma unroll
        for (int i = 0; i < 8; ++i) { float m0 = s[k0 + 8 * i + 2 * kq], m1 = s[k0 + 8 * i + 2 * kq + 1]; if (mode == 1) { m0 = 1.f - m0; m1 = 1.f - m1; } v0[i] *= m0; v1[i] *= m1; }
    }
#pragma unroll
    for (int i = 0; i < 8; ++i)
#pragma unroll
        for (int e = 0; e < 4; ++e) Tw[(n4 + e) * 33 + 4 * i + kq] = pk2(v0[i][e], v1[i][e]);
    asm volatile("s_waitcnt lgkmcnt(0)" ::: "memory");
    const int nr = lane >> 3, kc = lane & 7;
#pragma unroll
    for (int j = 0; j < 8; ++j) { const int n = nr + 8 * j; const LAS unsigned* p = Tw + n * 33 + 4 * kc;
        u32x4 o; o.x = p[0]; o.y = p[1]; o.z = p[2]; o.w = p[3];
        *(u32x4*)(WT + (size_t)(drow0 + n) * ldt + k0 + 8 * kc) = o; }
    asm volatile("s_waitcnt lgkmcnt(0)" ::: "memory");
}
__device__ __forceinline__ void cp_item(const float* W, int N, bf16_t* WN, int item, int lane, const float* s) {
    const int nblk = N / 64, k0 = 64 * (item / nblk), n0 = 64 * (item % nblk), kq = lane >> 4, n4 = (lane & 15) * 4;
    f32x4 v[16];
#pragma unroll
    for (int i = 0; i < 16; ++i) v[i] = __builtin_nontemporal_load((const f32x4*)(W + (size_t)(k0 + 4 * i + kq) * N + n0 + n4));
#pragma unroll
    for (int i = 0; i < 16; ++i) *(u32x2*)(WN + (size_t)(k0 + 4 * i + kq) * N + n0 + n4) = pack4(v[i] * s[k0 + 4 * i + kq]);
}
__device__ __forceinline__ void tr_item(const float* W, int K, int N, bf16_t* WT, int drow, LAS float* scr, int item, int lane, const float* s = nullptr, int mode = 0) {
    const int nblk = N / 64, kb = item / nblk, nb = item % nblk;
    tr_block(W, N, 64 * kb, 64 * nb, WT, K, drow + 64 * nb, scr, lane, s, mode);
}

struct In {
    const float *x, *mem, *norm_mix, *norm_cross, *norm_ffn, *norm_mem, *norm_final;
    const float *rw_mix, *rw_wr, *rw_wk, *rw_wv, *rw_w0, *rw_w1, *rw_w2, *rw_a0, *rw_a1, *rw_a2, *rw_g1, *rw_g2, *rw_kk, *rw_ka, *rw_rk, *rw_lnx_w, *rw_lnx_b, *rw_wo;
    const float *sb_wqkv, *sb_wo, *xa_wq, *xa_wkv, *xa_wo, *moe_wg, *moe_bg, *moe_we, *moe_be, *moe_w1, *moe_w3, *moe_w2;
};
struct Args { In in; float* out; unsigned char* ws; int ph_lo, ph_hi; };
struct InL { const LAS unsigned long long* p;
    __device__ __forceinline__ const float* get(int i) const { const unsigned long long v = p[i]; const unsigned lo = __builtin_amdgcn_readfirstlane((unsigned)v), hi = __builtin_amdgcn_readfirstlane((unsigned)(v >> 32)); return (const float*)(((unsigned long long)hi << 32) | lo); } };
#define IN(name) (in.get((int)(offsetof(In, name) / 8)))

__device__ __forceinline__ void rms_row_to_bf16(const float* xrow, const float* gain, bf16_t* orow, int lane) {
    const f32x4* xr = (const f32x4*)xrow + lane; f32x4 v[4]; float s = 0.f;
#pragma unroll
    for (int j = 0; j < 4; ++j) { v[j] = xr[64 * j]; s += (v[j].x * v[j].x + v[j].y * v[j].y) + (v[j].z * v[j].z + v[j].w * v[j].w); }
    const float rs = rsqrtf(wave_sum(s) * (1.f / DM) + NORM_EPS);
#pragma unroll
    for (int j = 0; j < 4; ++j) { const f32x4 g = gain ? ((const f32x4*)gain)[lane + 64 * j] : (f32x4){1.f, 1.f, 1.f, 1.f}; ((u32x2*)orow)[lane + 64 * j] = pack4(v[j] * rs * g); }
}

__device__ __forceinline__ void p_prologue(const Ctx& c, const InL& in, unsigned char* ws, LAS unsigned char* lds) {
    PHASE_IDS;
    LAS float* scr = (LAS float*)(lds + c.wave * 16384);
    constexpr int I_SQ = 16 * 16;
    constexpr int I_QKV = 16 * 48, I_KV = 16 * 32;
    constexpr int I_L64 = 16 * 1, I_L128 = 16 * 2;
    constexpr int I_M13 = 16 * 4;
    constexpr int I_M2 = 4 * 16;
    constexpr int NITEMS = 4 * I_SQ + 2 * (2 * I_L64 + I_L128) + I_QKV + I_SQ + 4 * I_SQ + I_KV + 2 * 64 * I_M13 + 64 * I_M2;
    for (int it = c.gw; it < NITEMS; it += c.NGW) {
        int r = it;
        if (r < I_SQ) { tr_item(IN(rw_wr), DM, DM, (bf16_t*)(ws + WS_WR), 0, scr, r, lane); continue; } r -= I_SQ;
        if (r < I_SQ) { tr_item(IN(rw_wk), DM, DM, (bf16_t*)(ws + WS_WK), 0, scr, r, lane); continue; } r -= I_SQ;
        if (r < I_SQ) { tr_item(IN(rw_wv), DM, DM, (bf16_t*)(ws + WS_WV), 0, scr, r, lane); continue; } r -= I_SQ;
        if (r < I_SQ) { tr_item(IN(rw_wo), DM, DM, (bf16_t*)(ws + WS_WO0), 0, scr, r, lane); continue; } r -= I_SQ;
        if (r < 2 * (2 * I_L64 + I_L128)) {
            const int q = r / (2 * I_L64 + I_L128), rr = r % (2 * I_L64 + I_L128); const int mode = 1 + q; bf16_t* WT = (bf16_t*)(ws + WS_WPQ);
            if (rr < I_L64) tr_item(IN(rw_w1), DM, 64, WT, 256 * q + 0, scr, rr, lane, IN(rw_mix) + 1 * DM, mode);
            else if (rr < 2 * I_L64) tr_item(IN(rw_a1), DM, 64, WT, 256 * q + 64, scr, rr - I_L64, lane, IN(rw_mix) + 4 * DM, mode);
            else tr_item(IN(rw_g1), DM, 128, WT, 256 * q + 128, scr, rr - 2 * I_L64, lane, IN(rw_mix) + 5 * DM, mode);
            continue; } r -= 2 * (2 * I_L64 + I_L128);
        if (r < I_QKV) { tr_item(IN(sb_wqkv), DM, 3 * DM, (bf16_t*)(ws + WS_SBQKV), 0, scr, r, lane, IN(norm_mix) + DM, 2); continue; } r -= I_QKV;
        if (r < I_SQ) { tr_item(IN(sb_wo), DM, DM, (bf16_t*)(ws + WS_SBWO), 0, scr, r, lane); continue; } r -= I_SQ;
        if (r < 2 * I_SQ) { const int l = r / I_SQ; cp_item(IN(xa_wq) + (size_t)l * DM * DM, DM, (bf16_t*)(ws + WS_XAWQ) + (size_t)l * DM * DM, r % I_SQ, lane, IN(norm_cross) + l * DM); continue; } r -= 2 * I_SQ;
        if (r < 2 * I_SQ) { const int l = r / I_SQ; tr_item(IN(xa_wo) + (size_t)l * DM * DM, DM, DM, (bf16_t*)(ws + WS_XAWO) + (size_t)l * DM * DM, 0, scr, r % I_SQ, lane); continue; } r -= 2 * I_SQ;
        if (r < I_KV) { tr_item(IN(xa_wkv), DM, 2 * DM, (bf16_t*)(ws + WS_XAWKV), 0, scr, r, lane); continue; } r -= I_KV;
        if (r < 2 * 64 * I_M13) {
            const int which = r / (64 * I_M13), rr = r % (64 * I_M13), le = rr / I_M13, item = rr % I_M13;
            const float* W = (which ? IN(moe_w3) : IN(moe_w1)) + (size_t)le * DM * DF; bf16_t* WT = (bf16_t*)(ws + WS_W13) + (size_t)le * 512 * DM;
            const int nblk = DF / 64, kb = item / nblk, nb = item % nblk, n0 = 64 * nb;
            tr_block(W, DF, 64 * kb, n0, WT, DM, (n0 / 128) * 256 + (n0 % 128) + which * 128, scr, lane, IN(norm_ffn) + (le / NE) * DM, 2);
            continue; } r -= 2 * 64 * I_M13;
        { const int le = r / I_M2, item = r % I_M2; tr_item(IN(moe_w2) + (size_t)le * DF * DM, DF, DM, (bf16_t*)(ws + WS_W2) + (size_t)le * DM * DF, 0, scr, item, lane); }
    }
    const int gt = c.bid * 512 + tid, NT = c.G * 512;
    for (int i = gt; i < 2 * 256 * DM; i += NT) { const int l = i / (256 * DM), n = (i / DM) % 256, k = i % DM; float v = 0.f;
        if (n < NG) v = IN(moe_wg)[((size_t)l * DM + k) * NG + n]; else if (n < NG + NE) v = IN(moe_we)[((size_t)l * DM + k) * NE + (n - NG)];
        ((bf16_t*)(ws + WS_ROUTE))[i] = (bf16_t)f2bf(v * IN(norm_ffn)[l * DM + k]); }
    for (int i = gt; i < 3072 * 256; i += NT) { const int n = i / 256, k = i % 256, t = n / 1024, nn = n % 1024; float v = 0.f;
        if (t == 0) { if (k < 64) v = IN(rw_w2)[(size_t)k * DM + nn]; } else if (t == 1) { if (k >= 64 && k < 128) v = IN(rw_a2)[(size_t)(k - 64) * DM + nn]; } else { if (k >= 128) v = IN(rw_g2)[(size_t)(k - 128) * DM + nn]; }
        ((bf16_t*)(ws + WS_WL2))[i] = (bf16_t)f2bf(v); }
    for (int m = c.gw; m < BATCH * NMEM; m += c.NGW) rms_row_to_bf16(IN(mem) + (size_t)m * DM, IN(norm_mem), (bf16_t*)(ws + WS_MEMN) + (size_t)m * DM, lane);
}

__device__ __forceinline__ void p_norm_shift(const Ctx& c, const InL& in, int g, bf16_t* hn, bf16_t* xr, bf16_t* xk, bf16_t* xv) {
    PHASE_IDS;
    const int NGW = c.G * 8; const float* xin = IN(x); const float* gnp = IN(norm_mix); const float* mixp = IN(rw_mix);
    for (int row0 = c.bid * 8 + c.wave; row0 < TG; row0 += 2 * NGW) {
        f32x4 v[2][4], p[2][4]; bool first[2];
#pragma unroll
        for (int q = 0; q < 2; ++q) { const int t = g * TG + row0 + q * NGW; first[q] = (t % SEQ) == 0;
            const f32x4* xc = (const f32x4*)(xin + (size_t)t * DM) + lane; const f32x4* xp = (const f32x4*)(xin + (size_t)(first[q] ? t : t - 1) * DM) + lane;
#pragma unroll
            for (int j = 0; j < 4; ++j) { v[q][j] = xc[64 * j]; p[q][j] = xp[64 * j]; } }
#pragma unroll
        for (int q = 0; q < 2; ++q) { const int row = row0 + q * NGW; float s = 0.f, sp = 0.f;
#pragma unroll
            for (int j = 0; j < 4; ++j) { s += (v[q][j].x * v[q][j].x + v[q][j].y * v[q][j].y) + (v[q][j].z * v[q][j].z + v[q][j].w * v[q][j].w); sp += (p[q][j].x * p[q][j].x + p[q][j].y * p[q][j].y) + (p[q][j].z * p[q][j].z + p[q][j].w * p[q][j].w); }
            const float rs = rsqrtf(wave_sum(s) * (1.f / DM) + NORM_EPS); const float rpv = rsqrtf(wave_sum(sp) * (1.f / DM) + NORM_EPS); const float rp = first[q] ? 0.f : rpv;
#pragma unroll
            for (int j = 0; j < 4; ++j) { const int ci = lane + 64 * j; const f32x4 gn = ((const f32x4*)gnp)[ci];
                const f32x4 h = v[q][j] * rs * gn, hp = p[q][j] * rp * gn, dx = hp - h;
                const f32x4 mr = ((const f32x4*)(mixp + 0 * DM))[ci], mk = ((const f32x4*)(mixp + 2 * DM))[ci], mv = ((const f32x4*)(mixp + 3 * DM))[ci];
                const size_t o = (size_t)row * (DM / 4) + ci;
                ((u32x2*)hn)[o] = pack4(h); ((u32x2*)xr)[o] = pack4(h + dx * mr); ((u32x2*)xk)[o] = pack4(h + dx * mk); ((u32x2*)xv)[o] = pack4(h + dx * mv); } }
    }
}
__device__ __forceinline__ void p_lora_act(const Ctx& c, const bf16_t* pq, bf16_t* act) {
    PHASE_IDS;
    for (int row = c.gw; row < TG; row += c.NGW) {
        const bool first = (row % SEQ) == 0;
        f32x4 u = unpack4(((const u32x2*)(pq + (size_t)row * 512))[lane]);
        if (!first) u += unpack4(((const u32x2*)(pq + (size_t)(row - 1) * 512 + 256))[lane]);
        f32x4 o;
#pragma unroll
        for (int e = 0; e < 4; ++e) { const float x = u[e]; o[e] = (lane < 16) ? (1.f - 2.f * __builtin_amdgcn_rcpf(1.f + __expf(2.f * x))) : (lane < 32 ? x : sigm(x)); }
        ((u32x2*)(act + (size_t)row * 256))[lane] = pack4(o);
    }
}
typedef _Float16 f16x8 __attribute__((ext_vector_type(8)));
typedef float f32x16 __attribute__((ext_vector_type(16)));
typedef __bf16 bf16x2_t __attribute__((ext_vector_type(2)));
__device__ __forceinline__ unsigned cvt2bf(float lo, float hi) { f32x2 v = {lo, hi}; bf16x2_t b = __builtin_convertvector(v, bf16x2_t); return __builtin_bit_cast(unsigned, b); }
__device__ __forceinline__ unsigned cvt2h(float lo, float hi) { return __builtin_bit_cast(unsigned, __builtin_amdgcn_cvt_pkrtz(lo, hi)); }
__device__ __forceinline__ bf16x8 frag144(const LAS unsigned char* img, int row, int s, int hh) { return *(const LAS bf16x8*)(img + row * 144 + s * 32 + hh * 16); }
__device__ __forceinline__ bf16x8 frag144s(const LAS unsigned char* img, int row, int s, int hh) { return *(const LAS bf16x8*)(img + row * 144 + (((2 * s + hh) ^ ((row >> 3) & 7)) << 4)); }
__device__ __forceinline__ void s1_solve(const Ctx& c, const LAS unsigned char* I_A, const LAS unsigned char* I_AB, const LAS unsigned char* TB, const LAS float* RZ, LAS unsigned char* AT, LAS unsigned char* I_XT) {
    constexpr int P = 144;
    const int ct = c.wave; LAS unsigned char* at = AT + ct * 512;
#pragma unroll
    for (int bb = 0; bb < 4; ++bb) {
        const int lane = lane_id(), c16 = lane & 15, g4 = lane >> 4, col = 16 * ct + c16;
        f32x4 d = (f32x4){0.f, 0.f, 0.f, 0.f};
        if (bb > 0) {
#pragma unroll
            for (int s = 0; s < (16 * bb + 31) / 32; ++s) {
                const bf16x8 a = *(const LAS bf16x8*)(I_AB + (16 * bb + c16) * P + s * 64 + g4 * 16), b = *(const LAS bf16x8*)(I_XT + col * P + s * 64 + g4 * 16);
                d = __builtin_amdgcn_mfma_f32_16x16x32_bf16(a, b, d, 0, 0, 0); }
        }
        if (ct < 4) {
#pragma unroll
            for (int e = 0; e < 4; ++e) d[e] += __uint_as_float(((unsigned)*(const LAS unsigned short*)(I_A + (16 * bb + 4 * g4 + e) * P + col * 2)) << 16);
        } else {
#pragma unroll
            for (int e = 0; e < 4; ++e) d[e] += RZ[(16 * bb + 4 * g4 + e) * 68 + (col - 64)];
        }
        { u32x2 w; w.x = cvt2bf(d[0], d[1]); w.y = cvt2bf(d[2], d[3]); *(LAS u32x2*)(at + c16 * 32 + 8 * g4) = w; }
        asm volatile("s_waitcnt lgkmcnt(0)" ::: "memory");
        u32x4 bw = *(const LAS u32x4*)(at + c16 * 32 + 16 * (g4 & 1)); if (g4 >= 2) bw = (u32x4){0u, 0u, 0u, 0u};
        const bf16x8 a2 = *(const LAS bf16x8*)(TB + bb * 1024 + c16 * 64 + g4 * 16);
        const f32x4 x = __builtin_amdgcn_mfma_f32_16x16x32_bf16(a2, __builtin_bit_cast(bf16x8, bw), (f32x4){0.f, 0.f, 0.f, 0.f}, 0, 0, 0);
        { u32x2 w; w.x = cvt2bf(x[0], x[1]); w.y = cvt2bf(x[2], x[3]); *(LAS u32x2*)(I_XT + col * P + (16 * bb + 4 * g4) * 2) = w; }
        asm volatile("s_waitcnt lgkmcnt(0)" ::: "memory");
    }
}
__device__ __forceinline__ void s1_tinv(const LAS float* ADG, LAS unsigned char* TB) {
    const int lane = lane_id(), bq = lane >> 4, jc = lane & 15;
    float x[16];
#pragma unroll
    for (int ii = 0; ii < 16; ++ii) {
        const LAS f32x4* ar = (const LAS f32x4*)(ADG + bq * 256 + ii * 16); const f32x4 a0 = ar[0], a1 = ar[1], a2 = ar[2], a3 = ar[3];
        const float av[16] = {a0[0], a0[1], a0[2], a0[3], a1[0], a1[1], a1[2], a1[3], a2[0], a2[1], a2[2], a2[3], a3[0], a3[1], a3[2], a3[3]};
        float v = (ii == jc) ? 1.f : 0.f;
#pragma unroll
        for (int jj = 0; jj < ii; ++jj) v += av[jj] * x[jj];
        x[ii] = v;
        *(LAS unsigned short*)(TB + bq * 1024 + ii * 64 + jc * 2) = (unsigned short)f2bf(v);
    }
    *(LAS u32x4*)(TB + bq * 1024 + jc * 64 + 32) = (u32x4){0u, 0u, 0u, 0u}; *(LAS u32x4*)(TB + bq * 1024 + jc * 64 + 48) = (u32x4){0u, 0u, 0u, 0u};
}
__device__ __forceinline__ void p_scan_s1(const Ctx& c, const InL& in, const bf16_t* R, const bf16_t* Kb, const bf16_t* Vb, const bf16_t* WL, const bf16_t* Ab,
                                          bf16_t* RH, bf16_t* YL, bf16_t* MM, bf16_t* NT, float* bonus, LAS unsigned char* lds) {
    PHASE_IDS;
    constexpr int P = 144, IMG = 64 * P;
    LAS unsigned char* I_R = lds; LAS unsigned char* I_BT = lds + IMG; LAS unsigned char* I_KT = lds + 2 * IMG; LAS unsigned char* I_VT = lds + 3 * IMG;
    LAS unsigned char* I_AK = lds + 4 * IMG; LAS unsigned char* I_RB = lds + 5 * IMG; LAS unsigned char* I_RK = lds + 6 * IMG;
    LAS unsigned char* I_A = lds + 7 * IMG; LAS unsigned char* I_B = lds + 8 * IMG; LAS unsigned char* I_K = lds + 9 * IMG; LAS unsigned char* I_XT = I_B;
    LAS float* A4 = (LAS float*)(lds + 10 * IMG);
    LAS unsigned char* I_AB = lds + 10 * IMG; LAS float* ADG = (LAS float*)(lds + 10 * IMG + IMG); LAS unsigned char* TB = lds + 10 * IMG + IMG + 4096;
    LAS unsigned char* AT = I_AK;
    LAS float* RZ = (LAS float*)(lds + 10 * IMG + 17408);
    LAS float* PL = (LAS float*)(lds + 10 * IMG + 2 * 17408);
    LAS float* TOT = PL + 64;
    u32x4 nrw, nkw, nvw, nww, naw;
#define S1_LOAD(uu) do { const int ch_ = (uu) % (SEQ / 64), h_ = ((uu) / (SEQ / 64)) % NH, bl_ = (uu) / ((SEQ / 64) * NH); \
        const size_t off_ = ((size_t)(bl_ * SEQ + ch_ * 64 + (tid >> 3))) * DM + h_ * HD + (tid & 7) * 8; \
        nrw = *(const u32x4*)(R + off_); nkw = *(const u32x4*)(Kb + off_); nvw = *(const u32x4*)(Vb + off_); nww = *(const u32x4*)(WL + off_); naw = *(const u32x4*)(Ab + off_); } while (0)
    if (c.bid < BG * NH * (SEQ / 64)) S1_LOAD(c.bid);
    for (int u = c.bid; u < BG * NH * (SEQ / 64); u += c.G) {
        const int ch = u % (SEQ / 64), h = (u / (SEQ / 64)) % NH, bl = u / ((SEQ / 64) * NH);
        __syncthreads();
        {
            const int lane = lane_id(), tid = c.wave * 64 + lane;
            const int i = tid >> 3, n8 = (tid & 7) * 8;
            const u32x4 rw = nrw, kw = nkw, vw = nvw, ww = nww, aw = naw;
            float rr[8] = {bflo(rw.x), bfhi(rw.x), bflo(rw.y), bfhi(rw.y), bflo(rw.z), bfhi(rw.z), bflo(rw.w), bfhi(rw.w)};
            float kx[8] = {bflo(kw.x), bfhi(kw.x), bflo(kw.y), bfhi(kw.y), bflo(kw.z), bfhi(kw.z), bflo(kw.w), bfhi(kw.w)};
            float wx[8] = {bflo(ww.x), bfhi(ww.x), bflo(ww.y), bfhi(ww.y), bflo(ww.z), bfhi(ww.z), bflo(ww.w), bfhi(ww.w)};
            float ax[8] = {bflo(aw.x), bfhi(aw.x), bflo(aw.y), bfhi(aw.y), bflo(aw.z), bfhi(aw.z), bflo(aw.w), bfhi(aw.w)};
            const float* pkk = IN(rw_kk) + h * HD + n8; const float* pka = IN(rw_ka) + h * HD + n8;
            float kk[8], kp[8], bb[8]; float ssq = 0.f;
#pragma unroll
            for (int e = 0; e < 8; ++e) { kk[e] = kx[e] * pkk[e]; ssq += kk[e] * kk[e]; kp[e] = kx[e] * (1.f + (ax[e] - 1.f) * pka[e]); }
            ssq = sum8(ssq); const float inv = 1.f / fmaxf(sqrtf(ssq), 1e-12f);
            { const float* prk = IN(rw_rk) + h * HD + n8; float bo = 0.f;
#pragma unroll
              for (int e = 0; e < 8; ++e) bo += rr[e] * kp[e] * prk[e];
              bo = sum8(bo); if ((tid & 7) == 0) bonus[(size_t)(bl * SEQ + ch * 64 + i) * NH + h] = bo; }
#pragma unroll
            for (int e = 0; e < 8; ++e) { kk[e] *= inv; bb[e] = kk[e] * ax[e]; }
            LAS float* CW = A4;
            *(LAS f32x4*)(CW + i * 64 + n8) = (f32x4){wx[0], wx[1], wx[2], wx[3]}; *(LAS f32x4*)(CW + i * 64 + n8 + 4) = (f32x4){wx[4], wx[5], wx[6], wx[7]};
            __syncthreads();
            { const int n = tid & 63, seg = tid >> 6; float acc = 0.f;
#pragma unroll
              for (int e = 0; e < 8; ++e) { acc += CW[(8 * seg + e) * 64 + n]; CW[(8 * seg + e) * 64 + n] = acc; }
              TOT[seg * 64 + n] = acc; }
            __syncthreads();
            float cw[8];
            { const f32x4 c0 = *(const LAS f32x4*)(CW + i * 64 + n8), c1 = *(const LAS f32x4*)(CW + i * 64 + n8 + 4);
              cw[0] = c0.x; cw[1] = c0.y; cw[2] = c0.z; cw[3] = c0.w; cw[4] = c1.x; cw[5] = c1.y; cw[6] = c1.z; cw[7] = c1.w;
              const int seg = i >> 3;
              for (int sp = 0; sp < seg; ++sp) { const f32x4 t0 = *(const LAS f32x4*)(TOT + sp * 64 + n8), t1 = *(const LAS f32x4*)(TOT + sp * 64 + n8 + 4);
                  cw[0] += t0.x; cw[1] += t0.y; cw[2] += t0.z; cw[3] += t0.w; cw[4] += t1.x; cw[5] += t1.y; cw[6] += t1.z; cw[7] += t1.w; } }
            float at[8], bt[8], kt[8], rt[8];
#pragma unroll
            for (int e = 0; e < 8; ++e) { const float ein = __expf(cw[e]), eex = __expf(cw[e] - wx[e]), eng = __expf(-cw[e]);
                at[e] = -kk[e] * eex; bt[e] = bb[e] * eng; kt[e] = kp[e] * eng; rt[e] = rr[e] * ein; if (i == 63) PL[n8 + e] = ein; }
            u32x4 w;
            w.x = cvt2bf(at[0], at[1]); w.y = cvt2bf(at[2], at[3]); w.z = cvt2bf(at[4], at[5]); w.w = cvt2bf(at[6], at[7]); *(LAS u32x4*)(I_A + i * P + n8 * 2) = w;
            w.x = cvt2bf(rt[0], rt[1]); w.y = cvt2bf(rt[2], rt[3]); w.z = cvt2bf(rt[4], rt[5]); w.w = cvt2bf(rt[6], rt[7]); *(LAS u32x4*)(I_R + i * P + n8 * 2) = w;
            u32x4 wb, wk;
            wb.x = cvt2bf(bt[0], bt[1]); wb.y = cvt2bf(bt[2], bt[3]); wb.z = cvt2bf(bt[4], bt[5]); wb.w = cvt2bf(bt[6], bt[7]); *(LAS u32x4*)(I_B + i * P + n8 * 2) = wb;
            wk.x = cvt2bf(kt[0], kt[1]); wk.y = cvt2bf(kt[2], kt[3]); wk.z = cvt2bf(kt[4], kt[5]); wk.w = cvt2bf(kt[6], kt[7]); *(LAS u32x4*)(I_K + i * P + n8 * 2) = wk;
            const unsigned tb[4] = {wb.x, wb.y, wb.z, wb.w}, tk[4] = {wk.x, wk.y, wk.z, wk.w}, tv[4] = {vw.x, vw.y, vw.z, vw.w};
#pragma unroll
            for (int e = 0; e < 8; ++e) { const int sh = (e & 1) * 16; const int ro = (n8 + e) * P + ((((i >> 3) ^ ((n8 >> 3) & 7)) << 4) | ((i & 7) * 2));
                *(LAS unsigned short*)(I_BT + ro) = (unsigned short)(tb[e >> 1] >> sh); *(LAS unsigned short*)(I_KT + ro) = (unsigned short)(tk[e >> 1] >> sh); *(LAS unsigned short*)(I_VT + ro) = (unsigned short)(tv[e >> 1] >> sh); }
        }
        __syncthreads();
        {
            const int lane = lane_id(), r = lane & 31, hh = lane >> 5;
            const int combo = c.wave >> 1, jt = c.wave & 1;
            const LAS unsigned char* Ximg = (combo & 1) ? I_K : I_B; const LAS unsigned char* Yimg = (combo >> 1) ? I_R : I_A;
            LAS unsigned char* Oimg = (combo == 1) ? I_AK : (combo == 2 ? I_RB : I_RK);
            const bool incl = combo >= 2;
#pragma unroll
            for (int tt = 0; tt < 2; ++tt) {
                f32x16 d;
#pragma unroll
                for (int e = 0; e < 16; ++e) d[e] = 0.f;
                if (tt >= jt) {
#pragma unroll
                    for (int s = 0; s < 4; ++s) d = __builtin_amdgcn_mfma_f32_32x32x16_bf16(frag144(Ximg, 32 * jt + r, s, hh), frag144(Yimg, 32 * tt + r, s, hh), d, 0, 0, 0);
                }
                const int t = 32 * tt + r;
#pragma unroll
                for (int e = 0; e < 16; ++e) { const int j = 32 * jt + (e & 3) + 8 * (e >> 2) + 4 * hh; const bool keep = incl ? (j <= t) : (j < t); d[e] = keep ? d[e] : 0.f; }
                if (combo == 0) {
#pragma unroll
                    for (int g = 0; g < 4; ++g) { u32x2 w; w.x = cvt2bf(d[4 * g], d[4 * g + 1]); w.y = cvt2bf(d[4 * g + 2], d[4 * g + 3]); *(LAS u32x2*)(I_AB + t * P + (32 * jt + 8 * g + 4 * hh) * 2) = w;
                        if ((2 * jt + (g >> 1)) == (t >> 4)) *(LAS f32x4*)(ADG + (t >> 4) * 256 + (t & 15) * 16 + ((8 * g + 4 * hh) & 15)) = (f32x4){d[4 * g], d[4 * g + 1], d[4 * g + 2], d[4 * g + 3]}; }
                } else {
#pragma unroll
                    for (int g = 0; g < 4; ++g) { u32x2 w; w.x = cvt2bf(d[4 * g], d[4 * g + 1]); w.y = cvt2bf(d[4 * g + 2], d[4 * g + 3]); *(LAS u32x2*)(Oimg + t * P + (32 * jt + 8 * g + 4 * hh) * 2) = w; }
                }
            }
        }
        __syncthreads();
        { const int tz = c.wave * 64 + lane_id(); for (int o = tz * 16; o < 128 * P; o += 512 * 16) *(LAS u32x4*)(I_XT + o) = (u32x4){0u, 0u, 0u, 0u}; }
        if (c.wave == 4) s1_tinv(ADG, TB);
        if (c.wave < 4) {
            const int lane = lane_id(), r = lane & 31, hh = lane >> 5;
            const int vt = c.wave >> 1, tt = c.wave & 1;
            f32x16 d;
#pragma unroll
            for (int e = 0; e < 16; ++e) d[e] = 0.f;
#pragma unroll
            for (int s = 0; s < 4; ++s) d = __builtin_amdgcn_mfma_f32_32x32x16_bf16(frag144s(I_VT, 32 * vt + r, s, hh), frag144(I_AK, 32 * tt + r, s, hh), d, 0, 0, 0);
            const int t = 32 * tt + r;
#pragma unroll
            for (int g = 0; g < 4; ++g) *(LAS f32x4*)(RZ + t * 68 + 32 * vt + 8 * g + 4 * hh) = (f32x4){d[4 * g], d[4 * g + 1], d[4 * g + 2], d[4 * g + 3]};
        }
        __syncthreads();
        if (u + c.G < BG * NH * (SEQ / 64)) { const int tid = c.wave * 64 + lane_id(); S1_LOAD(u + c.G); }
        s1_solve(c, I_A, I_AB, TB, RZ, AT, I_XT);
        __syncthreads();
        {
            const int lane = lane_id(), r = lane & 31, hh = lane >> 5;
            const int rt = (c.wave >> 1) & 1, ct = c.wave & 1; const bool mhi = c.wave >= 4;
            int u2 = u; asm volatile("" : "+s"(u2));
            const size_t ub = (size_t)u2 * 4096;
#pragma unroll
            for (int it = 0; it < 2; ++it) {
                const int mat = it == 0 ? (mhi ? 3 : 1) : (mhi ? 2 : 0);
                f32x16 d;
                const int cl = 32 * ct + r;
                if (mat == 0) {
#pragma unroll
                    for (int g = 0; g < 4; ++g) { const f32x4 v = unpack4(*(const LAS u32x2*)(I_R + cl * P + (32 * rt + 8 * g + 4 * hh) * 2)); d[4 * g] = v.x; d[4 * g + 1] = v.y; d[4 * g + 2] = v.z; d[4 * g + 3] = v.w; }
#pragma unroll
                    for (int s = 0; s < 4; ++s) d = __builtin_amdgcn_mfma_f32_32x32x16_bf16(frag144(I_XT, 32 * rt + r, s, hh), frag144(I_RB, cl, s, hh), d, 0, 0, 0);
                } else {
#pragma unroll
                    for (int e = 0; e < 16; ++e) d[e] = 0.f;
                    if (mat == 1) {
#pragma unroll
                        for (int s = 0; s < 4; ++s) d = __builtin_amdgcn_mfma_f32_32x32x16_bf16(frag144(I_XT, 64 + 32 * rt + r, s, hh), frag144(I_RB, cl, s, hh), d, 0, 0, 0);
#pragma unroll
                        for (int s = 0; s < 4; ++s) d = __builtin_amdgcn_mfma_f32_32x32x16_bf16(frag144s(I_VT, 32 * rt + r, s, hh), frag144(I_RK, cl, s, hh), d, 0, 0, 0);
                    } else if (mat == 2) {
#pragma unroll
                        for (int s = 0; s < 4; ++s) d = __builtin_amdgcn_mfma_f32_32x32x16_bf16(frag144(I_XT, 32 * rt + r, s, hh), frag144s(I_BT, cl, s, hh), d, 0, 0, 0);
                        const float pl = PL[cl];
#pragma unroll
                        for (int e = 0; e < 16; ++e) { const int k = 32 * rt + (e & 3) + 8 * (e >> 2) + 4 * hh; d[e] = (d[e] + (k == cl ? 1.f : 0.f)) * pl; }
                    } else {
#pragma unroll
                        for (int s = 0; s < 4; ++s) d = __builtin_amdgcn_mfma_f32_32x32x16_bf16(frag144s(I_BT, 32 * rt + r, s, hh), frag144(I_XT, 64 + cl, s, hh), d, 0, 0, 0);
#pragma unroll
                        for (int s = 0; s < 4; ++s) d = __builtin_amdgcn_mfma_f32_32x32x16_bf16(frag144s(I_KT, 32 * rt + r, s, hh), frag144s(I_VT, cl, s, hh), d, 0, 0, 0);
#pragma unroll
                        for (int g = 0; g < 4; ++g) { const f32x4 pl = *(const LAS f32x4*)(PL + 32 * rt + 8 * g + 4 * hh); d[4 * g] *= pl.x; d[4 * g + 1] *= pl.y; d[4 * g + 2] *= pl.z; d[4 * g + 3] *= pl.w; }
                    }
                }
                bf16_t* ob = (mat == 0 ? RH : mat == 1 ? YL : mat == 2 ? MM : NT) + ub + (size_t)cl * 64 + 32 * rt + 4 * hh;
#pragma unroll
                for (int g = 0; g < 4; g += 2) { u32x2 w0, w1; w0.x = cvt2bf(d[4 * g], d[4 * g + 1]); w0.y = cvt2bf(d[4 * g + 2], d[4 * g + 3]); w1.x = cvt2bf(d[4 * g + 4], d[4 * g + 5]); w1.y = cvt2bf(d[4 * g + 6], d[4 * g + 7]);
                    store_pair16(ob + 8 * g, hh, w0, w1); }
            }
        }
    }
}
__device__ __forceinline__ bf16x8 ldfrag8(const bf16_t* p) { const u32x2 lo = *(const u32x2*)p, hi = *(const u32x2*)(p + 8); u32x4 v; v.x = lo.x; v.y = lo.y; v.z = hi.x; v.w = hi.y; return __builtin_bit_cast(bf16x8, v); }
__device__ __forceinline__ bf16x8 packacc(const f32x16& x, int s) { u32x4 w; w.x = cvt2bf(x[8 * s], x[8 * s + 1]); w.y = cvt2bf(x[8 * s + 2], x[8 * s + 3]); w.z = cvt2bf(x[8 * s + 4], x[8 * s + 5]); w.w = cvt2bf(x[8 * s + 6], x[8 * s + 7]); return __builtin_bit_cast(bf16x8, w); }
__device__ __forceinline__ int s2_off(int row, int chunk, int sub) { return row * 128 + ((chunk ^ ((row ^ (row >> 3)) & 7)) << 4) + sub; }
__device__ __forceinline__ bf16x8 s2_frag(const LAS unsigned char* mat, int row, int ch, int hh) {
    const u32x2 lo = *(const LAS u32x2*)(mat + s2_off(row, ch, 8 * hh)), hi = *(const LAS u32x2*)(mat + s2_off(row, ch + 1, 8 * hh)); u32x4 v; v.x = lo.x; v.y = lo.y; v.z = hi.x; v.w = hi.y; return __builtin_bit_cast(bf16x8, v); }
__device__ __forceinline__ void p_scan_s2(const Ctx& c, const InL& in, const bf16_t* RH, const bf16_t* YL, const bf16_t* MM, const bf16_t* NT, const float* bonus, const bf16_t* Vb, const bf16_t* Gt, bf16_t* Z, LAS unsigned char* lds) {
    PHASE_IDS;
    constexpr int NCH = SEQ / 64, SLOT = 32768;
    for (int bh = c.bid; bh < BG * NH; bh += c.G) {
        const int bl = bh / NH, h = bh % NH;
        __syncthreads();
#define S2_ISSUE(ch) do { int ln_ = lane; asm volatile("" : "+v"(ln_)); const size_t ub_ = ((size_t)bh * NCH + (ch)) * 4096; LAS unsigned char* sl_ = lds + ((ch) & 3) * SLOT; \
        _Pragma("unroll") for (int j_ = 0; j_ < 8; ++j_) { const int d_ = ((c.wave - 4) * 8 + j_) * 64 + ln_, q_ = d_ >> 9, row_ = (d_ >> 3) & 63, cp_ = d_ & 7; \
            const bf16_t* src_ = (q_ == 0 ? RH : q_ == 1 ? YL : q_ == 2 ? MM : NT) + ub_ + row_ * 64 + ((cp_ ^ ((row_ ^ (row_ >> 3)) & 7)) << 3); \
            __builtin_amdgcn_global_load_lds((const unsigned*)src_, (LAS unsigned*)(sl_ + ((c.wave - 4) * 8 + j_) * 1024), 16, 0, 0); } } while (0)
        if (c.wave >= 4) { S2_ISSUE(0); S2_ISSUE(1); S2_ISSUE(2); asm volatile("s_waitcnt vmcnt(16)" ::: "memory"); }
        __syncthreads();
        f32x4 plw = {0.f, 0.f, 0.f, 0.f}, plb = {0.f, 0.f, 0.f, 0.f};
        if (c.wave == 2 || c.wave == 3) { int lp = lane; asm volatile("" : "+v"(lp)); plw = *(const f32x4*)(IN(rw_lnx_w) + h * HD + (lp & 15) * 4); plb = *(const f32x4*)(IN(rw_lnx_b) + h * HD + (lp & 15) * 4);
            asm volatile("" : "+v"(plw), "+v"(plb)); }
        f32x16 H0, H1;
#pragma unroll
        for (int e = 0; e < 16; ++e) { H0[e] = 0.f; H1[e] = 0.f; }
#pragma unroll 1
        for (int ch = 0; ch <= NCH; ++ch) {
            if (c.wave >= 4) {
                if (ch < NCH) {
                if (ch + 3 < NCH) S2_ISSUE(ch + 3);
                const int pend = (ch + 3 < NCH ? ch + 3 : NCH - 1) - (ch + 1);
                if (pend >= 2) asm volatile("s_waitcnt vmcnt(16)" ::: "memory"); else if (pend == 1) asm volatile("s_waitcnt vmcnt(8)" ::: "memory"); else asm volatile("s_waitcnt vmcnt(0)" ::: "memory");
                }
            } else if (c.wave >= 2) {
                if (ch >= 1) {
                    int lp = lane; asm volatile("" : "+v"(lp));
                    const LAS unsigned char* yb = lds + LDS_YB + ((ch + 1) & 1) * (64 * 136) + (32 * (c.wave - 2) + (lp >> 4)) * 136 + (lp & 15) * 8;
                    const size_t rowp = (size_t)bl * SEQ + (ch - 1) * 64 + 32 * (c.wave - 2) + (lp >> 4), offp = rowp * DM + h * HD + (lp & 15) * 4;
                    u32x2 pv[8], pg[8], yw[8]; float pb[8]; f32x4 tn[8];
#pragma unroll
                    for (int q = 0; q < 8; ++q) { pv[q] = *(const u32x2*)(Vb + offp + (size_t)4 * q * DM); pg[q] = *(const u32x2*)(Gt + offp + (size_t)4 * q * DM); pb[q] = bonus[(rowp + 4 * q) * NH + h]; }
                    asm volatile("ds_read_b64 %0, %8\n\tds_read_b64 %1, %8 offset:544\n\tds_read_b64 %2, %8 offset:1088\n\tds_read_b64 %3, %8 offset:1632\n\tds_read_b64 %4, %8 offset:2176\n\tds_read_b64 %5, %8 offset:2720\n\t"
                                 "ds_read_b64 %6, %8 offset:3264\n\tds_read_b64 %7, %8 offset:3808\n\ts_waitcnt lgkmcnt(0)"
                                 : "=&v"(yw[0]), "=&v"(yw[1]), "=&v"(yw[2]), "=&v"(yw[3]), "=&v"(yw[4]), "=&v"(yw[5]), "=&v"(yw[6]), "=&v"(yw[7]) : "v"((unsigned)(size_t)yb) : "memory");
#pragma unroll
                    for (int q = 0; q < 8; ++q) {
                        const f32x4 y4 = unpack4(yw[q]);
                        const float mu = sum16((y4.x + y4.y) + (y4.z + y4.w)) * (1.f / 64.f);
                        const f32x4 dy = y4 - mu; const float var = sum16((dy.x * dy.x + dy.y * dy.y) + (dy.z * dy.z + dy.w * dy.w)) * (1.f / 64.f);
                        tn[q] = dy * rsqrtf(var + GN_EPS) * plw + plb;
                    }
                    asm volatile("" : "+v"(tn[0]), "+v"(tn[1]), "+v"(tn[2]), "+v"(tn[3]), "+v"(tn[4]), "+v"(tn[5]), "+v"(tn[6]), "+v"(tn[7]) :: "memory");
                    asm volatile("" : "+v"(pv[0]), "+v"(pv[1]), "+v"(pv[2]), "+v"(pv[3]), "+v"(pv[4]), "+v"(pv[5]), "+v"(pv[6]), "+v"(pv[7]), "+v"(pg[0]), "+v"(pg[1]), "+v"(pg[2]), "+v"(pg[3]), "+v"(pg[4]), "+v"(pg[5]), "+v"(pg[6]), "+v"(pg[7]),
                                 "+v"(pb[0]), "+v"(pb[1]), "+v"(pb[2]), "+v"(pb[3]), "+v"(pb[4]), "+v"(pb[5]), "+v"(pb[6]), "+v"(pb[7]) :: "memory");
                    bf16_t* zo = Z + offp;
#pragma unroll
                    for (int q = 0; q < 8; ++q) { const f32x4 z = (tn[q] + pb[q] * unpack4(pv[q])) * unpack4(pg[q]); *(u32x2*)(zo + (size_t)4 * q * DM) = pack4(z); }
                }
            } else if (ch < NCH) {
                int lo_ = lane; asm volatile("" : "+v"(lo_)); const int r = lo_ & 31, hh = lo_ >> 5, vt = c.wave;
                const LAS unsigned char* sl = lds + (ch & 3) * SLOT; const LAS unsigned char* rh = sl; const LAS unsigned char* yl = sl + 8192; const LAS unsigned char* mm = sl + 16384; const LAS unsigned char* nt = sl + 24576;
                bf16x8 hp[2][2];
#pragma unroll
                for (int s = 0; s < 2; ++s) { hp[0][s] = packacc(H0, s); hp[1][s] = packacc(H1, s); }
#pragma unroll
                for (int tt = 0; tt < 2; ++tt) {
                    f32x16 a; const int t = 32 * tt + r;
#pragma unroll
                    for (int g = 0; g < 4; ++g) { const f32x4 v = unpack4(*(const LAS u32x2*)(yl + s2_off(t, 4 * vt + g, 8 * hh))); a[4 * g] = v.x; a[4 * g + 1] = v.y; a[4 * g + 2] = v.z; a[4 * g + 3] = v.w; }
#pragma unroll
                    for (int kt = 0; kt < 2; ++kt)
#pragma unroll
                        for (int s = 0; s < 2; ++s) a = __builtin_amdgcn_mfma_f32_32x32x16_bf16(hp[kt][s], s2_frag(rh, t, 4 * kt + 2 * s, hh), a, 0, 0, 0);
                    LAS unsigned char* yo = lds + LDS_YB + (ch & 1) * (64 * 136) + t * 136 + (32 * vt + 4 * hh) * 2;
#pragma unroll
                    for (int g = 0; g < 4; ++g) { u32x2 w; w.x = cvt2bf(a[4 * g], a[4 * g + 1]); w.y = cvt2bf(a[4 * g + 2], a[4 * g + 3]); *(LAS u32x2*)(yo + 16 * g) = w; }
                }
                f32x16 n0, n1;
#pragma unroll
                for (int kq = 0; kq < 2; ++kq) {
                    f32x16 a; const int v = 32 * vt + r;
#pragma unroll
                    for (int g = 0; g < 4; ++g) { const f32x4 x = unpack4(*(const LAS u32x2*)(nt + s2_off(v, 4 * kq + g, 8 * hh))); a[4 * g] = x.x; a[4 * g + 1] = x.y; a[4 * g + 2] = x.z; a[4 * g + 3] = x.w; }
#pragma unroll
                    for (int kt = 0; kt < 2; ++kt)
#pragma unroll
                        for (int s = 0; s < 2; ++s) a = __builtin_amdgcn_mfma_f32_32x32x16_bf16(s2_frag(mm, 32 * kq + r, 4 * kt + 2 * s, hh), hp[kt][s], a, 0, 0, 0);
                    if (kq == 0) n0 = a; else n1 = a;
                }
                H0 = n0; H1 = n1;
            }
            asm volatile("s_waitcnt lgkmcnt(0)" ::: "memory"); __builtin_amdgcn_s_barrier(); asm volatile("" ::: "memory");
        }
#undef S2_ISSUE
    }
}
__device__ __forceinline__ void p_scan_post(const Ctx& c, const InL& in, const bf16_t* Yb, const float* bonus, const bf16_t* Vb, const bf16_t* Gt, bf16_t* Z) {
    PHASE_IDS;
    const int gt = c.bid * 512 + tid, NT_ = c.G * 512;
    const int col = (gt & 255) * 4;
    const f32x4 lw = *(const f32x4*)(IN(rw_lnx_w) + col), lb = *(const f32x4*)(IN(rw_lnx_b) + col);
    for (int it = gt; it < TG * 256; it += 4 * NT_) {
        u32x2 yw[4], vw[4], gw[4]; float bo[4];
#pragma unroll
        for (int q = 0; q < 4; ++q) { const int row = (it + q * NT_) >> 8; const size_t off = (size_t)row * DM + col;
            yw[q] = *(const u32x2*)(Yb + off); vw[q] = *(const u32x2*)(Vb + off); gw[q] = *(const u32x2*)(Gt + off); bo[q] = bonus[(size_t)row * NH + (col >> 6)]; }
#pragma unroll
        for (int q = 0; q < 4; ++q) { const int row = (it + q * NT_) >> 8; const size_t off = (size_t)row * DM + col;
            const f32x4 y4 = unpack4(yw[q]), v4 = unpack4(vw[q]), g4 = unpack4(gw[q]);
            const float mu = sum16((y4.x + y4.y) + (y4.z + y4.w)) * (1.f / 64.f);
            const f32x4 dy = y4 - mu; const float var = sum16((dy.x * dy.x + dy.y * dy.y) + (dy.z * dy.z + dy.w * dy.w)) * (1.f / 64.f);
            const f32x4 z = (dy * rsqrtf(var + GN_EPS) * lw + lb + bo[q] * v4) * g4;
            *(u32x2*)(Z + off) = pack4(z); }
    }
}

template <class Sched> __device__ __forceinline__ void p_select(const Ctx& c, const Sched& S, const float* logit, const float* bg, const float* be, unsigned* gcnt, int* tok_e, int* tok_p, float* tok_w, int* rowtab, LAS unsigned char* lds) {
    PHASE_IDS;
    for (int i = c.bid * 512 + tid; i < MAXSLOT; i += c.G * 512) { rowtab[i] = 0; rowtab[STAB_OFF + i] = -1; }
    LAS int* lcnt = (LAS int*)(lds + LDS_HIST); LAS int* lbase = lcnt + NB;
    for (int it = 0; ; ++it) {
        pg8::Unit su; if (!S.next(it, su)) break; const int tb = su.pm * 256;
        if (tid < NB) lcnt[tid] = 0;
        __syncthreads();
        const bool act_ = tid < 256; const int t = tb + (act_ ? tid : 0); const f32x4* lr = (const f32x4*)(logit + (size_t)t * 64);
        const f32x4 gl = lr[0] + *(const f32x4*)bg;
        int grp = 0; float gm = gl.x; if (gl.y > gm) { gm = gl.y; grp = 1; } if (gl.z > gm) { gm = gl.z; grp = 2; } if (gl.w > gm) { gm = gl.w; grp = 3; }
        const float pg = 1.f / ((__expf(gl.x - gm) + __expf(gl.y - gm)) + (__expf(gl.z - gm) + __expf(gl.w - gm)));
        const float* er = logit + (size_t)t * 64 + 4 + 8 * grp; const float* eb = be + 8 * grp;
        float ev[8];
#pragma unroll
        for (int e = 0; e < 8; ++e) ev[e] = er[e] + eb[e];
        int i0 = 0; float m0 = ev[0];
#pragma unroll
        for (int e = 1; e < 8; ++e) if (ev[e] > m0) { m0 = ev[e]; i0 = e; }
        int i1 = -1; float m1 = -3.0e38f;
#pragma unroll
        for (int e = 0; e < 8; ++e) if (e != i0 && ev[e] > m1) { m1 = ev[e]; i1 = e; }
        const float e1 = __expf(m1 - m0), w0 = pg / (1.f + e1), w1 = pg * e1 / (1.f + e1);
        const int ea = grp * 8 + i0, eb2 = NE + grp * 8 + i1;
        int la = 0, lb = 0; if (act_) { la = atomicAdd((int*)&lcnt[ea], 1); lb = atomicAdd((int*)&lcnt[eb2], 1); }
        __syncthreads();
        if (tid < NB) lbase[tid] = (int)atomicAdd(&gcnt[tid], (unsigned)lcnt[tid]);
        __syncthreads();
        if (act_) { tok_e[2 * t] = ea; tok_e[2 * t + 1] = eb2; tok_p[2 * t] = lbase[ea] + la; tok_p[2 * t + 1] = lbase[eb2] + lb; tok_w[2 * t] = w0; tok_w[2 * t + 1] = w1; }
        __syncthreads();
    }
}
__device__ __forceinline__ void moe_table(const Ctx& c, unsigned* gcnt, LAS unsigned char* lds) {
    PHASE_IDS;
    LAS int* toff = (LAS int*)(lds + LDS_TOFF);
    LAS int* tmp = (LAS int*)(lds + LDS_HIST);
    __syncthreads();
    if (tid < NB) tmp[tid] = ((int)__hip_atomic_load(gcnt + tid, RLX_AGENT) + 255) >> 8;
    __syncthreads();
    if (tid == 0) { int o = 0; for (int e = 0; e < NB; ++e) { toff[e] = o; o += tmp[e]; } toff[NB] = o; }
    __syncthreads();
    { LAS unsigned char* texp = (LAS unsigned char*)(lds + LDS_TEXP); const int ntile = toff[NB];
      for (int m = tid; m < ntile; m += 512) { int e = 0; for (int k = 1; k < NB; ++k) if (toff[k] <= m) e = k; texp[m] = (unsigned char)(e & (NE - 1)); } }
    __syncthreads();
}
__device__ __forceinline__ void p_gather(const Ctx& c, const float* ssq, const int* tok_e, const int* tok_p, const float* tok_w, int* tok_s, float* gate, int* rowtab, LAS unsigned char* lds) {
    PHASE_IDS;
    const LAS int* toff = (const LAS int*)(lds + LDS_TOFF);
    for (int i = c.bid * 512 + tid; i < 2 * T; i += c.G * 512) {
        const int slot = toff[tok_e[i]] * 256 + tok_p[i];
        tok_s[i] = slot; rowtab[slot] = i >> 1; rowtab[STAB_OFF + slot] = i >> 1; { const float rs_ = pg8::rstd16(ssq, i >> 1); gate[2 * slot] = rs_; gate[2 * slot + 1] = tok_w[i] * rs_; }
    }
}
struct OrderMoE {
    const LAS int* toff; int G, c, npn; long sA, sBe, sBn; int mlo, mhi;
    __device__ __forceinline__ bool next(int i, pg8::Unit& u) const {
        const int cv = (G % 8 == 0) ? (c % 8) * (G / 8) + c / 8 : c;
        const int L = i * G + cv, m = mlo + L / npn; if (m >= mhi) return false;
        const int e = __builtin_amdgcn_readfirstlane((int)((const LAS unsigned char*)toff)[(LDS_TEXP - LDS_TOFF) + m]);
        u.pm = m; u.pn = L % npn; u.offA = m * sA; u.offB = e * sBe + u.pn * sBn; return true;
    }
};
template <bool FINAL> __device__ __forceinline__ void p_combine(const Ctx& c, bf16_t* h, float* outf, const bf16_t* Y, const int* tok_s, const float* gain, bf16_t* o) {
    PHASE_IDS;
    const int NGW = c.G * 8;
    for (int m0 = c.bid * 8 + c.wave; m0 < T; m0 += 4 * NGW) {
        int s0[4], s1[4];
#pragma unroll
        for (int q = 0; q < 4; ++q) { const int m = m0 + q * NGW; s0[q] = tok_s[2 * m]; s1[q] = tok_s[2 * m + 1]; }
        u32x2 rh[4][4], ya[4][4], yb[4][4];
#pragma unroll
        for (int q = 0; q < 4; ++q) { const int m = m0 + q * NGW; const u32x2* hp = (const u32x2*)(h + (size_t)m * DM) + lane; const u32x2* y0 = (const u32x2*)(Y + (size_t)s0[q] * DM) + lane; const u32x2* y1 = (const u32x2*)(Y + (size_t)s1[q] * DM) + lane;
#pragma unroll
            for (int j = 0; j < 4; ++j) { rh[q][j] = hp[64 * j]; ya[q][j] = y0[64 * j]; yb[q][j] = y1[64 * j]; } }
#pragma unroll
        for (int q = 0; q < 4; ++q) { const int m = m0 + q * NGW; f32x4 v[4]; float ss = 0.f;
#pragma unroll
            for (int j = 0; j < 4; ++j) { v[j] = unpack4(rh[q][j]) + unpack4(ya[q][j]) + unpack4(yb[q][j]); ss += (v[j].x * v[j].x + v[j].y * v[j].y) + (v[j].z * v[j].z + v[j].w * v[j].w); }
            const float rs = rsqrtf(wave_sum(ss) * (1.f / DM) + NORM_EPS);
#pragma unroll
            for (int j = 0; j < 4; ++j) { const f32x4 g = ((const f32x4*)gain)[lane + 64 * j];
                if (FINAL) ((f32x4*)(outf + (size_t)m * DM))[lane + 64 * j] = v[j] * rs * g;
                else { ((u32x2*)(h + (size_t)m * DM))[lane + 64 * j] = pack4(v[j]); ((u32x2*)(o + (size_t)m * DM))[lane + 64 * j] = pack4(v[j] * rs * g); } } }
    }
}
__device__ __forceinline__ void p_final(const Ctx& c, const bf16_t* h, const float* ssq, const float* gain, float* outf) {
    PHASE_IDS;
    const int NGW = c.G * 8;
    f32x4 g[4];
#pragma unroll
    for (int j = 0; j < 4; ++j) g[j] = ((const f32x4*)gain)[lane + 64 * j];
    for (int m0 = c.bid * 8 + c.wave; m0 < T; m0 += 4 * NGW) {
        u32x2 rh[4][4]; float rs[4];
#pragma unroll
        for (int q = 0; q < 4; ++q) { const int m = m0 + q * NGW; const u32x2* hp = (const u32x2*)(h + (size_t)m * DM) + lane; rs[q] = pg8::rstd16(ssq, m);
#pragma unroll
            for (int j = 0; j < 4; ++j) rh[q][j] = hp[64 * j]; }
#pragma unroll
        for (int q = 0; q < 4; ++q) { const int m = m0 + q * NGW;
#pragma unroll
            for (int j = 0; j < 4; ++j) __builtin_nontemporal_store(unpack4(rh[q][j]) * rs[q] * g[j], (f32x4*)(outf + (size_t)m * DM) + lane + 64 * j); }
    }
}
constexpr float STICK_EXIT = 30.f * 1.4426950408889634f;
__device__ __forceinline__ void p_stick2(const Ctx& c, const bf16_t* Q, const bf16_t* Kb, const bf16_t* Vb, bf16_t* O, unsigned* queue, LAS unsigned char* lds) {
    PHASE_IDS;
    const int r = lane & 31, hh = lane >> 5;
    LAS unsigned char* Kw = lds + c.wave * 9216; LAS unsigned char* Vt = Kw + 4608;
    f16x8 Lf[2];
#pragma unroll
    for (int s = 0; s < 2; ++s)
#pragma unroll
        for (int j = 0; j < 8; ++j) Lf[s][j] = (16 * s + 8 * (j >> 2) + 4 * hh + (j & 3) >= r) ? (_Float16)1.0f : (_Float16)0.0f;
    constexpr int NUNIT = BATCH * NH * (SEQ / 32), QLEN = NUNIT / 8, QBATCH = 4;
    int qi = c.bid & 7, qtries = 0, ubase = 0, uleft = 0;
    for (;;) {
        if (uleft == 0) {
            unsigned got = 0u; bool ok = false;
            while (qtries < 8) {
                if (lane == 0) got = __hip_atomic_fetch_add(queue + 64 * qi, (unsigned)QBATCH, RLX_AGENT);
                got = (unsigned)__builtin_amdgcn_readfirstlane((int)got);
                if (got < (unsigned)QLEN) { ok = true; break; }
                qi = (qi + 1) & 7; ++qtries;
            }
            if (!ok) break;
            ubase = qi * QLEN + (int)got; uleft = QBATCH;
        }
        const int u = ubase; ++ubase; --uleft;
        const int qb = u % (SEQ / 32), h = (u / (SEQ / 32)) % NH, b = u / ((SEQ / 32) * NH);
        const size_t rowbase = (size_t)b * SEQ; const int q0 = qb * 32;
        bf16x8 qf[4];
#pragma unroll
        for (int s = 0; s < 4; ++s) qf[s] = *(const bf16x8*)(Q + (rowbase + q0 + r) * DM + h * HD + 16 * s + 8 * hh);
        float carry = 0.f; f32x16 o0, o1;
#pragma unroll
        for (int i = 0; i < 16; ++i) { o0[i] = 0.f; o1[i] = 0.f; }
        u32x4 nk[4], nv[4];
#define STICK_LOAD(jt_) do { _Pragma("unroll") for (int i_ = 0; i_ < 4; ++i_) { const int chunk_ = lane + 64 * i_; const size_t g_ = (rowbase + (jt_) * 32 + (chunk_ >> 3)) * DM + h * HD + (chunk_ & 7) * 8; \
            nk[i_] = *(const u32x4*)(Kb + g_); nv[i_] = *(const u32x4*)(Vb + g_); } } while (0)
        STICK_LOAD(qb);
        for (int jt = qb; jt >= 0; --jt) {
#pragma unroll
            for (int i = 0; i < 4; ++i) { const int chunk = lane + 64 * i, row = chunk >> 3, cc = chunk & 7;
                const u32x4 kv = nk[i], vv = nv[i];
                *(LAS u32x4*)(Kw + row * 144 + cc * 16) = kv;
                const unsigned px = (unsigned)__builtin_amdgcn_update_dpp(0, (int)vv.x, 0x128, 0xF, 0xF, true), py = (unsigned)__builtin_amdgcn_update_dpp(0, (int)vv.y, 0x128, 0xF, 0xF, true);
                const unsigned pz = (unsigned)__builtin_amdgcn_update_dpp(0, (int)vv.z, 0x128, 0xF, 0xF, true), pw = (unsigned)__builtin_amdgcn_update_dpp(0, (int)vv.w, 0x128, 0xF, 0xF, true);
                const bool odd = (row & 1) != 0; const unsigned a0 = odd ? pz : vv.x, a1 = odd ? pw : vv.y, b0 = odd ? vv.z : px, b1 = odd ? vv.w : py;
                LAS unsigned* vt = (LAS unsigned*)(Vt + (cc * 8 + (odd ? 4 : 0)) * 72 + (row & ~1) * 2);
                vt[0 * 18] = (a0 & 0xffffu) | (b0 << 16); vt[1 * 18] = (a0 >> 16) | (b0 & 0xffff0000u); vt[2 * 18] = (a1 & 0xffffu) | (b1 << 16); vt[3 * 18] = (a1 >> 16) | (b1 & 0xffff0000u); }
            if (jt > 0) STICK_LOAD(jt - 1);
            f32x16 p;
#pragma unroll
            for (int i = 0; i < 16; ++i) p[i] = 0.f;
#pragma unroll
            for (int s = 0; s < 4; ++s) { const bf16x8 kf = *(const LAS bf16x8*)(Kw + r * 144 + s * 32 + hh * 16); p = __builtin_amdgcn_mfma_f32_32x32x16_bf16(kf, qf[s], p, 0, 0, 0); }
            const bool diag = (jt == qb);
            float sp[16]; f32x16 cum;
#pragma unroll
            for (int i = 0; i < 16; ++i) { const int kr = (i & 3) + 8 * (i >> 2) + 4 * hh; const bool valid = !diag || (kr < r); const float z = p[i];
                sp[i] = valid ? (fmaxf(z, 0.f) + __builtin_amdgcn_logf(1.f + __builtin_amdgcn_exp2f(-fabsf(z)))) : 0.f; cum[i] = carry; }
#pragma unroll
            for (int s = 0; s < 2; ++s) { u32x4 w; w.x = cvt2h(sp[8 * s], sp[8 * s + 1]); w.y = cvt2h(sp[8 * s + 2], sp[8 * s + 3]); w.z = cvt2h(sp[8 * s + 4], sp[8 * s + 5]); w.w = cvt2h(sp[8 * s + 6], sp[8 * s + 7]);
                cum = __builtin_amdgcn_mfma_f32_32x32x16_f16(Lf[s], __builtin_bit_cast(f16x8, w), cum, 0, 0, 0); }
            float att[16];
#pragma unroll
            for (int i = 0; i < 16; ++i) { const int kr = (i & 3) + 8 * (i >> 2) + 4 * hh; const bool valid = !diag || (kr < r); att[i] = valid ? __builtin_amdgcn_exp2f(p[i] - cum[i]) : 0.f; }
            { const unsigned cu_ = __float_as_uint(cum[0]); carry = __uint_as_float(__builtin_amdgcn_permlane32_swap(cu_, cu_, false, false)[0]); }
#pragma unroll
            for (int s = 0; s < 2; ++s) { u32x4 w; w.x = cvt2bf(att[8 * s], att[8 * s + 1]); w.y = cvt2bf(att[8 * s + 2], att[8 * s + 3]); w.z = cvt2bf(att[8 * s + 4], att[8 * s + 5]); w.w = cvt2bf(att[8 * s + 6], att[8 * s + 7]);
                const bf16x8 af = __builtin_bit_cast(bf16x8, w);
                { const u32x2 lo = *(const LAS u32x2*)(Vt + r * 72 + (16 * s + 4 * hh) * 2), hi = *(const LAS u32x2*)(Vt + r * 72 + (16 * s + 8 + 4 * hh) * 2);
                  u32x4 v; v.x = lo.x; v.y = lo.y; v.z = hi.x; v.w = hi.y; o0 = __builtin_amdgcn_mfma_f32_32x32x16_bf16(__builtin_bit_cast(bf16x8, v), af, o0, 0, 0, 0); }
                { const u32x2 lo = *(const LAS u32x2*)(Vt + (32 + r) * 72 + (16 * s + 4 * hh) * 2), hi = *(const LAS u32x2*)(Vt + (32 + r) * 72 + (16 * s + 8 + 4 * hh) * 2);
                  u32x4 v; v.x = lo.x; v.y = lo.y; v.z = hi.x; v.w = hi.y; o1 = __builtin_amdgcn_mfma_f32_32x32x16_bf16(__builtin_bit_cast(bf16x8, v), af, o1, 0, 0, 0); } }
            if (__all(carry > STICK_EXIT)) break;
        }
#undef STICK_LOAD
        bf16_t* orow = O + (rowbase + q0 + r) * DM + h * HD + 4 * hh;
#pragma unroll
        for (int g = 0; g < 4; g += 2) { u32x2 w0, w1, x0, x1;
            w0.x = cvt2bf(o0[4 * g], o0[4 * g + 1]); w0.y = cvt2bf(o0[4 * g + 2], o0[4 * g + 3]); w1.x = cvt2bf(o0[4 * g + 4], o0[4 * g + 5]); w1.y = cvt2bf(o0[4 * g + 6], o0[4 * g + 7]);
            x0.x = cvt2bf(o1[4 * g], o1[4 * g + 1]); x0.y = cvt2bf(o1[4 * g + 2], o1[4 * g + 3]); x1.x = cvt2bf(o1[4 * g + 4], o1[4 * g + 5]); x1.y = cvt2bf(o1[4 * g + 6], o1[4 * g + 7]);
            store_pair16(orow + 8 * g, hh, w0, w1); store_pair16(orow + 32 + 8 * g, hh, x0, x1); }
    }
}

struct OrderPre {
    int G, c; bool vo;
    __device__ __forceinline__ bool next(int i, pg8::Unit& u) const {
        const int cv = (G % 8 == 0) ? (c % 8) * (G / 8) + c / 8 : c;
        const int L = i * G + cv; if (L >= BATCH * 16) return false;
        const int b = L / 16, s1 = (L / 4) % 4, s0 = L % 4;
        const long om = ((long)b * NMEM * DM + (vo ? s0 : s1) * XD) * 2, ow = ((long)(vo ? s1 : s0) * 256 * DM + (vo ? s0 : s1) * XD) * 2;
        u.pm = b * 4 + s1; u.pn = s0; u.offA = vo ? ow : om; u.offB = vo ? om : ow; return true;
    }
};
struct OrderXS {
    int G, c;
    __device__ __forceinline__ bool next(int i, pg8::Unit& u) const {
        const int cv = (G % 8 == 0) ? (c % 8) * (G / 8) + c / 8 : c;
        const int L = i * G + cv; if (L >= BATCH * 4 * (SEQ / 256)) return false;
        const int b = L / 32, hh = (L / 8) % 4, it = L % 8;
        u.pm = b * 8 + it; u.pn = hh; u.offA = (long)u.pm * 256 * DM * 2; u.offB = ((long)b * DM + hh * 256) * DM * 2; return true;
    }
};

constexpr int NPHASE = 2 + 7 * NGRP + 7 + 3 + 8;
#define AR(i) ((bf16_t*)(ws + WS_ARENA + (size_t)(i) * BUF))
#define HB(i) ((bf16_t*)(ws + WS_ARENA + (size_t)(i) * HBUF))
#define SSQ(i) ((float*)(ws + WS_SSQ) + (size_t)(i) * T * 16)
#define HBR ((bf16_t*)(ws + WS_HB))
#define PH_BEGIN if (lo <= ph && ph < hi) {
#define PH_END   if (!MK_MULTI && ph + 1 < hi) xcd_barrier(bar); } ++ph;

template <int L> __device__ __forceinline__ void xa_fold(const Ctx& c, unsigned char* ws, LAS unsigned char* lds) {
    using namespace pg8;
    bf16_t* KQ = AR(2); bf16_t* VO = AR(2) + (size_t)BATCH * DM * DM;
    { Gemm gm{(const bf16_t*)(ws + WS_MEMK), (const bf16_t*)(ws + WS_XAWQ) + (size_t)L * DM * DM, DM, DM, XD}; OrderPre S{c.G, c.bid, false}; EpiBf16 E{KQ, DM, 0, 0, 1.f, nullptr, nullptr}; gemm_phase<EpiBf16, OrderPre, true>(lds, c.wave, gm, S, E); }
    { Gemm gm{(const bf16_t*)(ws + WS_XAWO) + (size_t)L * DM * DM, (const bf16_t*)(ws + WS_MEMVT), DM, DM, XD}; OrderPre S{c.G, c.bid, true}; EpiBf16 E{VO, DM, 0, 0, 1.f, nullptr, nullptr}; gemm_phase<EpiBf16, OrderPre, true>(lds, c.wave, gm, S, E); }
}
template <int GI> __device__ __forceinline__ void rwkv_group(const Ctx& c, const InL& in, unsigned char* ws, float* hres, LAS unsigned char* lds, const XcdBarrier& bar, int lo, int hi, int& ph) {
    using namespace pg8;
    bf16_t* pq = HB(7); bf16_t* act = HB(7) + (size_t)TG * 512;
    PH_BEGIN p_norm_shift(c, in, GI, HB(0), HB(1), HB(2), HB(3)); PH_END
    PH_BEGIN
    { Gemm gm{HB(1), (const bf16_t*)(ws + WS_WR), DM, DM, DM}; OrderRKV S; S.init(TG, 3 * DM, DM, DM, c.G, c.bid); S.aStep = (long)HBUF;
      EpiBf16 E{HB(4), DM, DM, HBUF / 2, 1.f, nullptr, nullptr}; gemm_phase<EpiBf16, OrderRKV, true>(lds, c.wave, gm, S, E); }
    { Gemm gm{HB(0), (const bf16_t*)(ws + WS_WPQ), DM, DM, DM}; OrderMN S; S.init(TG, 512, DM, DM, c.G, c.bid); EpiBf16 E{pq, 512, 0, 0, 1.f, nullptr, nullptr}; gemm_phase<EpiBf16, OrderMN, true>(lds, c.wave, gm, S, E); }
    PH_END
    PH_BEGIN p_lora_act(c, pq, act); PH_END
    PH_BEGIN
    { Gemm gm{act, (const bf16_t*)(ws + WS_WL2), 256, 256, 128}; OrderLora2 S; S.init(TG, 3072, 256, 256, c.G, c.bid); EpiLora E{HB(0), (size_t)TG * DM, IN(rw_w0), IN(rw_a0)}; gemm_phase<EpiLora, OrderLora2, true>(lds, c.wave, gm, S, E); }
    PH_END
    PH_BEGIN p_scan_s1(c, in, HB(4), HB(5), HB(6), HB(0), HB(1), HB(7), HB(8), HB(9), HB(10), (float*)(ws + WS_BONUS), lds);
    PH_END
    PH_BEGIN p_scan_s2(c, in, HB(7), HB(8), HB(9), HB(10), (const float*)(ws + WS_BONUS), HB(6), HB(2), HB(3), lds); PH_END
    PH_BEGIN
    { Gemm gm{HB(3), (const bf16_t*)(ws + WS_WO0), DM, DM, DM}; OrderMN S; S.init(TG, DM, DM, DM, c.G, c.bid);
      EpiResB E{IN(x) + (size_t)GI * TG * DM, HBR + (size_t)GI * TG * DM, DM, SSQ(0) + (size_t)GI * TG * 16}; gemm_phase<EpiResB, OrderMN, true>(lds, c.wave, gm, S, E); }
    if (GI == NGRP - 1) xa_fold<0>(c, ws, lds);
    PH_END
}
template <int L> __device__ __forceinline__ void layer_tail(const Ctx& c, const InL& in, unsigned char* ws, float* outp, LAS unsigned char* lds, const XcdBarrier& bar, int lo, int hi, int& ph) {
    using namespace pg8;
    unsigned* ctl = (unsigned*)(ws + WS_CTL);
    bf16_t* KQ = AR(2); bf16_t* VO = AR(2) + (size_t)BATCH * DM * DM;
    PH_BEGIN
    { Gemm gm{HBR, KQ, DM, DM, DM}; OrderXS S{c.G, c.bid}; EpiSoftmax E{AR(0), DM, 0.0625f, (LAS float*)(lds + LDS_SM), SSQ(0), (LAS float*)(lds + LDS_SSQP)}; gemm_phase<EpiSoftmax, OrderXS, true>(lds, c.wave, gm, S, E); }
    PH_END
    PH_BEGIN
    { Gemm gm{AR(0), VO, DM, DM, DM}; OrderXS S{c.G, c.bid}; EpiResB E{nullptr, HBR, DM, SSQ(1)}; gemm_phase<EpiResB, OrderXS, true>(lds, c.wave, gm, S, E); }
    PH_END
    bf16_t* xs = AR(1); bf16_t* hid = (bf16_t*)(ws + WS_ARENA + BUF + (size_t)MAXSLOT * DM * 2);
    unsigned* gcnt = ctl + CW_CNT + 128 * L;
    float* logit = (float*)(ws + WS_LOGIT); int* tok_e = (int*)(ws + WS_TOKE); int* tok_p = (int*)(ws + WS_TOKP); float* tok_w = (float*)(ws + WS_TOKW); int* tok_s = (int*)(ws + WS_TOKS); float* gate = (float*)(ws + WS_GATE);
    PH_BEGIN
    { Gemm gm{HBR, (const bf16_t*)(ws + WS_ROUTE) + (size_t)L * 256 * DM, DM, DM, DM}; OrderMN S; S.init(T, 256, DM, DM, c.G, c.bid); EpiRoute E{logit, SSQ(1), (LAS float*)(lds + LDS_SSQP)}; gemm_phase<EpiRoute, OrderMN, true>(lds, c.wave, gm, S, E);
      __builtin_amdgcn_fence(__ATOMIC_ACQUIRE, "agent");
      p_select(c, S, logit, IN(moe_bg) + L * NG, IN(moe_be) + L * NE, gcnt, tok_e, tok_p, tok_w, (int*)(ws + WS_ROWTAB), lds); }
    PH_END
    PH_BEGIN moe_table(c, gcnt, lds); p_gather(c, SSQ(1), tok_e, tok_p, tok_w, tok_s, gate, (int*)(ws + WS_ROWTAB), lds); PH_END
    PH_BEGIN
    { moe_table(c, gcnt, lds); const LAS int* toff = (const LAS int*)(lds + LDS_TOFF);
      Gemm gm{HBR, (const bf16_t*)(ws + WS_W13) + (size_t)L * NE * 512 * DM, DM, DM, DM}; OrderMoE S{toff, c.G, c.bid, 2, (long)256 * DM * 2, (long)512 * DM * 2, (long)256 * DM * 2, 0, __builtin_amdgcn_readfirstlane(toff[NB])};
      EpiSwiGLU E{hid, gate}; gemm_phase_g<EpiSwiGLU, OrderMoE, true>(lds, c.wave, gm, S, E, (const int*)(ws + WS_ROWTAB), (LAS unsigned*)(lds + LDS_GTAB)); }
    PH_END
    PH_BEGIN
    { moe_table(c, gcnt, lds); const LAS int* toff = (const LAS int*)(lds + LDS_TOFF);
      Gemm gm{hid, (const bf16_t*)(ws + WS_W2) + (size_t)L * NE * DM * DF, DF, DF, DF}; OrderMoE S{toff, c.G, c.bid, 4, (long)256 * DF * 2, (long)DM * DF * 2, (long)256 * DF * 2, 0, __builtin_amdgcn_readfirstlane(toff[NE])};
      EpiScatter E{HBR, (const int*)(ws + WS_ROWTAB) + STAB_OFF, nullptr, (LAS int*)(lds + LDS_GTAB)}; gemm_phase<EpiScatter, OrderMoE, true>(lds, c.wave, gm, S, E); }
    PH_END
    PH_BEGIN
    { moe_table(c, gcnt, lds); const LAS int* toff = (const LAS int*)(lds + LDS_TOFF);
      Gemm gm{hid, (const bf16_t*)(ws + WS_W2) + (size_t)L * NE * DM * DF, DF, DF, DF}; OrderMoE S{toff, c.G, c.bid, 4, (long)256 * DF * 2, (long)DM * DF * 2, (long)256 * DF * 2, __builtin_amdgcn_readfirstlane(toff[NE]), __builtin_amdgcn_readfirstlane(toff[NB])};
      EpiScatter E{HBR, (const int*)(ws + WS_ROWTAB) + STAB_OFF, SSQ(0), (LAS int*)(lds + LDS_GTAB)}; gemm_phase<EpiScatter, OrderMoE, true>(lds, c.wave, gm, S, E); }
    PH_END
    if (L == 1) { PH_BEGIN p_final(c, HBR, SSQ(0), IN(norm_final), outp); PH_END }
}

__global__ void __launch_bounds__(512, 2) fwd_kernel(Args args) {
    extern __shared__ __attribute__((aligned(16))) unsigned char lds_raw[];
    LAS unsigned char* lds = (LAS unsigned char*)lds_raw;
    Ctx c; c.wave = __builtin_amdgcn_readfirstlane((int)(threadIdx.x >> 6)); c.bid = blockIdx.x; c.G = gridDim.x; c.gw = c.bid * 8 + c.wave; c.NGW = c.G * 8;
    unsigned char* ws = args.ws; float* hres = args.out;
    unsigned* ctl = (unsigned*)(ws + WS_CTL);
    { const int t0 = c.wave * 64 + lane_id();
      for (int u = t0; u < (LDS_BYTES - LDSCTL_OFF) / 4; u += 512) ((LAS unsigned*)(lds + LDSCTL_OFF))[u] = 0u;
      __syncthreads();
      if (t0 < 37) ((LAS unsigned long long*)(lds + LDS_INP))[t0] = ((const unsigned long long*)__builtin_amdgcn_kernarg_segment_ptr())[t0];
      __syncthreads(); }
    InL in; in.p = (const LAS unsigned long long*)(lds + LDS_INP);
    XcdBarrier bar; bar.bar = ctl + CW_BAR; bar.x = 0; bar.st = nullptr;
    if (!MK_MULTI) bar = xcd_barrier_post(ctl + CW_BAR, (volatile LAS unsigned*)(lds + LDS_XB));
    const int lo = args.ph_lo, hi = args.ph_hi; int ph = 0;
    using namespace pg8;
    PH_BEGIN
    p_prologue(c, in, ws, lds);
    PH_END
    PH_BEGIN
    { Gemm g{(const bf16_t*)(ws + WS_MEMN), (const bf16_t*)(ws + WS_XAWKV), DM, DM, DM}; OrderMN S; S.init(BATCH * NMEM, 2 * DM, DM, DM, c.G, c.bid);
      EpiBf16 E{(bf16_t*)(ws + WS_MEMK), DM, DM, (WS_MEMVT - WS_MEMK) / 2, 1.f, nullptr, nullptr}; gemm_phase<EpiBf16, OrderMN, true>(lds, c.wave, g, S, E); }
    PH_END
    rwkv_group<0>(c, in, ws, hres, lds, bar, lo, hi, ph);
    rwkv_group<1>(c, in, ws, hres, lds, bar, lo, hi, ph);
    layer_tail<0>(c, in, ws, hres, lds, bar, lo, hi, ph);
    PH_BEGIN
    { Gemm gm{HBR, (const bf16_t*)(ws + WS_SBQKV), DM, DM, DM}; OrderMN S; S.init(T, 3 * DM, DM, DM, c.G, c.bid); EpiBf16 E{AR(1), DM, DM, (size_t)T * DM, 0.125f * 1.4426950408889634f, SSQ(0), (LAS float*)(lds + LDS_SSQP)}; gemm_phase<EpiBf16, OrderMN, true>(lds, c.wave, gm, S, E); }
    PH_END
    PH_BEGIN
    p_stick2(c, AR(1), AR(2), AR(3), AR(0), (unsigned*)(ws + WS_CTL) + CW_STQ, lds);
    PH_END
    PH_BEGIN
    { Gemm gm{AR(0), (const bf16_t*)(ws + WS_SBWO), DM, DM, DM}; OrderMN S; S.init(T, DM, DM, DM, c.G, c.bid); EpiResB E{nullptr, HBR, DM, SSQ(0)}; gemm_phase<EpiResB, OrderMN, true>(lds, c.wave, gm, S, E); }
    xa_fold<1>(c, ws, lds);
    PH_END
    layer_tail<1>(c, in, ws, hres, lds, bar, lo, hi, ph);
}
#undef PH_BEGIN
#undef PH_END

extern "C" void kernel_launch(void* const* d_in, const int* in_sizes, int n_in, void* d_out, int out_size, void* d_ws, size_t ws_size, hipStream_t stream) {
    static int grid = 0;
    if (grid == 0) {
        if (n_in != 37 || out_size != T * DM || ws_size < WS_END) { fprintf(stderr, "kernel_launch: unexpected shapes (n_in %d, out %d, ws %zu < %zu)\n", n_in, out_size, ws_size, (size_t)WS_END); grid = -1; return; }
        int dev = 0, cus = 0, per_cu = 0;
        if (hipGetDevice(&dev) != hipSuccess || hipDeviceGetAttribute(&cus, hipDeviceAttributeMultiprocessorCount, dev) != hipSuccess) { grid = -1; return; }
        if (hipFuncSetAttribute((const void*)fwd_kernel, hipFuncAttributeMaxDynamicSharedMemorySize, LDS_BYTES) != hipSuccess) { fprintf(stderr, "kernel_launch: hipFuncSetAttribute failed\n"); grid = -1; return; }
        if (hipOccupancyMaxActiveBlocksPerMultiprocessor(&per_cu, (const void*)fwd_kernel, 512, LDS_BYTES) != hipSuccess || per_cu < 1) fprintf(stderr, "kernel_launch: occupancy query reports %d\n", per_cu);
        (void)hipGetLastError();
        grid = 1; while (grid * 2 <= cus && grid * 2 <= 256) grid *= 2;
    }
    if (grid < 0) return;
    if (hipMemsetAsync((char*)d_ws + WS_CTL, 0, CTL_ZERO_BYTES, stream) != hipSuccess) return;
    Args a{};
    const float** ip = (const float**)&a.in;
    for (int i = 0; i < 37; ++i) ip[i] = (const float*)d_in[i];
    a.out = (float*)d_out; a.ws = (unsigned char*)d_ws;
#if MK_MULTI
    for (int p = 0; p < NPHASE; ++p) { a.ph_lo = p; a.ph_hi = p + 1; hipLaunchKernelGGL(fwd_kernel, dim3(grid), dim3(512), LDS_BYTES, stream, a); }
#else
    a.ph_lo = 0; a.ph_hi = NPHASE; hipLaunchKernelGGL(fwd_kernel, dim3(grid), dim3(512), LDS_BYTES, stream, a);
#endif
}
```
